# Optimizing an MI355X kernel written in HIP

```python
import math
import jax, jax.numpy as jnp
from jax import lax
import numpy as np

D_MODEL = 2048
BATCH = 4
SEQ = 4096
DEPTH = 4

HEAD_DIM = 128
BR_WIDTH = 1024
N_BRANCH = 3
ROPE_THETA = 500000.0
ROPE_DIM = HEAD_DIM // 4
Q_BLOCK = 128
EPS = 1e-6
NEG_INF = -1e30
FORCE_SCORE = 1e6

DIFF_HEADS = BR_WIDTH // (2 * HEAD_DIM)
DIFF_NORM_EPS = 1e-5
NSA_HEADS = BR_WIDTH // HEAD_DIM
NSA_GROUPS = 2
NSA_REP = NSA_HEADS // NSA_GROUPS
CMP_LEN = 32
CMP_STRIDE = 16
SLC_LEN = 64
SLC_TOPK = 16
WINDOW = 512
SLC_Q_CHUNK = 64
SB_HEADS = BR_WIDTH // HEAD_DIM

NSA_KV = NSA_GROUPS * HEAD_DIM
IN_SPLITS = (
    2 * DIFF_HEADS * HEAD_DIM, 2 * DIFF_HEADS * HEAD_DIM, BR_WIDTH, BR_WIDTH,
    BR_WIDTH, NSA_KV, NSA_KV, NSA_KV, NSA_KV, NSA_KV, NSA_KV, 3 * NSA_HEADS, BR_WIDTH,
    BR_WIDTH, BR_WIDTH, BR_WIDTH, BR_WIDTH,
    N_BRANCH * D_MODEL,
)
N_IN = sum(IN_SPLITS)

kernel_name = "hybrid_diff_nsa_stickbreak_block"


def rmsnorm(x, g, eps=EPS):
    xf = x.astype(jnp.float32)
    y = xf * lax.rsqrt(jnp.mean(xf * xf, axis=-1, keepdims=True) + eps)
    return (y * g.astype(jnp.float32)).astype(x.dtype)


def rope_tables(S):
    pos = jnp.arange(S, dtype=jnp.float32)
    inv = ROPE_THETA ** (-jnp.arange(0, ROPE_DIM, 2, dtype=jnp.float32) / ROPE_DIM)
    ang = pos[:, None] * inv[None, :]
    return jnp.cos(ang), jnp.sin(ang)


def partial_rope(x, cos, sin):
    half = ROPE_DIM // 2
    shape = (1, x.shape[1]) + (1,) * (x.ndim - 3) + (half,)
    cs = cos.reshape(shape).astype(x.dtype)
    sn = sin.reshape(shape).astype(x.dtype)
    x1, x2, xp = x[..., :half], x[..., half:ROPE_DIM], x[..., ROPE_DIM:]
    return jnp.concatenate([x1 * cs - x2 * sn, x2 * cs + x1 * sn, xp], axis=-1)


def diff_attention(q, k, v, lq1, lk1, lq2, lk2, norm_g, layer_idx):
    B, S, H = q.shape[0], q.shape[1], q.shape[2]
    nb = S // Q_BLOCK
    lam_init = 0.8 - 0.6 * math.exp(-0.3 * layer_idx)
    f32 = jnp.float32
    lam = (jnp.exp(jnp.sum(lq1.astype(f32) * lk1.astype(f32)))
           - jnp.exp(jnp.sum(lq2.astype(f32) * lk2.astype(f32))) + lam_init)
    scale = HEAD_DIM ** -0.5
    kpos = jnp.arange(S)
    qb = q.reshape(B, nb, Q_BLOCK, H, 2, HEAD_DIM).transpose(1, 0, 2, 3, 4, 5)

    def block(args):
        qblk, b = args
        s = jnp.einsum('bqhcd,bkhcd->bhcqk', qblk, k).astype(f32) * scale
        qpos = b * Q_BLOCK + jnp.arange(Q_BLOCK)
        s = jnp.where(kpos[None, :] <= qpos[:, None], s, NEG_INF)
        p = jax.nn.softmax(s, axis=-1)
        a = p[:, :, 0] - lam * p[:, :, 1]
        return jnp.einsum('bhqk,bkhe->bqhe', a.astype(v.dtype), v)

    o = lax.map(block, (qb, jnp.arange(nb)))
    o = o.transpose(1, 0, 2, 3, 4).reshape(B, S, H, 2 * HEAD_DIM)
    o = rmsnorm(o, norm_g, eps=DIFF_NORM_EPS) * (1.0 - lam_init)
    return o.reshape(B, S, H * 2 * HEAD_DIM)


def stick_breaking(q, k, v):
    B, S, H = q.shape[0], q.shape[1], q.shape[2]
    nb = S // Q_BLOCK
    scale = HEAD_DIM ** -0.5
    kpos = jnp.arange(S)
    qb = q.reshape(B, nb, Q_BLOCK, H, HEAD_DIM).transpose(1, 0, 2, 3, 4)

    def block(args):
        qblk, b = args
        z = jnp.einsum('bqhd,bkhd->bhqk', qblk, k).astype(jnp.float32) * scale
        qpos = b * Q_BLOCK + jnp.arange(Q_BLOCK)
        strict = kpos[None, :] < qpos[:, None]
        log_1m = jnp.where(strict, jax.nn.log_sigmoid(-z), 0.0)
        after = lax.cumsum(log_1m, axis=3, reverse=True) - log_1m
        a = jnp.where(strict, jnp.exp(jax.nn.log_sigmoid(z) + after), 0.0)
        return jnp.einsum('bhqk,bkhd->bqhd', a.astype(v.dtype), v)

    o = lax.map(block, (qb, jnp.arange(nb)))
    return o.transpose(1, 0, 2, 3, 4).reshape(B, S, H * HEAD_DIM)


def compress(x, pe, w1, w2):
    B, S, G, d = x.shape
    n_cmp = (S - CMP_LEN) // CMP_STRIDE + 1
    idx = CMP_STRIDE * jnp.arange(n_cmp)[:, None] + jnp.arange(CMP_LEN)[None, :]
    blk = x[:, idx] + pe[None, None, :, None, :]
    flat = blk.transpose(0, 1, 3, 2, 4).reshape(B, n_cmp, G, CMP_LEN * d)
    return jax.nn.silu(flat @ w1) @ w2


def nsa_attention(q, kc, vc, ks, vs, kw, vw, gate_logits, pe_k, w1_k, w2_k, pe_v, w1_v, w2_v):
    B, S = q.shape[0], q.shape[1]
    G, R, d = NSA_GROUPS, NSA_REP, HEAD_DIM
    f32 = jnp.float32
    scale = d ** -0.5
    qg = q.reshape(B, S, G, R, d)
    t = jnp.arange(S)

    kcmp = compress(kc, pe_k, w1_k, w2_k)
    vcmp = compress(vc, pe_v, w1_v, w2_v)
    n_cmp = kcmp.shape[1]
    cend = CMP_STRIDE * jnp.arange(n_cmp) + CMP_LEN - 1
    cvalid = cend[None, :] <= t[:, None]
    s = jnp.einsum('btgrd,bngd->bgrtn', qg, kcmp).astype(f32) * scale
    p_cmp = jnp.where(cvalid, jax.nn.softmax(jnp.where(cvalid, s, NEG_INF), axis=-1), 0.0)
    o_cmp = jnp.einsum('bgrtn,bngd->btgrd', p_cmp.astype(vcmp.dtype), vcmp)

    n_slc = S // SLC_LEN
    cstart = CMP_STRIDE * jnp.arange(n_cmp)
    sstart = SLC_LEN * jnp.arange(n_slc)
    overlap = ((cstart[:, None] < sstart[None, :] + SLC_LEN)
               & (cstart[:, None] + CMP_LEN > sstart[None, :])).astype(f32)
    imp = jnp.einsum('bgrtn,nj->bgtj', p_cmp, overlap)
    jj = jnp.arange(n_slc)
    tblk = t // SLC_LEN
    forced = (jj[None, :] == tblk[:, None]) | (jj[None, :] == 0)
    imp = jnp.where(forced, FORCE_SCORE, imp)
    imp = jnp.where(jj[None, :] <= tblk[:, None], imp, NEG_INF)
    n_sel = min(SLC_TOPK, n_slc)
    top_val, top_idx = lax.top_k(imp, n_sel)
    sel_ok = top_val > 0.5 * NEG_INF

    ks_blk = ks.reshape(B, n_slc, SLC_LEN, G, d).transpose(0, 3, 1, 2, 4)
    vs_blk = vs.reshape(B, n_slc, SLC_LEN, G, d).transpose(0, 3, 1, 2, 4)
    C = SLC_Q_CHUNK
    nc = S // C
    q_ch = qg.reshape(B, nc, C, G, R, d).transpose(1, 0, 3, 4, 2, 5)
    i_ch = top_idx.reshape(B, G, nc, C, n_sel).transpose(2, 0, 1, 3, 4)
    ok_ch = sel_ok.reshape(B, G, nc, C, n_sel).transpose(2, 0, 1, 3, 4)
    bi = jnp.arange(B)[:, None, None, None]
    gi = jnp.arange(G)[None, :, None, None]

    def sel_block(args):
        qc, ic, okc, cb = args
        kg = ks_blk[bi, gi, ic]
        vg = vs_blk[bi, gi, ic]
        sc = jnp.einsum('bgrcd,bgcnld->bgrcnl', qc, kg).astype(f32) * scale
        tpos = cb * C + jnp.arange(C)
        kpos = ic[..., None] * SLC_LEN + jnp.arange(SLC_LEN)
        ok = okc[..., None] & (kpos <= tpos[None, None, :, None, None])
        sc = jnp.where(ok[:, :, None], sc, NEG_INF)
        p = jax.nn.softmax(sc.reshape(B, G, R, C, n_sel * SLC_LEN), axis=-1)
        p = p.reshape(B, G, R, C, n_sel, SLC_LEN)
        return jnp.einsum('bgrcnl,bgcnld->bgrcd', p.astype(vg.dtype), vg)

    o_slc = lax.map(sel_block, (q_ch, i_ch, ok_ch, jnp.arange(nc)))
    o_slc = o_slc.transpose(1, 0, 4, 2, 3, 5).reshape(B, S, G, R, d)

    nb = S // Q_BLOCK
    span = WINDOW + Q_BLOCK
    kp = jnp.pad(kw, ((0, 0), (WINDOW, 0), (0, 0), (0, 0)))
    vp = jnp.pad(vw, ((0, 0), (WINDOW, 0), (0, 0), (0, 0)))
    widx = Q_BLOCK * jnp.arange(nb)[:, None] + jnp.arange(span)[None, :]
    kb, vb = kp[:, widx], vp[:, widx]
    qb = qg.reshape(B, nb, Q_BLOCK, G, R, d)
    sw = jnp.einsum('bnqgrd,bnkgd->bgrnqk', qb, kb).astype(f32) * scale
    tpos = Q_BLOCK * jnp.arange(nb)[:, None] + jnp.arange(Q_BLOCK)[None, :]
    kpos = (widx - WINDOW)[:, None, :]
    wok = (kpos <= tpos[:, :, None]) & (kpos > tpos[:, :, None] - WINDOW) & (kpos >= 0)
    pw = jax.nn.softmax(jnp.where(wok, sw, NEG_INF), axis=-1)
    o_win = jnp.einsum('bgrnqk,bnkgd->bnqgrd', pw.astype(vb.dtype), vb).reshape(B, S, G, R, d)

    g = jax.nn.sigmoid(gate_logits.reshape(B, S, G, R, 3))
    o = g[..., 0:1] * o_cmp + g[..., 1:2] * o_slc + g[..., 2:3] * o_win
    return o.reshape(B, S, NSA_HEADS * d)


def setup_inputs(seed: int = 0) -> dict:
    key = jax.random.key(seed)
    ks = jax.random.split(key, 20)
    f32 = jnp.float32

    def nrm(k, shape, s):
        return jax.random.normal(k, shape, f32) * s

    D = D_MODEL
    return {
        "x": nrm(ks[0], (BATCH, SEQ, D), 1.0),
        "c": nrm(ks[1], (BATCH, D), 1.0),
        "norm_pre_g": 1.0 + nrm(ks[2], (DEPTH, D), 0.05),
        "norm_post_g": 1.0 + nrm(ks[3], (DEPTH, D), 0.05),
        "w_ada": nrm(ks[4], (DEPTH, D, 3 * D), 0.5 * D ** -0.5),
        "b_ada": nrm(ks[5], (DEPTH, 3 * D), 0.01),
        "w_in": nrm(ks[6], (DEPTH, D, N_IN), D ** -0.5),
        "lambda_q1": nrm(ks[7], (DEPTH, HEAD_DIM), 0.1),
        "lambda_k1": nrm(ks[8], (DEPTH, HEAD_DIM), 0.1),
        "lambda_q2": nrm(ks[9], (DEPTH, HEAD_DIM), 0.1),
        "lambda_k2": nrm(ks[10], (DEPTH, HEAD_DIM), 0.1),
        "diff_norm_g": 1.0 + nrm(ks[11], (DEPTH, 2 * HEAD_DIM), 0.05),
        "cmp_pe_k": nrm(ks[12], (DEPTH, CMP_LEN, HEAD_DIM), 0.02),
        "cmp_w1_k": nrm(ks[13], (DEPTH, CMP_LEN * HEAD_DIM, HEAD_DIM), (CMP_LEN * HEAD_DIM) ** -0.5),
        "cmp_w2_k": nrm(ks[14], (DEPTH, HEAD_DIM, HEAD_DIM), HEAD_DIM ** -0.5),
        "cmp_pe_v": nrm(ks[15], (DEPTH, CMP_LEN, HEAD_DIM), 0.02),
        "cmp_w1_v": nrm(ks[16], (DEPTH, CMP_LEN * HEAD_DIM, HEAD_DIM), (CMP_LEN * HEAD_DIM) ** -0.5),
        "cmp_w2_v": nrm(ks[17], (DEPTH, HEAD_DIM, HEAD_DIM), HEAD_DIM ** -0.5),
        "w_branch": nrm(ks[18], (DEPTH, N_BRANCH, BR_WIDTH, D), BR_WIDTH ** -0.5),
        "w_out": nrm(ks[19], (DEPTH, D, D), D ** -0.5),
    }


def reference(x, c, norm_pre_g, norm_post_g, w_ada, b_ada, w_in, lambda_q1, lambda_k1,
              lambda_q2, lambda_k2, diff_norm_g, cmp_pe_k, cmp_w1_k, cmp_w2_k,
              cmp_pe_v, cmp_w1_v, cmp_w2_v, w_branch, w_out):
    B, S, D = x.shape
    cos, sin = rope_tables(S)
    split_points = [int(v) for v in np.cumsum(IN_SPLITS)[:-1]]
    for l in range(DEPTH):
        mod = jax.nn.silu(c) @ w_ada[l] + b_ada[l]
        shift, scale, gate = jnp.split(mod, 3, axis=-1)
        h = rmsnorm(x, norm_pre_g[l]) * (1.0 + scale[:, None, :]) + shift[:, None, :]
        (a_q, a_k, a_v, a_z,
         n_q, n_kc, n_vc, n_ks, n_vs, n_kw, n_vw, n_g, n_z,
         sb_q, sb_k, sb_v, sb_z, m_g) = jnp.split(h @ w_in[l], split_points, axis=-1)

        a_q = partial_rope(a_q.reshape(B, S, DIFF_HEADS, 2, HEAD_DIM), cos, sin)
        a_k = partial_rope(a_k.reshape(B, S, DIFF_HEADS, 2, HEAD_DIM), cos, sin)
        a_v = a_v.reshape(B, S, DIFF_HEADS, 2 * HEAD_DIM)
        y_a = diff_attention(a_q, a_k, a_v, lambda_q1[l], lambda_k1[l], lambda_q2[l],
                             lambda_k2[l], diff_norm_g[l], l)

        kvs = lambda t_: t_.reshape(B, S, NSA_GROUPS, HEAD_DIM)
        y_b = nsa_attention(
            partial_rope(n_q.reshape(B, S, NSA_HEADS, HEAD_DIM), cos, sin),
            partial_rope(kvs(n_kc), cos, sin), kvs(n_vc),
            partial_rope(kvs(n_ks), cos, sin), kvs(n_vs),
            partial_rope(kvs(n_kw), cos, sin), kvs(n_vw),
            n_g, cmp_pe_k[l], cmp_w1_k[l], cmp_w2_k[l], cmp_pe_v[l], cmp_w1_v[l], cmp_w2_v[l])

        hs = lambda t_: t_.reshape(B, S, SB_HEADS, HEAD_DIM)
        y_c = stick_breaking(hs(sb_q), hs(sb_k), hs(sb_v))

        ys = jnp.stack([y_a * jax.nn.silu(a_z), y_b * jax.nn.silu(n_z),
                        y_c * jax.nn.silu(sb_z)], axis=0)
        yproj = jnp.einsum('nbsw,nwd->nbsd', ys, w_branch[l])
        mg = jax.nn.sigmoid(m_g.reshape(B, S, N_BRANCH, D))
        merged = jnp.einsum('nbsd,bsnd->bsd', yproj, mg)
        out = rmsnorm(merged @ w_out[l], norm_post_g[l])
        x = x + gate[:, None, :] * out
    return x
```

```cpp
#include <hip/hip_runtime.h>
#include <cstdio>
#include <cstdint>

#ifndef MK_ONE_LAUNCH
#define MK_ONE_LAUNCH 1
#endif
#ifndef PROBE_DUP_MASK
#define PROBE_DUP_MASK 0
#endif

namespace pg8 {
#define PG8_LAS __attribute__((address_space(3)))
typedef unsigned short bf16_t;
typedef short bf16x8 __attribute__((ext_vector_type(8)));
typedef float f32x4 __attribute__((ext_vector_type(4)));
typedef unsigned u32x4 __attribute__((ext_vector_type(4)));
constexpr int BM = 256, BK = 64, HALF = 128, HTB = HALF * BK * 2  , STAGE_BYTES = 8 * HTB, NXCD = 8, WGM = 8;

__host__ __device__ __forceinline__ int lds_byte(int r, int c) { const int st = (r >> 4) * 2 + (c >> 5), rr = r & 15, cc = c & 31, ob = rr * 64 + cc * 2; return st * 1024 + (ob ^ (((ob >> 9) & 1) << 5)); }
__host__ __device__ __forceinline__ void stage_rc(int b, int& R, int& C) { const int st = b / 1024, sb = b % 1024, swz = sb ^ (((sb >> 9) & 1) << 5); R = (st >> 1) * 16 + swz / 64; C = (st & 1) * 32 + (swz % 64) / 2; }
__host__ __device__ __forceinline__ int perm32(int rho) { const int n = rho >> 4, i = rho & 15; return 8 * (i >> 2) + 4 * n + (i & 3); }

struct Unit { int pm, pn; };
struct Gemm { const bf16_t* A; const bf16_t* Bt; int M, N, K; };

struct StaticOrder {
    int nM, nN, nwg, G, c;
    __host__ __device__ void init(int M, int N, int G_, int c_) { nM = M / BM; nN = N / BM; nwg = nM * nN; G = G_; c = c_; }
    __host__ __device__ bool next(int i, Unit& u) const {
        const long L = (long)i * G + c; if (L >= nwg) return false;
        int wgid = (int)L; { const int q = nwg / NXCD, r = nwg % NXCD, xcd = wgid % NXCD, off = wgid / NXCD; wgid = (xcd < r ? xcd * (q + 1) : r * (q + 1) + (xcd - r) * q) + off; }
        const int nig = WGM * nN, gid = wgid / nig, fm = gid * WGM, gsz = (nM - fm) < WGM ? (nM - fm) : WGM;
        u.pm = fm + ((wgid % nig) % gsz); u.pn = (wgid % nig) / gsz; return true;
    }
    __device__ __forceinline__ void a_ready(const Unit&) const {}
    __device__ __forceinline__ void done(const Unit&) const {}
};

__device__ __forceinline__ unsigned cvt_pk_bf16(float lo, float hi) { unsigned r; asm volatile("v_cvt_pk_bf16_f32 %0, %1, %2" : "=v"(r) : "v"(lo), "v"(hi)); return r; }
typedef int pg8_v8i32 __attribute__((ext_vector_type(8))); typedef int pg8_v4i32 __attribute__((ext_vector_type(4)));
__device__ __forceinline__ pg8_v8i32 pg8_cat8(bf16x8 lo, bf16x8 hi) { const pg8_v4i32 a = __builtin_bit_cast(pg8_v4i32, lo), b = __builtin_bit_cast(pg8_v4i32, hi); return __builtin_shufflevector(a, b, 0, 1, 2, 3, 4, 5, 6, 7); }
template <class Epi, class Sched, bool ALIGN_EPI = false, bool SP2 = false, bool F8 = false>
__device__ __forceinline__ void gemm_phase(PG8_LAS unsigned char* lds, const Gemm g, const Sched& S, const Epi& E) {
    int tid_ = threadIdx.x; asm volatile("" : "+v"(tid_)); const int tid = tid_, wid = __builtin_amdgcn_readfirstlane(tid >> 6), lane = tid & 63, wr = wid >> 2, wc = wid & 3, fr = lane & 15, fq = lane >> 4;
    const int K = g.K, nt = K / BK;
    unsigned voffA[2], voffB[2];
#pragma unroll
    for (int i = 0; i < 2; ++i) { int R, C; stage_rc(tid * 16 + i * 8192, R, C); const int Rb = Epi::PERM ? ((R & ~31) + perm32(R & 31)) : R;
        voffA[i] = (unsigned)(R * K + C) * 2u; voffB[i] = (unsigned)(Rb * K + C) * 2u; }
    const __amdgpu_buffer_rsrc_t rsrc_voffA = __builtin_amdgcn_make_buffer_rsrc((void*)g.A, 0, 0x7fffffff, 0x00020000), rsrc_voffB = __builtin_amdgcn_make_buffer_rsrc((void*)g.Bt, 0, 0x7fffffff, 0x00020000);
    const unsigned kstep = (unsigned)(BK * 2);
    const unsigned hstep = (unsigned)(HALF * K * 2);
    const unsigned tstep = 2u * hstep;
    const unsigned ldsw = (unsigned)wid * 1024u;
    const int aoff = lds_byte(wr * 64 + fr, fq * 8), boff = lds_byte(wc * 32 + fr, fq * 8);
#define PG8_SA(b, h) (((b) * 2 + (h)) * HTB)
#define PG8_SB(b, h) ((4 + (b) * 2 + (h)) * HTB)
#define PG8_STAGE(bufoff, gbase, voff) do { _Pragma("unroll") for (int _i = 0; _i < 2; ++_i) \
        __builtin_amdgcn_raw_ptr_buffer_load_lds(rsrc_##voff, (PG8_LAS void*)(lds + (bufoff) + ldsw + _i * 8192), 16, (int)(voff)[_i], (int)(unsigned)(gbase), 0, 0); } while (0)
#define PG8_LD8(addr_) __builtin_shufflevector(*(const PG8_LAS pg8_v4i32*)(addr_), *(const PG8_LAS pg8_v4i32*)((addr_) + 1024), 0, 1, 2, 3, 4, 5, 6, 7)
#define PG8_LDA(dst, b, h) do { if constexpr (F8) { _Pragma("unroll") for (int m = 0; m < 4; ++m) dst##8[m] = PG8_LD8(lds + PG8_SA(b, h) + aoff + m * 2048); } \
        else { _Pragma("unroll") for (int m = 0; m < 4; ++m) _Pragma("unroll") for (int k = 0; k < 2; ++k) dst[m][k] = *(const PG8_LAS bf16x8*)(lds + PG8_SA(b, h) + aoff + m * 2048 + k * 1024); } } while (0)
#define PG8_LDB(dst, b, h) do { if constexpr (F8) { _Pragma("unroll") for (int n = 0; n < 2; ++n) dst##8[n] = PG8_LD8(lds + PG8_SB(b, h) + boff + n * 2048); } \
        else { _Pragma("unroll") for (int n = 0; n < 2; ++n) _Pragma("unroll") for (int k = 0; k < 2; ++k) dst[n][k] = *(const PG8_LAS bf16x8*)(lds + PG8_SB(b, h) + boff + n * 2048 + k * 1024); } } while (0)
#define PG8_MMA(ai, bj, At, Bt) do { __builtin_amdgcn_s_setprio(1); \
        if constexpr (F8) { _Pragma("unroll") for (int m = 0; m < 4; ++m) _Pragma("unroll") for (int n = 0; n < 2; ++n) \
            asm volatile("v_mfma_scale_f32_16x16x128_f8f6f4 %0, %1, %2, %0, %3, %3 op_sel_hi:[0,0,0]" : "+v"(acc[ai][bj][m][n]) : "v"(Bt##8[n]), "v"(At##8[m]), "v"(sc8_)); } \
        else { _Pragma("unroll") for (int m = 0; m < 4; ++m) _Pragma("unroll") for (int n = 0; n < 2; ++n) _Pragma("unroll") for (int k = 0; k < 2; ++k) \
            acc[ai][bj][m][n] = __builtin_amdgcn_mfma_f32_16x16x32_bf16(Bt[n][k], At[m][k], acc[ai][bj][m][n], 0, 0, 0); } \
        __builtin_amdgcn_s_setprio(0); } while (0)
#define PG8_WAIT_V(n) asm volatile("s_waitcnt vmcnt(" #n ")" ::: "memory")
#define PG8_WAIT_L(n) asm volatile("s_waitcnt lgkmcnt(" #n ")" ::: "memory")
#define PG8_BAR __builtin_amdgcn_s_barrier()
#define PG8_SCHED __builtin_amdgcn_sched_barrier(0)
    Unit cur, nxt; int ui = 0;
    if (!S.next(0, cur)) return;
    f32x4 acc[2][2][4][2];
#pragma unroll
    for (int a = 0; a < 2; ++a)
#pragma unroll
        for (int b = 0; b < 2; ++b)
#pragma unroll
            for (int m = 0; m < 4; ++m)
#pragma unroll
                for (int n = 0; n < 2; ++n) acc[a][b][m][n] = (f32x4){0.f, 0.f, 0.f, 0.f};
    const int sc8_ = 0x7F7F7F7F;
    bf16x8 At[4][2], B0[2][2], B1[2][2]; pg8_v8i32 At8[4], B08[2], B18[2];
    unsigned cA = (unsigned)cur.pm * tstep, cB = (unsigned)cur.pn * tstep;
    S.a_ready(cur);
    if constexpr (SP2) {
        PG8_STAGE(PG8_SB(0, 0), cB, voffB); PG8_STAGE(PG8_SB(0, 1), cB + hstep, voffB); PG8_STAGE(PG8_SA(0, 0), cA, voffA); PG8_STAGE(PG8_SA(0, 1), cA + hstep, voffA);
        if (wr == 1) PG8_BAR;
        PG8_WAIT_V(2); PG8_BAR;
        PG8_STAGE(PG8_SB(1, 0), cB + kstep, voffB); PG8_STAGE(PG8_SA(1, 0), cA + kstep, voffA); PG8_STAGE(PG8_SB(1, 1), cB + hstep + kstep, voffB);
        PG8_WAIT_V(6); PG8_BAR;
    } else {
        PG8_STAGE(PG8_SB(0, 0), cB, voffB); PG8_STAGE(PG8_SA(0, 0), cA, voffA); PG8_STAGE(PG8_SB(0, 1), cB + hstep, voffB); PG8_STAGE(PG8_SA(0, 1), cA + hstep, voffA);
        if (wr == 1) PG8_BAR;
        PG8_WAIT_V(4); PG8_BAR;
        PG8_STAGE(PG8_SB(1, 0), cB + kstep, voffB); PG8_STAGE(PG8_SA(1, 0), cA + kstep, voffA); PG8_STAGE(PG8_SB(1, 1), cB + hstep + kstep, voffB);
        PG8_WAIT_V(6); PG8_BAR;
    }
    for (;;) {
        const bool has_next = S.next(ui + 1, nxt);
        const unsigned nA = has_next ? (unsigned)nxt.pm * tstep : cA, nB = has_next ? (unsigned)nxt.pn * tstep : cB;
        for (int t = 0; t < nt; t += 2) {
            const bool last = (t == nt - 2);
            const unsigned a1 = cA + (unsigned)(t + 1) * kstep;
            const unsigned a2 = last ? nA : cA + (unsigned)(t + 2) * kstep, b2 = last ? nB : cB + (unsigned)(t + 2) * kstep;
            const unsigned a3 = a2 + kstep, b3 = b2 + kstep;
            if (last && has_next) S.a_ready(nxt);
            if constexpr (SP2) {
            PG8_LDB(B0, 0, 0); PG8_LDB(B1, 0, 1); PG8_SCHED; PG8_LDA(At, 0, 0); PG8_STAGE(PG8_SA(1, 1), a1 + hstep, voffA);
            PG8_WAIT_V(8); PG8_WAIT_L(0); PG8_BAR; PG8_MMA(0, 0, At, B0); PG8_MMA(0, 1, At, B1); PG8_BAR; PG8_SCHED;
            PG8_LDA(At, 0, 1); PG8_STAGE(PG8_SB(0, 0), b2, voffB); PG8_STAGE(PG8_SB(0, 1), b2 + hstep, voffB); PG8_STAGE(PG8_SA(0, 0), a2, voffA);
            PG8_WAIT_V(8); PG8_WAIT_L(0); PG8_BAR; PG8_MMA(1, 0, At, B0); PG8_MMA(1, 1, At, B1); PG8_BAR; PG8_SCHED;
            PG8_LDB(B0, 1, 0); PG8_LDB(B1, 1, 1); PG8_SCHED; PG8_LDA(At, 1, 0); PG8_STAGE(PG8_SA(0, 1), a2 + hstep, voffA);
            PG8_WAIT_V(8); PG8_WAIT_L(0); PG8_BAR; PG8_MMA(0, 0, At, B0); PG8_MMA(0, 1, At, B1); PG8_BAR; PG8_SCHED;
            PG8_LDA(At, 1, 1); PG8_STAGE(PG8_SB(1, 0), b3, voffB); PG8_STAGE(PG8_SB(1, 1), b3 + hstep, voffB); PG8_STAGE(PG8_SA(1, 0), a3, voffA);
            PG8_WAIT_V(8); PG8_WAIT_L(0); PG8_BAR; PG8_MMA(1, 0, At, B0); PG8_MMA(1, 1, At, B1); PG8_BAR; PG8_SCHED;
            } else {
            PG8_LDB(B0, 0, 0); PG8_SCHED; PG8_LDA(At, 0, 0); PG8_STAGE(PG8_SA(1, 1), a1 + hstep, voffA);
            PG8_WAIT_L(8); PG8_BAR; PG8_WAIT_L(0); PG8_MMA(0, 0, At, B0); PG8_BAR; PG8_SCHED;
            PG8_LDB(B1, 0, 1); PG8_STAGE(PG8_SB(0, 0), b2, voffB);
            PG8_BAR; PG8_WAIT_L(0); PG8_MMA(0, 1, At, B1); PG8_BAR;
            PG8_LDA(At, 0, 1); PG8_STAGE(PG8_SA(0, 0), a2, voffA);
            PG8_BAR; PG8_WAIT_L(0); PG8_MMA(1, 0, At, B0); PG8_BAR; PG8_SCHED;
            PG8_STAGE(PG8_SB(0, 1), b2 + hstep, voffB);
            PG8_WAIT_V(6); PG8_BAR; PG8_MMA(1, 1, At, B1); PG8_BAR;
            PG8_LDB(B0, 1, 0); PG8_SCHED; PG8_LDA(At, 1, 0); PG8_STAGE(PG8_SA(0, 1), a2 + hstep, voffA);
            PG8_WAIT_L(8); PG8_BAR; PG8_WAIT_L(0); PG8_MMA(0, 0, At, B0); PG8_BAR; PG8_SCHED;
            PG8_LDB(B1, 1, 1); PG8_STAGE(PG8_SB(1, 0), b3, voffB);
            PG8_BAR; PG8_WAIT_L(0); PG8_MMA(0, 1, At, B1); PG8_BAR;
            PG8_LDA(At, 1, 1); PG8_STAGE(PG8_SA(1, 0), a3, voffA);
            PG8_BAR; PG8_WAIT_L(0); PG8_MMA(1, 0, At, B0); PG8_BAR; PG8_SCHED;
            PG8_STAGE(PG8_SB(1, 1), b3 + hstep, voffB);
            PG8_WAIT_V(6); PG8_BAR; PG8_MMA(1, 1, At, B1); PG8_BAR;
            }
        }
        if constexpr (ALIGN_EPI) { if (wr == 0) PG8_BAR; }
        if constexpr (F8) asm volatile("s_nop 15\n\ts_nop 15" ::: "memory");
        if constexpr (!Epi::AFTER_DRAIN) { E(acc, cur, wr, wc, fr, fq); S.done(cur); }
        if (!has_next) break;
#pragma unroll
        for (int a = 0; a < 2; ++a)
#pragma unroll
            for (int b = 0; b < 2; ++b)
#pragma unroll
                for (int m = 0; m < 4; ++m)
#pragma unroll
                    for (int n = 0; n < 2; ++n) acc[a][b][m][n] = (f32x4){0.f, 0.f, 0.f, 0.f};
        cur = nxt; cA = nA; cB = nB; ++ui;
        if constexpr (ALIGN_EPI) { if (wr == 1) PG8_BAR; }
    }
    PG8_WAIT_V(0);
    if constexpr (!ALIGN_EPI) { if (wr == 0) PG8_BAR; }
    PG8_BAR;
    if constexpr (Epi::AFTER_DRAIN) { E.fused(acc, cur, wr, wc, fr, fq, lds, wid, lane); S.done(cur); }
#undef PG8_SA
#undef PG8_SB
#undef PG8_STAGE
#undef PG8_LDA
#undef PG8_LD8
#undef PG8_LDB
#undef PG8_MMA
#undef PG8_WAIT_V
#undef PG8_WAIT_L
#undef PG8_BAR
#undef PG8_SCHED
}
}
#define XB_TMO      128
#define XB_XCNT(j)  (256  + 64 * (j))
#define XB_XSUB(j)  (1280 + 64 * (j))
#define XB_XGEN(j)  (2304 + 64 * (j))
#define XB_TOP      3328
#define XB_TOPGEN   3392
#define XCD_BAR_WORDS 3456
#define XB_SPIN_CAP (1u << 18)
#define LAS __attribute__((address_space(3)))

__device__ __forceinline__ unsigned xb_ld(unsigned* p)              { return __hip_atomic_load(p, __ATOMIC_RELAXED, __HIP_MEMORY_SCOPE_AGENT); }
__device__ __forceinline__ unsigned xb_add(unsigned* p, unsigned v) { return __hip_atomic_fetch_add(p, v, __ATOMIC_RELAXED, __HIP_MEMORY_SCOPE_AGENT); }
__device__ __forceinline__ unsigned xb_xcc_id() { return (unsigned)__builtin_amdgcn_s_getreg((3 << 11) | 20) & 0xFu; }
#define XB_SPIN(cond, bar) do { unsigned _sp = 0; while (cond) { __builtin_amdgcn_s_sleep(1); \
    if ((++_sp & 255u) == 0u) { if (xb_ld(&(bar)[XB_TMO])) break; if (_sp > XB_SPIN_CAP) { atomicAdd(&(bar)[XB_TMO], 1u); break; } } } } while (0)

struct XcdBarrier {
    unsigned* bar; unsigned x;
    volatile LAS unsigned* st;
};

__device__ __forceinline__ XcdBarrier xcd_barrier_post(unsigned* bar, volatile LAS unsigned* st) {
    XcdBarrier b; b.bar = bar; b.x = xb_xcc_id(); b.st = st;
    if (threadIdx.x == 0) (void)xb_add(&bar[XB_XCNT(b.x)], 1u);
    return b;
}
__device__ __forceinline__ void xcd_barrier_complete(unsigned* bar, unsigned x, unsigned& nloc, unsigned& nx) {
    const unsigned G = gridDim.x * gridDim.y * gridDim.z;
    unsigned sum, cnt, mine, sp = 0u;
    for (;;) {
        sum = 0u; cnt = 0u; mine = 0u;
#pragma unroll
        for (unsigned j = 0; j < 16; ++j) { const unsigned c = xb_ld(&bar[XB_XCNT(j)]); sum += c; cnt += (c > 0u) ? 1u : 0u; mine = (j == x) ? c : mine; }
        if (sum == G) break;
        __builtin_amdgcn_s_sleep(1);
        if ((++sp & 255u) == 0u) { if (xb_ld(&bar[XB_TMO])) break; if (sp > XB_SPIN_CAP) { atomicAdd(&bar[XB_TMO], 1u); break; } }
    }
    nloc = mine > 0u ? mine : 1u; nx = cnt > 0u ? cnt : 1u;
}

__device__ __forceinline__ void xcd_barrier(const XcdBarrier& b) {
    asm volatile("s_waitcnt vmcnt(0)" ::: "memory");
    __syncthreads();
    if (threadIdx.x == 0) {
        unsigned* bar = b.bar;
        __builtin_amdgcn_s_waitcnt(0);
        unsigned nloc = b.st[0], nx = b.st[1];
        if (nloc == 0u) { xcd_barrier_complete(bar, b.x, nloc, nx); b.st[0] = nloc; b.st[1] = nx; }
        const unsigned old = xb_add(&bar[XB_XSUB(b.x)], 1u);
        const unsigned gen = old / nloc;
        if (old + 1u == (gen + 1u) * nloc) {
            __builtin_amdgcn_fence(__ATOMIC_RELEASE, "agent");
            asm volatile("s_waitcnt vmcnt(0)" ::: "memory");
            const unsigned og = xb_add(&bar[XB_TOP], 1u);
            const unsigned tg = og / nx;
            if (og + 1u == (tg + 1u) * nx) xb_add(&bar[XB_TOPGEN], 1u);
            else XB_SPIN(xb_ld(&bar[XB_TOPGEN]) == tg, bar);
            __builtin_amdgcn_fence(__ATOMIC_ACQUIRE, "agent");
            xb_add(&bar[XB_XGEN(b.x)], 1u);
            asm volatile("s_waitcnt vmcnt(0)" ::: "memory");
        } else {
            XB_SPIN(xb_ld(&bar[XB_XGEN(b.x)]) == gen, bar);
            __builtin_amdgcn_fence(__ATOMIC_ACQUIRE, "agent");
            asm volatile("s_waitcnt vmcnt(0)" ::: "memory");
        }
    }
    __syncthreads();
}

__device__ __forceinline__ void group_barrier(unsigned* bar, unsigned* ctr, unsigned target) {
    asm volatile("s_waitcnt vmcnt(0)" ::: "memory");
    __syncthreads();
    if (threadIdx.x == 0) {
        __builtin_amdgcn_s_waitcnt(0);
        __builtin_amdgcn_fence(__ATOMIC_RELEASE, "agent");
        asm volatile("s_waitcnt vmcnt(0)" ::: "memory");
        (void)xb_add(ctr, 1u);
        XB_SPIN(xb_ld(ctr) < target, bar);
        __builtin_amdgcn_fence(__ATOMIC_ACQUIRE, "agent");
        asm volatile("s_waitcnt vmcnt(0)" ::: "memory");
    }
    __syncthreads();
}

__device__ __forceinline__ void wg_publish(unsigned* ctr) {
    asm volatile("s_waitcnt vmcnt(0)" ::: "memory");
    __syncthreads();
    if (threadIdx.x == 0) { __builtin_amdgcn_s_waitcnt(0); __builtin_amdgcn_fence(__ATOMIC_RELEASE, "agent"); asm volatile("s_waitcnt vmcnt(0)" ::: "memory"); (void)xb_add(ctr, 1u); }
}
__device__ __forceinline__ void wg_await(unsigned* bar, unsigned* ctr, unsigned target) {
    if (threadIdx.x == 0) { XB_SPIN(xb_ld(ctr) < target, bar); __builtin_amdgcn_fence(__ATOMIC_ACQUIRE, "agent"); asm volatile("s_waitcnt vmcnt(0)" ::: "memory"); }
    __syncthreads();
}

typedef unsigned short bf16;
typedef unsigned long long u64;
constexpr int NBATCH = 4, SEQ = 4096, DM = 2048, MTOK = NBATCH * SEQ, DEPTH = 4;
constexpr int N_IN = 17944, LDP = 18176;
constexpr int C_AQ = 0, C_AK = 1024, C_AV = 2048, C_AZ = 3072;
constexpr int C_NQ = 4096, C_NKC = 5120, C_NVC = 5376, C_NKS = 5632, C_NVS = 5888, C_NKW = 6144, C_NVW = 6400, C_NZ = 6656;
constexpr int C_SQ = 7680, C_SK = 8704, C_SV = 9728, C_SZ = 10752, C_NG = 11776, C_MG = 12032;
constexpr int N_BF = 12032, N_F8 = 6144;
constexpr float F8_SCALE_H = 32.f, F8_SCALE_W = 2048.f, F8_UNSCALE = 1.0f / (32.f * 2048.f);
constexpr u64 ROPE_BLOCKS = 0xFFFFull | (0x3FFull << 32) | (3ull << 44) | (3ull << 48);

constexpr size_t MiB = 1u << 20;
constexpr size_t WS_CTL = 0;
constexpr size_t CTL_BYTES = 1 * MiB;
constexpr size_t WS_ROPE = 1 * MiB;
constexpr size_t WS_MOD = 2 * MiB;
constexpr size_t WS_LAM = 3 * MiB;
constexpr size_t WS_MODP = 4 * MiB;
constexpr size_t WS_KCMP = 20 * MiB;
constexpr size_t WS_VCMP = 21 * MiB;
constexpr size_t WS_SELM = 22 * MiB;
constexpr size_t WS_W1K = 24 * MiB;
constexpr size_t WS_W1V = 28 * MiB;
constexpr size_t WS_W2K = 32 * MiB;
constexpr size_t WS_W2V = 33 * MiB;
constexpr size_t WS_WOUT = 34 * MiB;
constexpr size_t WS_WBR = 66 * MiB;
constexpr size_t WS_WIN = 114 * MiB;
constexpr size_t WS_H = 398 * MiB;
constexpr size_t WS_PROJ = 462 * MiB;
constexpr size_t WS_DIFFO = 1030 * MiB;
constexpr size_t WS_YS = 1094 * MiB;
constexpr size_t WS_OWIN = 1190 * MiB;
constexpr size_t WS_OCMP = 1222 * MiB;
constexpr size_t WS_WG8 = 1254 * MiB;
constexpr size_t WS_H8 = 1302 * MiB;
constexpr size_t WS_MERGED = 1382 * MiB;
constexpr size_t WS_OUTPRE = 1446 * MiB;
constexpr size_t WS_END = 1510 * MiB;

constexpr int CW_TMO = 0;
constexpr int CW_QUEUE = 8192;
constexpr int CW_CMPD = 5632, CW_DIFFD = 6144;
constexpr int CW_GRP = 5120;
constexpr int CW_BAR = 1024;

constexpr int LDS_MAIN = 131072;
constexpr int LDS_AUX = 131072;
constexpr int LDS_CTL = 147456;
constexpr int LDS_BYTES = 147712;

#define GAS __attribute__((address_space(1)))
typedef float f32x2 __attribute__((ext_vector_type(2)));
typedef unsigned u32x2 __attribute__((ext_vector_type(2)));
__device__ __forceinline__ float bf2f(unsigned short b) { return __uint_as_float(((unsigned)b) << 16); }
__device__ __forceinline__ unsigned f2bf(float f) { unsigned u = __float_as_uint(f); return (u + 0x7fffu + ((u >> 16) & 1u)) >> 16; }
__device__ __forceinline__ unsigned pk2(float lo, float hi) { unsigned r; asm volatile("v_cvt_pk_bf16_f32 %0, %1, %2" : "=v"(r) : "v"(lo), "v"(hi)); return r; }
__device__ __forceinline__ float clamp8(float x) { return fminf(fmaxf(x, -448.f), 448.f); }
__device__ __forceinline__ unsigned pk4_fp8(float a, float b, float c, float d) {
    int w = __builtin_amdgcn_cvt_pk_fp8_f32(clamp8(a), clamp8(b), 0, false); w = __builtin_amdgcn_cvt_pk_fp8_f32(clamp8(c), clamp8(d), w, true); return (unsigned)w; }
__device__ __forceinline__ float lo_bf(unsigned w) { return __uint_as_float(w << 16); }
__device__ __forceinline__ float hi_bf(unsigned w) { return __uint_as_float(w & 0xffff0000u); }
__device__ __forceinline__ float sigmoidf_(float x) { return __builtin_amdgcn_rcpf(1.0f + __builtin_amdgcn_exp2f(-1.4426950408889634f * x)); }
__device__ __forceinline__ float siluf_(float x) { return x * sigmoidf_(x); }
__device__ __forceinline__ float other_half(float x) {
    auto rr = __builtin_amdgcn_permlane32_swap(__float_as_uint(x), __float_as_uint(x), false, false);
    return __uint_as_float((__lane_id() & 32) ? rr[0] : rr[1]);
}

__device__ __forceinline__ int opaque_tid() { const int w = __builtin_amdgcn_readfirstlane((int)threadIdx.x >> 6);
    int t = w * 64 + (int)__builtin_amdgcn_mbcnt_hi(~0u, __builtin_amdgcn_mbcnt_lo(~0u, 0u)); asm volatile("" : "+v"(t)); return t; }
struct Params {
    const float* x; const float* c; const float* norm_pre_g; const float* norm_post_g; const float* w_ada; const float* b_ada; const float* w_in;
    const float* lq1; const float* lk1; const float* lq2; const float* lk2; const float* diff_norm_g;
    const float* pe_k; const float* w1_k; const float* w2_k; const float* pe_v; const float* w1_v; const float* w2_v; const float* w_branch; const float* w_out;
    float* out; unsigned char* ws;
};

namespace pg8 {
struct EpiProj {
    static constexpr bool PERM = true, AFTER_DRAIN = false;
    bf16_t* __restrict__ O; const float* __restrict__ rope;
    __device__ __forceinline__ void operator()(const f32x4 (&acc)[2][2][4][2], const Unit& u, int wr, int wc, int fr, int fq) const {
        run(acc, u, wr, wc, fr, fq); if constexpr (((PROBE_DUP_MASK) >> 15) & 1) { asm volatile("" ::: "memory"); run(acc, u, wr, wc, fr, fq); } }
    __device__ __forceinline__ void run(const f32x4 (&acc)[2][2][4][2], const Unit& u, int wr, int wc, int fr, int fq) const {
        const int row0 = u.pm * BM + wr * 64 + fr, col0 = u.pn * BM + wc * 32 + 8 * fq;
        const bool rot = wc == 0 && u.pn < 32 && ((ROPE_BLOCKS >> (2 * u.pn)) & 1ull);
        const float sg = (fq < 2) ? -1.f : 1.f;
#pragma unroll
        for (int ai = 0; ai < 2; ++ai) {
            f32x4 c0[4], c1[4], s0[4], s1[4];
            if (rot) {
#pragma unroll
                for (int m = 0; m < 4; ++m) { const float* cs = rope + (size_t)((row0 + ai * HALF + m * 16) & (SEQ - 1)) * 32 + 8 * (fq & 1);
                    c0[m] = *(const f32x4*)cs; c1[m] = *(const f32x4*)(cs + 4); s0[m] = *(const f32x4*)(cs + 16); s1[m] = *(const f32x4*)(cs + 20); }
                asm volatile("" ::: "memory");
            }
#pragma unroll
            for (int m = 0; m < 4; ++m) {
                const int row = row0 + ai * HALF + m * 16;
                bf16_t* rowp = O + (size_t)row * LDP + col0;
#pragma unroll
                for (int bj = 0; bj < 2; ++bj) {
                    f32x4 v0 = acc[ai][bj][m][0], v1 = acc[ai][bj][m][1];
                    if (rot) {
                        f32x4 o0, o1;
#pragma unroll
                        for (int j = 0; j < 4; ++j) { o0[j] = other_half(v0[j]); o1[j] = other_half(v1[j]); }
                        v0 = v0 * c0[m] + sg * (o0 * s0[m]); v1 = v1 * c1[m] + sg * (o1 * s1[m]);
                    }
                    u32x4 w; w.x = cvt_pk_bf16(v0[0], v0[1]); w.y = cvt_pk_bf16(v0[2], v0[3]); w.z = cvt_pk_bf16(v1[0], v1[1]); w.w = cvt_pk_bf16(v1[2], v1[3]);
                    *(u32x4*)(rowp + bj * HALF) = w;
                }
            }
        }
    }
};
struct EpiPlain {
    static constexpr bool PERM = true, AFTER_DRAIN = false;
    bf16_t* O; int ldc;
    __device__ __forceinline__ void operator()(const f32x4 (&acc)[2][2][4][2], const Unit& u, int wr, int wc, int fr, int fq) const {
        const int row0 = u.pm * BM + wr * 64 + fr, col0 = u.pn * BM + wc * 32 + 8 * fq;
#pragma unroll
        for (int ai = 0; ai < 2; ++ai)
#pragma unroll
            for (int m = 0; m < 4; ++m) {
                bf16_t* rowp = O + (size_t)(row0 + ai * HALF + m * 16) * ldc + col0;
#pragma unroll
                for (int bj = 0; bj < 2; ++bj) {
                    const f32x4 v0 = acc[ai][bj][m][0], v1 = acc[ai][bj][m][1];
                    u32x4 w; w.x = cvt_pk_bf16(v0[0], v0[1]); w.y = cvt_pk_bf16(v0[2], v0[3]); w.z = cvt_pk_bf16(v1[0], v1[1]); w.w = cvt_pk_bf16(v1[2], v1[3]);
                    *(u32x4*)(rowp + bj * HALF) = w;
                }
            }
    }
};
struct EpiGate8 {
    static constexpr bool PERM = true, AFTER_DRAIN = false;
    bf16_t* O;
    __device__ __forceinline__ void operator()(const f32x4 (&acc)[2][2][4][2], const Unit& u, int wr, int wc, int fr, int fq) const {
        const int row0 = u.pm * BM + wr * 64 + fr, col0 = C_MG + u.pn * BM + wc * 32 + 8 * fq;
#pragma unroll
        for (int ai = 0; ai < 2; ++ai)
#pragma unroll
            for (int m = 0; m < 4; ++m) {
                bf16_t* rowp = O + (size_t)(row0 + ai * HALF + m * 16) * LDP + col0;
#pragma unroll
                for (int bj = 0; bj < 2; ++bj) {
                    const f32x4 v0 = acc[ai][bj][m][0] * F8_UNSCALE, v1 = acc[ai][bj][m][1] * F8_UNSCALE;
                    u32x4 w; w.x = cvt_pk_bf16(v0[0], v0[1]); w.y = cvt_pk_bf16(v0[2], v0[3]); w.z = cvt_pk_bf16(v1[0], v1[1]); w.w = cvt_pk_bf16(v1[2], v1[3]);
                    *(u32x4*)(rowp + bj * HALF) = w;
                }
            }
    }
};
struct EpiBranch {
    static constexpr bool PERM = true, AFTER_DRAIN = false;
    const bf16_t* __restrict__ proj; bf16_t* merged;
    __device__ __forceinline__ void operator()(const f32x4 (&acc)[2][2][4][2], const Unit& u, int wr, int wc, int fr, int fq) const {
        const int n = u.pm >> 6, pm = u.pm & 63, pn = u.pn & 7;
        const int row0 = pm * BM + wr * 64 + fr, col0 = pn * BM + wc * 32 + 8 * fq;
        const unsigned goff = (unsigned)(row0 * LDP + C_MG + n * DM + col0) * 2u, toff = (unsigned)(row0 * DM + col0) * 2u;
#pragma unroll
        for (int ai = 0; ai < 2; ++ai) {
            u32x4 g[4][2], t[4][2];
#pragma unroll
            for (int m = 0; m < 4; ++m)
#pragma unroll
                for (int bj = 0; bj < 2; ++bj) { const int dr = ai * HALF + m * 16;
                    g[m][bj] = *(const u32x4*)((const char*)proj + goff + (unsigned)(dr * LDP + bj * HALF) * 2u);
                    if (n > 0) t[m][bj] = *(const u32x4*)((const char*)merged + toff + (unsigned)(dr * DM + bj * HALF) * 2u); }
            asm volatile("" ::: "memory");
#pragma unroll
            for (int m = 0; m < 4; ++m)
#pragma unroll
                for (int bj = 0; bj < 2; ++bj) { const int dr = ai * HALF + m * 16;
                    const u32x4 gg = g[m][bj];
                    f32x4 v0 = acc[ai][bj][m][0], v1 = acc[ai][bj][m][1];
                    v0[0] *= sigmoidf_(lo_bf(gg.x)); v0[1] *= sigmoidf_(hi_bf(gg.x)); v0[2] *= sigmoidf_(lo_bf(gg.y)); v0[3] *= sigmoidf_(hi_bf(gg.y));
                    v1[0] *= sigmoidf_(lo_bf(gg.z)); v1[1] *= sigmoidf_(hi_bf(gg.z)); v1[2] *= sigmoidf_(lo_bf(gg.w)); v1[3] *= sigmoidf_(hi_bf(gg.w));
                    if (n > 0) { const u32x4 tt = t[m][bj];
                        v0[0] += lo_bf(tt.x); v0[1] += hi_bf(tt.x); v0[2] += lo_bf(tt.y); v0[3] += hi_bf(tt.y); v1[0] += lo_bf(tt.z); v1[1] += hi_bf(tt.z); v1[2] += lo_bf(tt.w); v1[3] += hi_bf(tt.w); }
                    u32x4 w; w.x = cvt_pk_bf16(v0[0], v0[1]); w.y = cvt_pk_bf16(v0[2], v0[3]); w.z = cvt_pk_bf16(v1[0], v1[1]); w.w = cvt_pk_bf16(v1[2], v1[3]);
                    *(u32x4*)((char*)merged + toff + (unsigned)(dr * DM + bj * HALF) * 2u) = w;
                }
        }
    }
};
struct BranchOrder {
    int G, c;
    __device__ bool next(int i, Unit& u) const {
        const int ts = i / 3, n = i - ts * 3; const long L = (long)ts * G + c; constexpr int nM = 64, nN = 8, nwg = nM * nN;
        if (L >= nwg) return false;
        int wgid = (int)L; { const int q = nwg / NXCD, xcd = wgid % NXCD, off = wgid / NXCD; wgid = xcd * q + off; }
        const int nig = WGM * nN, gid = wgid / nig, fm = gid * WGM;
        u.pm = n * 64 + fm + ((wgid % nig) % WGM); u.pn = n * 8 + (wgid % nig) / WGM; return true;
    }
    __device__ __forceinline__ void a_ready(const Unit&) const {}
    __device__ __forceinline__ void done(const Unit&) const {}
};
}

typedef short bf16x8 __attribute__((ext_vector_type(8)));
typedef short s16x4 __attribute__((ext_vector_type(4)));
typedef float f32x16 __attribute__((ext_vector_type(16)));
typedef float f32x4 __attribute__((ext_vector_type(4)));
typedef unsigned u32x4 __attribute__((ext_vector_type(4)));
template <class A, class Bt> struct same_t { static constexpr bool v = false; };
template <class A> struct same_t<A, A> { static constexpr bool v = true; };
constexpr int D = 128;
constexpr float SCALE = 0.08838834764831845f;
constexpr float THR = 8.f;
constexpr int NW = 8, QBLK = 32, KVBLK = 64, QB = NW * QBLK;
constexpr int SHM_V = KVBLK * D * 2, SHM_K = KVBLK * D * 2;
#define KSWZ(row, colB) ((row) * 256 + ((colB) ^ (((row) & 7) << 4)))
#define SBAR() __builtin_amdgcn_sched_barrier(0)
__device__ __forceinline__ int v_st(int k, int c) { const int kk = (k & ~0xC) | ((k & 4) << 1) | ((k & 8) >> 1); return ((kk >> 3) * 4 + (c >> 5)) * 512 + ((kk & 7) * 32 + (c & 31)) * 2; }
__device__ __forceinline__ int v_rd_base(int lane) { return ((lane & 3) << 3) | (((lane >> 2) & 3) << 6) | (((lane >> 4) & 1) << 5) | (((lane >> 5) & 1) << 8); }
constexpr int v_rd_off(int d0, int ks, int half) { return d0 * 512 + ks * 4096 + half * 2048; }
__device__ __forceinline__ int crow(int r, int hi) { return (r & 3) + 8 * (r >> 2) + 4 * hi; }
__device__ __forceinline__ unsigned cvtpk(float lo, float hi) {
    unsigned r; asm volatile("v_cvt_pk_bf16_f32 %0, %1, %2" : "=v"(r) : "v"(lo), "v"(hi)); return r;
}
__device__ __forceinline__ bf16x8 pack8(f32x4 a, f32x4 b) {
    u32x4 w = {cvtpk(a[0], a[1]), cvtpk(a[2], a[3]), cvtpk(b[0], b[1]), cvtpk(b[2], b[3])};
    return *reinterpret_cast<bf16x8*>(&w);
}
template <class T> __device__ __forceinline__ bf16x8 load8(const T* p) {
    if constexpr (same_t<T, float>::v) { return pack8(*(const f32x4*)p, *(const f32x4*)(p + 4)); }
    else { return *reinterpret_cast<const bf16x8*>(p); }
}
__device__ __forceinline__ void mask_tile(f32x16& p0, f32x16& p1, int dq, unsigned W) {
    const float NEG = -__builtin_inff();
#pragma unroll
    for (int r = 0; r < 16; ++r) {
        const int c = (r & 3) + 8 * (r >> 2);
        if ((unsigned)(dq - c) >= W) p0[r] = NEG;
        if ((unsigned)(dq - c - 32) >= W) p1[r] = NEG;
    }
}
__device__ __forceinline__ void partialSM(f32x16& p0, f32x16& p1, float& m_reg, float& mn, float& alpha) {
    float pmax = p0[0]; for (int r = 1; r < 16; ++r) pmax = fmaxf(pmax, p0[r]); for (int r = 0; r < 16; ++r) pmax = fmaxf(pmax, p1[r]);
    { auto rr = __builtin_amdgcn_permlane32_swap(__float_as_uint(pmax), __float_as_uint(pmax), false, false);
      pmax = fmaxf(__uint_as_float(rr[0]), __uint_as_float(rr[1])); }
    constexpr float C2 = 1.4426950408889634f * SCALE;
    if (__builtin_expect(__all((pmax - m_reg) * SCALE <= THR), 1)) { mn = m_reg; alpha = 1.f; }
    else { mn = fmaxf(m_reg, pmax); alpha = __builtin_amdgcn_exp2f((m_reg - mn) * C2); m_reg = mn; }
    const float mnL = -mn * C2;
    for (int r = 0; r < 16; ++r) p0[r] = fmaf(p0[r], C2, mnL); for (int r = 0; r < 16; ++r) p1[r] = fmaf(p1[r], C2, mnL);
    for (int r = 0; r < 16; ++r) p0[r] = __builtin_amdgcn_exp2f(p0[r]);
}
__device__ __forceinline__ void finishSM(f32x16& p0, f32x16& p1, float alpha, float& l_reg, bf16x8& pa0, bf16x8& pa1, bf16x8& pa2, bf16x8& pa3) {
    for (int r = 0; r < 16; ++r) p1[r] = __builtin_amdgcn_exp2f(p1[r]);
    float ps = 0; for (int r = 0; r < 16; ++r) ps += p0[r]; for (int r = 0; r < 16; ++r) ps += p1[r];
    { auto rr = __builtin_amdgcn_permlane32_swap(__float_as_uint(ps), __float_as_uint(ps), false, false);
      ps = __uint_as_float(rr[0]) + __uint_as_float(rr[1]); }
    l_reg = l_reg * alpha + ps;
#define PK4(P, B_, OUT) do { unsigned a0 = cvtpk(P[B_+0], P[B_+1]), a1 = cvtpk(P[B_+2], P[B_+3]);                          \
        unsigned b0 = cvtpk(P[B_+4], P[B_+5]), b1 = cvtpk(P[B_+6], P[B_+7]);                                             \
        auto r0 = __builtin_amdgcn_permlane32_swap(a0, b0, false, false); auto r1 = __builtin_amdgcn_permlane32_swap(a1, b1, false, false); \
        u32x4 w = {r0[0], r1[0], r0[1], r1[1]}; OUT = *reinterpret_cast<bf16x8*>(&w); } while (0)
    PK4(p0, 0, pa0); PK4(p0, 8, pa1); PK4(p1, 0, pa2); PK4(p1, 8, pa3);
#undef PK4
}
template <int KB, bool SK>
__device__ __forceinline__ void qkt(f32x16& p0, f32x16& p1, const char* K_lds, int r32, int hi, const bf16x8* qr, bool act) {
    if (SK && !act) { const float NEG = -__builtin_inff();
#pragma unroll
        for (int r = 0; r < 16; ++r) { p0[r] = NEG; p1[r] = NEG; } return; }
    p0 = f32x16{}; p1 = f32x16{};
    const char* kb[4];
#pragma unroll
    for (int dd = 0; dd < 4; ++dd) kb[dd] = K_lds + KB * SHM_K + KSWZ(r32, (dd * 16 + hi * 8) * 2);
#pragma unroll
    for (int d0 = 0; d0 < 8; ++d0) { const char* a = kb[d0 & 3] + (d0 >> 2) * 128;
        bf16x8 b0 = *reinterpret_cast<const bf16x8*>(a);
        bf16x8 b1 = *reinterpret_cast<const bf16x8*>(a + 32 * 256);
        p0 = __builtin_amdgcn_mfma_f32_32x32x16_bf16(b0, qr[d0], p0, 0, 0, 0);
        p1 = __builtin_amdgcn_mfma_f32_32x32x16_bf16(b1, qr[d0], p1, 0, 0, 0); }
}
template <int VB, bool SK>
__device__ __forceinline__ void pv_tile(f32x16* o, int vb0, bf16x8 pa0, bf16x8 pa1, bf16x8 pa2, bf16x8 pa3, bool act) {
    if (SK && !act) return;
#define TRRD(dst, off) asm volatile("ds_read_b64_tr_b16 %0, %1 offset:%2" : "=&v"(dst) : "v"(vb0), "i"(off) : "memory")
#define PV_D0(d0) do { s16x4 l0, l1, l2, l3, h0, h1, h2, h3; constexpr int b_ = VB * SHM_V + v_rd_off(d0, 0, 0);     \
        TRRD(l0, b_); TRRD(h0, b_ + 2048); TRRD(l1, b_ + 4096); TRRD(h1, b_ + 6144); TRRD(l2, b_ + 8192); TRRD(h2, b_ + 10240); TRRD(l3, b_ + 12288); TRRD(h3, b_ + 14336); \
        asm volatile("s_waitcnt lgkmcnt(0)" ::: "memory"); SBAR();                 \
        o[d0] = __builtin_amdgcn_mfma_f32_32x32x16_bf16(pa0, (bf16x8){l0[0], l0[1], l0[2], l0[3], h0[0], h0[1], h0[2], h0[3]}, o[d0], 0, 0, 0);   \
        o[d0] = __builtin_amdgcn_mfma_f32_32x32x16_bf16(pa1, (bf16x8){l1[0], l1[1], l1[2], l1[3], h1[0], h1[1], h1[2], h1[3]}, o[d0], 0, 0, 0);   \
        o[d0] = __builtin_amdgcn_mfma_f32_32x32x16_bf16(pa2, (bf16x8){l2[0], l2[1], l2[2], l2[3], h2[0], h2[1], h2[2], h2[3]}, o[d0], 0, 0, 0);   \
        o[d0] = __builtin_amdgcn_mfma_f32_32x32x16_bf16(pa3, (bf16x8){l3[0], l3[1], l3[2], l3[3], h3[0], h3[1], h3[2], h3[3]}, o[d0], 0, 0, 0); } while (0)
    PV_D0(0); PV_D0(1); PV_D0(2); PV_D0(3);
#undef PV_D0
#undef TRRD
}

__device__ __forceinline__ bf16x8 ld8(const bf16* p) { return *reinterpret_cast<const bf16x8*>(p); }
__device__ __forceinline__ bf16x8 bload8(const void* base, unsigned voff, unsigned soff) {
    const __amdgpu_buffer_rsrc_t r = __builtin_amdgcn_make_buffer_rsrc((void*)base, 0, 0x7fffffff, 0x00020000);
    u32x4 v = __builtin_amdgcn_raw_buffer_load_b128(r, (int)voff, (int)soff, 0);
    return *reinterpret_cast<bf16x8*>(&v);
}

struct BlockRef { const bf16* Q; const bf16* K; const bf16* V; const u64* M; int P0; int row0; int aux; int aux2; };
struct Seam { bf16x8 qr[8]; bf16x8 st_v0, st_v1, st_k0, st_k1; };
__device__ __forceinline__ int swa_jlo(int P0, int W) { const int lowk = P0 - W + 1; return lowk > 0 ? lowk / KVBLK : 0; }
#define TILEP(p, k0) ((const char*)(p) + (size_t)(k0) * (LDP * 2))
#define VMW() asm volatile("s_waitcnt vmcnt(0)" ::: "memory")
#define VMWN(n) asm volatile("s_waitcnt vmcnt(%0)" :: "i"(n) : "memory")
#define SLOAD_H(Kp, Vp, k0) do { const unsigned so_ = (unsigned)(k0) * (LDP * 2u);                                   \
                         S.st_v0 = bload8(Vp, roff0, so_); S.st_v1 = bload8(Vp, roff0, so_ + 32u * LDP * 2u);              \
                         S.st_k0 = bload8(Kp, roff0, so_); S.st_k1 = bload8(Kp, roff0, so_ + 32u * LDP * 2u); } while (0)
#define SWRITE_HK(bf) do { *(bf16x8*)(K_lds + (bf) * SHM_K + kws) = S.st_k0; *(bf16x8*)(K_lds + (bf) * SHM_K + kws + 32 * 256) = S.st_k1; } while (0)
#define SWRITE_HV(bf) do { *(bf16x8*)(V_lds + (bf) * SHM_V + vst0) = S.st_v0; *(bf16x8*)(V_lds + (bf) * SHM_V + vst1) = S.st_v1; } while (0)
#define SWRITE_H(bf) do { SWRITE_HV(bf); SWRITE_HK(bf); } while (0)
__device__ __forceinline__ void attn_prime(const BlockRef& cur, int W, char* lds, Seam& S) {
    const int tid = opaque_tid(), wid = __builtin_amdgcn_readfirstlane(tid >> 6), lane = tid & 63, r32 = lane & 31, hi = lane >> 5;
    const int sr = tid >> 4, sc = (tid & 15) * 8, kws = KSWZ(sr, sc * 2); char* K_lds = lds + 2 * SHM_V;
    const unsigned roff0 = (unsigned)(sr * LDP + sc) * 2u, qoff = (unsigned)(r32 * LDP + hi * 8) * 2u;
    const int kb0 = swa_jlo(cur.P0, W) * KVBLK;
    { const unsigned qs_ = (unsigned)(wid * QBLK) * (LDP * 2u);
#pragma unroll
    for (int d0 = 0; d0 < 8; ++d0) S.qr[d0] = bload8(cur.Q, qoff + d0 * 32, qs_); }
    SLOAD_H(cur.K, cur.V, kb0); VMW(); SWRITE_HK(0);
    __syncthreads();
}

__device__ __forceinline__ void partialSM_sel(f32x16& p0, f32x16& p1, float& m_reg, float& mn, float& alpha, bool sel) {
    const float NEG = -__builtin_inff();
    float pmax = p0[0]; for (int r = 1; r < 16; ++r) pmax = fmaxf(pmax, p0[r]); for (int r = 0; r < 16; ++r) pmax = fmaxf(pmax, p1[r]);
    { auto rr = __builtin_amdgcn_permlane32_swap(__float_as_uint(pmax), __float_as_uint(pmax), false, false);
      pmax = fmaxf(__uint_as_float(rr[0]), __uint_as_float(rr[1])); }
    pmax = sel ? pmax : NEG;
    constexpr float C2 = 1.4426950408889634f * SCALE;
    if (__builtin_expect(__all((pmax - m_reg) * SCALE <= THR), 1)) { mn = m_reg; alpha = 1.f; }
    else { mn = fmaxf(m_reg, pmax); alpha = __builtin_amdgcn_exp2f((m_reg - mn) * C2); m_reg = mn; }
    const float mnL = sel ? -mn * C2 : NEG;
    for (int r = 0; r < 16; ++r) p0[r] = fmaf(p0[r], C2, mnL); for (int r = 0; r < 16; ++r) p1[r] = fmaf(p1[r], C2, mnL);
    for (int r = 0; r < 16; ++r) p0[r] = __builtin_amdgcn_exp2f(p0[r]);
}
template <bool SK, bool SLC, class Epi>
__device__ __forceinline__ void attn_block(const BlockRef& cur, const BlockRef& nxt, int skv, int W, char* lds, Seam& S, const Epi& E) {
    const int tid = opaque_tid(), wid = __builtin_amdgcn_readfirstlane(tid >> 6), lane = tid & 63, r32 = lane & 31, hi = lane >> 5;
    const int j_lo = swa_jlo(cur.P0, W);
    int j_hi = (cur.P0 + QB - 1) / KVBLK + 1; if (j_hi > skv / KVBLK) j_hi = skv / KVBLK;
    const int NT = j_hi - j_lo;
    const int kbn = swa_jlo(nxt.P0, W) * KVBLK;
    const int qlo = cur.P0 + wid * QBLK, qm = qlo + r32 - 4 * hi;
    char* V_lds = lds; char* K_lds = lds + 2 * SHM_V;
    float* ws = (float*)(lds + 2 * SHM_V + 2 * SHM_K) + wid * 64; float* li_l = ws, * al_l = ws + 32;
    float m_reg = -1e30f, l_reg = 0; f32x16 o[4] = {};
    const int sr = tid >> 4, sc = (tid & 15) * 8, vst0 = v_st(sr, sc), vst1 = vst0 + 8192, kws = KSWZ(sr, sc * 2);
    const unsigned roff0 = (unsigned)(sr * LDP + sc) * 2u, qoff = (unsigned)(r32 * LDP + hi * 8) * 2u;
    const int vb0 = (int)(uintptr_t)V_lds + v_rd_base(lane);
    const bf16* Kh = cur.K; const bf16* Vh = cur.V;
    u64 rowmask = ~0ull; if constexpr (SLC) rowmask = cur.M[cur.P0 + wid * QBLK + r32];
#define RESC(a) do { if (__any((a) < 1.f)) { if (hi == 0) al_l[r32] = (a); asm volatile("s_waitcnt lgkmcnt(0)" ::: "memory");              \
                     for (int d_ = 0; d_ < 4; ++d_) for (int r = 0; r < 16; ++r) o[d_][r] *= al_l[crow(r, hi)]; } } while (0)
#define KBASE(t) ((j_lo + (t)) * KVBLK)
#define ACT(t) (KBASE(t) <= qlo + QBLK - 1 && KBASE(t) + KVBLK - 1 >= qlo - W + 1)
#define MASKT(P0_, P1_, t) do { const int kb_ = KBASE(t); if ((!SK || ACT(t)) && (kb_ + KVBLK - 1 > qlo || kb_ <= qlo + QBLK - 1 - W)) mask_tile(P0_, P1_, qm - kb_, (unsigned)W); } while (0)
#define PSM(P0_, P1_, mn_, al_, t) do { if constexpr (SLC) partialSM_sel(P0_, P1_, m_reg, mn_, al_, ((rowmask >> (j_lo + (t))) & 1ull) != 0ull); else partialSM(P0_, P1_, m_reg, mn_, al_); } while (0)
    constexpr int NQL = 8;
#define SEAM_K0() do { VMWN(NQL); SWRITE_HK(0); SBAR(); } while (0)
    f32x16 pA0, pA1, pB0, pB1; float mnA, mnB, alA, alB; bf16x8 pa0, pa1, pa2, pa3;
    SWRITE_HV(0); SBAR();
    if (NT > 1) { SLOAD_H(Kh, Vh, KBASE(1)); }
    SBAR(); qkt<0, SK>(pA0, pA1, K_lds, r32, hi, S.qr, ACT(0));
    MASKT(pA0, pA1, 0); PSM(pA0, pA1, mnA, alA, 0);
    if (NT > 1) { VMW(); SWRITE_H(1); }
    __syncthreads();
#define HALF_STEP(PX0, PX1, mnX, alX, PY0, PY1, alY, t, KB, VB, SB) do {                                                      \
        SBAR(); qkt<KB, SK>(PX0, PX1, K_lds, r32, hi, S.qr, ACT(t));                                             \
        finishSM(PY0, PY1, alY, l_reg, pa0, pa1, pa2, pa3); SBAR();                                                           \
        if ((t) + 1 < NT) { SLOAD_H(Kh, Vh, KBASE((t) + 1)); SBAR(); }                                               \
        pv_tile<VB, SK>(o, vb0, pa0, pa1, pa2, pa3, ACT((t) - 1)); MASKT(PX0, PX1, (t)); PSM(PX0, PX1, mnX, alX, (t));                                        \
        __syncthreads();                                                                                                      \
        if ((t) + 1 < NT) { VMW(); SWRITE_H(SB); }                                                                          \
        RESC(alX); __syncthreads(); } while (0)
    for (int t = 1; t + 1 < NT; t += 2) {
        HALF_STEP(pB0, pB1, mnB, alB, pA0, pA1, alA, t, 1, 0, 0);
        HALF_STEP(pA0, pA1, mnA, alA, pB0, pB1, alB, t + 1, 0, 1, 1);
    }
    const bool even = (NT & 1) == 0;
    if (even) { SBAR(); qkt<1, SK>(pB0, pB1, K_lds, r32, hi, S.qr, ACT(NT - 1)); SBAR(); }
    SLOAD_H(nxt.K, nxt.V, kbn); SBAR();
    { const unsigned qs_ = (unsigned)(wid * QBLK) * (LDP * 2u);
#pragma unroll
    for (int d0 = 0; d0 < 8; ++d0) S.qr[d0] = bload8(nxt.Q, qoff + d0 * 32, qs_); }
    SBAR();
    finishSM(pA0, pA1, alA, l_reg, pa0, pa1, pa2, pa3); SBAR();
    pv_tile<0, SK>(o, vb0, pa0, pa1, pa2, pa3, ACT(even ? NT - 2 : NT - 1));
    if (even) { MASKT(pB0, pB1, NT - 1); PSM(pB0, pB1, mnB, alB, NT - 1); __syncthreads(); RESC(alB);
        finishSM(pB0, pB1, alB, l_reg, pa0, pa1, pa2, pa3); SBAR(); pv_tile<1, SK>(o, vb0, pa0, pa1, pa2, pa3, ACT(NT - 1)); }
    SBAR(); SEAM_K0();
    if (hi == 0) li_l[r32] = l_reg; asm volatile("s_waitcnt lgkmcnt(0)" ::: "memory");
    float rli[16];
#pragma unroll
    for (int r = 0; r < 16; ++r) rli[r] = __builtin_amdgcn_rcpf(li_l[crow(r, hi)]);
    E(o, rli, cur, wid, r32, hi);
    __syncthreads();
#undef RESC
#undef KBASE
#undef ACT
#undef MASKT
#undef PSM
#undef SEAM_K0
#undef HALF_STEP
}


constexpr int OST_PITCH = 272, OST_WAVE = 32 * OST_PITCH, OST_BASE = 73728;
__device__ __forceinline__ void ost_put(char* scr, const f32x16* o, const float (&sc)[16], int r32, int hi) {
#pragma unroll
    for (int r = 0; r < 16; r += 2) {
        char* rp = scr + crow(r, hi) * OST_PITCH + r32 * 2;
#pragma unroll
        for (int d0 = 0; d0 < 4; ++d0) { const unsigned w = cvtpk(o[d0][r] * sc[r], o[d0][r + 1] * sc[r + 1]);
            *(unsigned short*)(rp + d0 * 64) = (unsigned short)w; *(unsigned short*)(rp + OST_PITCH + d0 * 64) = (unsigned short)(w >> 16); }
    }
}
__device__ __forceinline__ u32x4 ost_get(const char* scr, int q, int lane) { return *(const u32x4*)(scr + (q * 4 + (lane >> 4)) * OST_PITCH + (lane & 15) * 16); }

struct EpiAttnStore {
    bf16* O; int ldo; char* lds;
    __device__ __forceinline__ void operator()(const f32x16 (&o)[4], const float (&rli)[16], const BlockRef& cur, int wid, int r32, int hi) const {
        int lane = hi * 32 + r32; asm volatile("" : "+v"(lane));
        char* scr = lds + OST_BASE + wid * OST_WAVE;
        ost_put(scr, o, rli, r32, hi);
        char* Ow = (char*)(O + (size_t)(cur.row0 + wid * QBLK) * ldo + cur.aux);
        const unsigned loff = (unsigned)((lane >> 4) * ldo + (lane & 15) * 8) * 2u;
#pragma unroll
        for (int q = 0; q < 8; ++q) *(u32x4*)(Ow + (size_t)(q * 4 * ldo) * 2 + loff) = ost_get(scr, q, lane);
    }
};
struct EpiNsaCombine {
    const bf16* __restrict__ proj; const bf16* __restrict__ ocmp; const bf16* __restrict__ owin; bf16* __restrict__ ys; char* lds;
    __device__ __forceinline__ void operator()(const f32x16 (&o)[4], const float (&rli)[16], const BlockRef& cur, int wid, int r32, int hi) const {
        int lane = hi * 32 + r32; asm volatile("" : "+v"(lane));
        char* scr = lds + OST_BASE + wid * OST_WAVE;
        ost_put(scr, o, rli, r32, hi);
        const int rowb = cur.row0 + wid * QBLK + (lane >> 4), colb = cur.aux + (lane & 15) * 8;
#pragma unroll
        for (int qh = 0; qh < 2; ++qh) {
            u32x4 oc[4], ow[4], zz[4]; unsigned short gq[4][3];
#pragma unroll
            for (int qi = 0; qi < 4; ++qi) { const size_t row = (size_t)(rowb + (qh * 4 + qi) * 4);
                oc[qi] = *(const u32x4*)(ocmp + row * 1024 + colb); ow[qi] = *(const u32x4*)(owin + row * 1024 + colb); zz[qi] = *(const u32x4*)(proj + row * LDP + C_NZ + colb);
                const bf16* gp = proj + row * LDP + C_NG + cur.aux2 * 3; gq[qi][0] = gp[0]; gq[qi][1] = gp[1]; gq[qi][2] = gp[2]; }
            asm volatile("" ::: "memory");
#pragma unroll
            for (int qi = 0; qi < 4; ++qi) { const size_t row = (size_t)(rowb + (qh * 4 + qi) * 4);
                const u32x4 os = ost_get(scr, qh * 4 + qi, lane);
                const float g0 = sigmoidf_(bf2f(gq[qi][0])), g1 = sigmoidf_(bf2f(gq[qi][1])), g2 = sigmoidf_(bf2f(gq[qi][2]));
                const unsigned ocw[4] = {oc[qi].x, oc[qi].y, oc[qi].z, oc[qi].w}, oww[4] = {ow[qi].x, ow[qi].y, ow[qi].z, ow[qi].w}, zw[4] = {zz[qi].x, zz[qi].y, zz[qi].z, zz[qi].w}, osw[4] = {os.x, os.y, os.z, os.w};
                unsigned res[4];
#pragma unroll
                for (int j = 0; j < 4; ++j) {
                    const float a = (g0 * lo_bf(ocw[j]) + g1 * lo_bf(osw[j]) + g2 * lo_bf(oww[j])) * siluf_(lo_bf(zw[j]));
                    const float b2 = (g0 * hi_bf(ocw[j]) + g1 * hi_bf(osw[j]) + g2 * hi_bf(oww[j])) * siluf_(hi_bf(zw[j]));
                    res[j] = cvtpk(a, b2); }
                *(u32x4*)(ys + row * 1024 + colb) = (u32x4){res[0], res[1], res[2], res[3]}; }
        }
    }
};

template <class Epi>
__device__ __forceinline__ void sb_block(const BlockRef& cur, char* lds, const Epi& E) {
    const int tid = opaque_tid(), wid = __builtin_amdgcn_readfirstlane(tid >> 6), lane = tid & 63, r32 = lane & 31, hi = lane >> 5;
    char* V_lds = lds; char* K_lds = lds + 2 * SHM_V;
    volatile unsigned* flags = (volatile unsigned*)(lds + 2 * SHM_V + 2 * SHM_K + 4096);
    const int sr = tid >> 4, sc = (tid & 15) * 8, vst0 = v_st(sr, sc), vst1 = vst0 + 8192, kws = KSWZ(sr, sc * 2);
    const unsigned roff0 = (unsigned)(sr * LDP + sc) * 2u, qoff = (unsigned)(r32 * LDP + hi * 8) * 2u;
    const int vb0 = (int)(uintptr_t)V_lds + v_rd_base(lane);
    const int qlo = cur.P0 + wid * QBLK, qpos = qlo + r32;
    const int j_hi = cur.P0 / KVBLK + 4;
    Seam S;
    { const unsigned qs_ = (unsigned)(wid * QBLK) * (LDP * 2u);
#pragma unroll
    for (int d0 = 0; d0 < 8; ++d0) S.qr[d0] = bload8(cur.Q, qoff + d0 * 32, qs_); }
    SLOAD_H(cur.K, cur.V, (j_hi - 1) * KVBLK); VMW(); SWRITE_H(0);
    if (tid < 16) flags[tid] = 0u;
    __syncthreads();
    float carry = 1.f; f32x16 o[4] = {}; bool wdone = false; int buf = 0, par = 0;
    for (int j = j_hi - 1; j >= 0; --j) {
        const int kb = j * KVBLK;
        if (j > 0) { SLOAD_H(cur.K, cur.V, kb - KVBLK); }
        const bool act = (kb < qlo + QBLK - 1) && !wdone;
        if (act) {
            f32x16 p0, p1;
            qkt<0, false>(p0, p1, K_lds + buf * SHM_K, r32, hi, S.qr, true);
            const int dq = qpos - kb - 4 * hi;
            f32x16 f0, f1;
#pragma unroll
            for (int r = 0; r < 16; ++r) {
                const int c = (r & 3) + 8 * (r >> 2);
                const float u0 = __builtin_amdgcn_exp2f(fminf(p0[r] * SCALE, 80.f) * 1.4426950408889634f), u1 = __builtin_amdgcn_exp2f(fminf(p1[r] * SCALE, 80.f) * 1.4426950408889634f);
                const float r0 = __builtin_amdgcn_rcpf(1.0f + u0), r1 = __builtin_amdgcn_rcpf(1.0f + u1);
                const bool s0 = c < dq, s1 = c + 32 < dq;
                f0[r] = s0 ? r0 : 1.f; f1[r] = s1 ? r1 : 1.f;
                p0[r] = s0 ? u0 * r0 : 0.f; p1[r] = s1 ? u1 * r1 : 0.f;
            }
            float T[8];
#pragma unroll
            for (int k = 0; k < 4; ++k) {
                { const float e2 = f0[4 * k + 3], e1 = f0[4 * k + 2] * e2, e0 = f0[4 * k + 1] * e1; T[k] = f0[4 * k] * e0; f0[4 * k + 3] = 1.f; f0[4 * k + 2] = e2; f0[4 * k + 1] = e1; f0[4 * k] = e0; }
                { const float e2 = f1[4 * k + 3], e1 = f1[4 * k + 2] * e2, e0 = f1[4 * k + 1] * e1; T[4 + k] = f1[4 * k] * e0; f1[4 * k + 3] = 1.f; f1[4 * k + 2] = e2; f1[4 * k + 1] = e1; f1[4 * k] = e0; }
            }
            float R = 1.f;
#pragma unroll
            for (int k = 7; k >= 0; --k) {
                auto rr = __builtin_amdgcn_permlane32_swap(__float_as_uint(T[k]), __float_as_uint(T[k]), false, false);
                const float tlo = __uint_as_float(rr[0]), thi = __uint_as_float(rr[1]);
                const float base = carry * R * (hi == 0 ? thi : 1.f);
                if (k < 4) { p0[4 * k] *= f0[4 * k] * base; p0[4 * k + 1] *= f0[4 * k + 1] * base; p0[4 * k + 2] *= f0[4 * k + 2] * base; p0[4 * k + 3] *= base; }
                else { p1[4 * (k - 4)] *= f1[4 * (k - 4)] * base; p1[4 * (k - 4) + 1] *= f1[4 * (k - 4) + 1] * base; p1[4 * (k - 4) + 2] *= f1[4 * (k - 4) + 2] * base; p1[4 * (k - 4) + 3] *= base; }
                R *= tlo * thi;
            }
            carry *= R;
            bf16x8 pa0, pa1, pa2, pa3;
#define PK4(P, B_, OUT) do { unsigned a0 = cvtpk(P[B_+0], P[B_+1]), a1 = cvtpk(P[B_+2], P[B_+3]);                          \
        unsigned b0 = cvtpk(P[B_+4], P[B_+5]), b1 = cvtpk(P[B_+6], P[B_+7]);                                             \
        auto r0 = __builtin_amdgcn_permlane32_swap(a0, b0, false, false); auto r1 = __builtin_amdgcn_permlane32_swap(a1, b1, false, false); \
        u32x4 w = {r0[0], r1[0], r0[1], r1[1]}; OUT = *reinterpret_cast<bf16x8*>(&w); } while (0)
            PK4(p0, 0, pa0); PK4(p0, 8, pa1); PK4(p1, 0, pa2); PK4(p1, 8, pa3);
            pv_tile<0, false>(o, vb0 + buf * SHM_V, pa0, pa1, pa2, pa3, true);
            if (__all(carry == 0.f)) wdone = true;
        }
        if (lane == 0) flags[par * 8 + wid] = wdone ? 1u : 0u;
        if (j > 0) { VMW(); if (buf == 0) { SWRITE_H(1); } else { SWRITE_H(0); } }
        __syncthreads();
        unsigned alld = 1u;
#pragma unroll
        for (int w = 0; w < 8; ++w) alld &= flags[par * 8 + w];
        if (alld) break;
        buf ^= 1; par ^= 1;
    }
    float rli[16];
#pragma unroll
    for (int r = 0; r < 16; ++r) rli[r] = 1.f;
    E(o, rli, cur, wid, r32, hi);
    __syncthreads();
}
struct EpiSb {
    const bf16* __restrict__ proj; bf16* __restrict__ ys; char* lds;
    __device__ __forceinline__ void put(const f32x16 (&o)[4], int row_w, int col0, char* scr, int r32, int hi) const {
        int lane = hi * 32 + r32; asm volatile("" : "+v"(lane));
        float one[16];
#pragma unroll
        for (int r = 0; r < 16; ++r) one[r] = 1.f;
        ost_put(scr, o, one, r32, hi);
        const int rowb = row_w + (lane >> 4), colb = col0 + (lane & 15) * 8;
        u32x4 zz[8];
#pragma unroll
        for (int q = 0; q < 8; ++q) zz[q] = *(const u32x4*)(proj + (size_t)(rowb + q * 4) * LDP + C_SZ + colb);
        asm volatile("" ::: "memory");
#pragma unroll
        for (int q = 0; q < 8; ++q) { const u32x4 os = ost_get(scr, q, lane);
            const unsigned zw[4] = {zz[q].x, zz[q].y, zz[q].z, zz[q].w}, osw[4] = {os.x, os.y, os.z, os.w}; unsigned res[4];
#pragma unroll
            for (int j = 0; j < 4; ++j) res[j] = cvtpk(lo_bf(osw[j]) * siluf_(lo_bf(zw[j])), hi_bf(osw[j]) * siluf_(hi_bf(zw[j])));
            *(u32x4*)(ys + (size_t)(rowb + q * 4) * 1024 + colb) = (u32x4){res[0], res[1], res[2], res[3]}; }
    }
    __device__ __forceinline__ void operator()(const f32x16 (&o)[4], const float (&rli)[16], const BlockRef& cur, int wid, int r32, int hi) const {
        put(o, cur.row0 + wid * QBLK, cur.aux, lds + OST_BASE + wid * OST_WAVE, r32, hi);
    }
};

__device__ __forceinline__ void glds16(const void* gsrc, char* lds_dst) {
    __builtin_amdgcn_global_load_lds((const unsigned*)gsrc, (__attribute__((address_space(3))) unsigned*)lds_dst, 16, 0, 0);
}

__device__ __forceinline__ void pv_tile256(f32x16* o, int vbA, int vbB, bf16x8 pa0, bf16x8 pa1, bf16x8 pa2, bf16x8 pa3) {
#define TRR(dst, base, off) asm volatile("ds_read_b64_tr_b16 %0, %1 offset:%2" : "=&v"(dst) : "v"(base), "i"(off) : "memory")
#define PV_LOAD(S, base, d0) do { constexpr int b_ = v_rd_off(d0, 0, 0); \
        TRR(S[0], base, b_); TRR(S[1], base, b_ + 2048); TRR(S[2], base, b_ + 4096); TRR(S[3], base, b_ + 6144); TRR(S[4], base, b_ + 8192); TRR(S[5], base, b_ + 10240); TRR(S[6], base, b_ + 12288); TRR(S[7], base, b_ + 14336); } while (0)
#define PV_MMA(S, acc) do { \
        acc = __builtin_amdgcn_mfma_f32_32x32x16_bf16(pa0, (bf16x8){S[0][0], S[0][1], S[0][2], S[0][3], S[1][0], S[1][1], S[1][2], S[1][3]}, acc, 0, 0, 0); \
        acc = __builtin_amdgcn_mfma_f32_32x32x16_bf16(pa1, (bf16x8){S[2][0], S[2][1], S[2][2], S[2][3], S[3][0], S[3][1], S[3][2], S[3][3]}, acc, 0, 0, 0); \
        acc = __builtin_amdgcn_mfma_f32_32x32x16_bf16(pa2, (bf16x8){S[4][0], S[4][1], S[4][2], S[4][3], S[5][0], S[5][1], S[5][2], S[5][3]}, acc, 0, 0, 0); \
        acc = __builtin_amdgcn_mfma_f32_32x32x16_bf16(pa3, (bf16x8){S[6][0], S[6][1], S[6][2], S[6][3], S[7][0], S[7][1], S[7][2], S[7][3]}, acc, 0, 0, 0); } while (0)
#define PV_W8() do { asm volatile("s_waitcnt lgkmcnt(8)" ::: "memory"); SBAR(); } while (0)
    s16x4 X[8], Y[8];
    asm volatile("s_waitcnt lgkmcnt(0)" ::: "memory");
    PV_LOAD(X, vbA, 0);
    PV_LOAD(Y, vbA, 1); PV_W8(); PV_MMA(X, o[0]);
    PV_LOAD(X, vbA, 2); PV_W8(); PV_MMA(Y, o[1]);
    PV_LOAD(Y, vbA, 3); PV_W8(); PV_MMA(X, o[2]);
    PV_LOAD(X, vbB, 0); PV_W8(); PV_MMA(Y, o[3]);
    PV_LOAD(Y, vbB, 1); PV_W8(); PV_MMA(X, o[4]);
    PV_LOAD(X, vbB, 2); PV_W8(); PV_MMA(Y, o[5]);
    PV_LOAD(Y, vbB, 3); PV_W8(); PV_MMA(X, o[6]);
    asm volatile("s_waitcnt lgkmcnt(0)" ::: "memory"); SBAR(); PV_MMA(Y, o[7]);
#undef TRR
#undef PV_LOAD
#undef PV_MMA
#undef PV_W8
}
__device__ __forceinline__ void diff_block(const BlockRef& cur, bf16* __restrict__ O, char* lds) {
    const int tid = opaque_tid(), wid = __builtin_amdgcn_readfirstlane(tid >> 6), lane = tid & 63, r32 = lane & 31, hi = lane >> 5;
    char* V_lds = lds; char* K_lds = lds + 4 * SHM_V;
    float* ws = (float*)(lds + 4 * SHM_V + 2 * SHM_K) + wid * 64; float* li_l = ws, * al_l = ws + 32;
    const int vb0 = (int)(uintptr_t)V_lds + v_rd_base(lane);
    const int qlo = cur.P0 + wid * QBLK, qm = qlo + r32 - 4 * hi;
    const int NT = cur.P0 / KVBLK + 4;
    unsigned koff[2], voff[2];
#pragma unroll
    for (int i = 0; i < 2; ++i) {
        const int q = i * 8 + wid;
        { const int row = q * 4 + (lane >> 4), ch = (lane & 15) ^ (row & 7); koff[i] = (unsigned)(row * LDP * 2 + ch * 16); }
        { const int sub = q * 2 + (lane >> 5), kk = (sub >> 2) * 8 + ((lane & 31) >> 2), c = (sub & 3) * 32 + (lane & 3) * 8;
          const int k = (kk & ~0xC) | ((kk & 4) << 1) | ((kk & 8) >> 1); voff[i] = (unsigned)(k * LDP * 2 + c * 2); }
    }
#define DIFF_STAGE(t_, b_) do { const char* kq_ = (const char*)cur.K + (size_t)(t_) * KVBLK * (LDP * 2); const char* vq_ = (const char*)cur.V + (size_t)(t_) * KVBLK * (LDP * 2); \
        _Pragma("unroll") for (int i_ = 0; i_ < 2; ++i_) { \
            glds16(kq_ + koff[i_], K_lds + (b_) * SHM_K + (i_ * 8 + wid) * 1024); \
            glds16(vq_ + voff[i_], V_lds + ((b_) * 2) * SHM_V + (i_ * 8 + wid) * 1024); \
            glds16(vq_ + 256 + voff[i_], V_lds + ((b_) * 2 + 1) * SHM_V + (i_ * 8 + wid) * 1024); } } while (0)
    bf16x8 qr[8];
    { const unsigned qoff = (unsigned)(r32 * LDP + hi * 8) * 2u, qs_ = (unsigned)(wid * QBLK) * (LDP * 2u);
#pragma unroll
      for (int d0 = 0; d0 < 8; ++d0) qr[d0] = bload8(cur.Q, qoff + d0 * 32, qs_); }
    DIFF_STAGE(0, 0);
    asm volatile("s_waitcnt vmcnt(0)" ::: "memory");
    __syncthreads();
    float m_reg = -1e30f, l_reg = 0.f; f32x16 o[8] = {};
    int buf = 0;
    for (int t = 0; t < NT; ++t) {
        const int kb = t * KVBLK;
        if (t + 1 < NT) { if (buf == 0) DIFF_STAGE(t + 1, 1); else DIFF_STAGE(t + 1, 0); }
        if (kb <= qlo + QBLK - 1) {
            f32x16 p0, p1; float mn, alpha; bf16x8 pa0, pa1, pa2, pa3;
            qkt<0, false>(p0, p1, K_lds + buf * SHM_K, r32, hi, qr, true);
            if (kb + KVBLK - 1 > qlo) mask_tile(p0, p1, qm - kb, 1u << 30);
            partialSM(p0, p1, m_reg, mn, alpha);
            finishSM(p0, p1, alpha, l_reg, pa0, pa1, pa2, pa3);
            if (__any(alpha < 1.f)) { if (hi == 0) al_l[r32] = alpha; asm volatile("s_waitcnt lgkmcnt(0)" ::: "memory");
#pragma unroll
                for (int d_ = 0; d_ < 8; ++d_)
#pragma unroll
                    for (int r = 0; r < 16; ++r) o[d_][r] *= al_l[crow(r, hi)]; }
            pv_tile256(o, vb0 + (buf * 2) * SHM_V, vb0 + (buf * 2 + 1) * SHM_V, pa0, pa1, pa2, pa3);
        }
        asm volatile("s_waitcnt vmcnt(0)" ::: "memory");
        __syncthreads();
        buf ^= 1;
    }
#undef DIFF_STAGE
    if (hi == 0) li_l[r32] = l_reg; asm volatile("s_waitcnt lgkmcnt(0)" ::: "memory");
    float rl[16];
#pragma unroll
    for (int r = 0; r < 16; ++r) rl[r] = __builtin_amdgcn_rcpf(li_l[crow(r, hi)]);
    char* scr = lds + wid * OST_WAVE;
    char* Ow = (char*)(O + (size_t)(cur.row0 + wid * QBLK) * 1024 + cur.aux);
    const unsigned loff = (unsigned)((lane >> 4) * 1024 + (lane & 15) * 8) * 2u;
#pragma unroll
    for (int h = 0; h < 2; ++h) {
        ost_put(scr, o + 4 * h, rl, r32, hi);
#pragma unroll
        for (int q = 0; q < 8; ++q) *(u32x4*)(Ow + (size_t)(q * 4 * 1024 + h * 128) * 2 + loff) = ost_get(scr, q, lane);
    }
    __syncthreads();
}

struct SbPairRef { const bf16* Q; const bf16* K; const bf16* V; int P0; int row0; int aux; };
__device__ __forceinline__ void sb_pair(const SbPairRef& pr, char* lds, const EpiSb& E) {
    const int tid = opaque_tid(), wid = __builtin_amdgcn_readfirstlane(tid >> 6), lane = tid & 63, r32 = lane & 31, hi = lane >> 5;
    const int hs = wid >> 2, w4 = wid & 3;
    char* V_lds = lds; char* K_lds = lds + 4 * SHM_V;
    volatile unsigned* flags = (volatile unsigned*)(lds + LDS_AUX + 4096);
    const int vb0 = (int)(uintptr_t)V_lds + v_rd_base(lane);
    const int qlo = pr.P0 + w4 * QBLK, qpos = qlo + r32;
    const int j_hi = pr.P0 / KVBLK + 2;
    unsigned koff[2], voff[2];
#pragma unroll
    for (int i = 0; i < 2; ++i) {
        const int q = i * 8 + wid;
        { const int row = q * 4 + (lane >> 4), ch = (lane & 15) ^ (row & 7); koff[i] = (unsigned)(row * LDP * 2 + ch * 16); }
        { const int sub = q * 2 + (lane >> 5), kk = (sub >> 2) * 8 + ((lane & 31) >> 2), c = (sub & 3) * 32 + (lane & 3) * 8;
          const int k = (kk & ~0xC) | ((kk & 4) << 1) | ((kk & 8) >> 1); voff[i] = (unsigned)(k * LDP * 2 + c * 2); }
    }
#define SBP_STAGE(t_, b_) do { const char* kq_ = (const char*)pr.K + (size_t)(t_) * KVBLK * (LDP * 2); const char* vq_ = (const char*)pr.V + (size_t)(t_) * KVBLK * (LDP * 2); \
        _Pragma("unroll") for (int i_ = 0; i_ < 2; ++i_) { \
            glds16(kq_ + koff[i_], K_lds + ((b_) * 2) * SHM_K + (i_ * 8 + wid) * 1024); glds16(kq_ + 256 + koff[i_], K_lds + ((b_) * 2 + 1) * SHM_K + (i_ * 8 + wid) * 1024); \
            glds16(vq_ + voff[i_], V_lds + ((b_) * 2) * SHM_V + (i_ * 8 + wid) * 1024); glds16(vq_ + 256 + voff[i_], V_lds + ((b_) * 2 + 1) * SHM_V + (i_ * 8 + wid) * 1024); } } while (0)
    bf16x8 qr[8];
    { const unsigned qoff = (unsigned)(r32 * LDP + hi * 8) * 2u + (unsigned)hs * 256u, qs_ = (unsigned)(w4 * QBLK) * (LDP * 2u);
#pragma unroll
      for (int d0 = 0; d0 < 8; ++d0) qr[d0] = bload8(pr.Q, qoff + d0 * 32, qs_); }
    SBP_STAGE(j_hi - 1, 0);
    if (tid < 16) flags[tid] = 0u;
    asm volatile("s_waitcnt vmcnt(0)" ::: "memory");
    __syncthreads();
    float carry = 1.f; f32x16 o[4] = {}; bool wdone = false; int buf = 0, par = 0;
    for (int j = j_hi - 1; j >= 0; --j) {
        const int kb = j * KVBLK;
        if (j > 0) { if (buf == 0) SBP_STAGE(j - 1, 1); else SBP_STAGE(j - 1, 0); }
        const bool act = (kb < qlo + QBLK - 1) && !wdone;
        if (act) {
            f32x16 p0, p1;
            qkt<0, false>(p0, p1, K_lds + (buf * 2 + hs) * SHM_K, r32, hi, qr, true);
            const int dq = qpos - kb - 4 * hi;
            f32x16 f0, f1;
            constexpr float CS = SCALE * 1.4426950408889634f, CCL = 80.f * 1.4426950408889634f;
            if (kb + KVBLK - 1 >= qlo) {
#pragma unroll
                for (int r = 0; r < 16; ++r) {
                    const int c = (r & 3) + 8 * (r >> 2);
                    const float u0 = __builtin_amdgcn_exp2f(fminf(p0[r] * CS, CCL)), u1 = __builtin_amdgcn_exp2f(fminf(p1[r] * CS, CCL));
                    const float r0 = __builtin_amdgcn_rcpf(1.0f + u0), r1 = __builtin_amdgcn_rcpf(1.0f + u1);
                    const bool s0 = c < dq, s1 = c + 32 < dq;
                    f0[r] = s0 ? r0 : 1.f; f1[r] = s1 ? r1 : 1.f;
                    p0[r] = s0 ? u0 : 0.f; p1[r] = s1 ? u1 : 0.f;
                }
            } else {
#pragma unroll
                for (int r = 0; r < 16; ++r) {
                    const float u0 = __builtin_amdgcn_exp2f(fminf(p0[r] * CS, CCL)), u1 = __builtin_amdgcn_exp2f(fminf(p1[r] * CS, CCL));
                    f0[r] = __builtin_amdgcn_rcpf(1.0f + u0); f1[r] = __builtin_amdgcn_rcpf(1.0f + u1);
                    p0[r] = u0; p1[r] = u1;
                }
            }
            float T[8];
#pragma unroll
            for (int k = 0; k < 4; ++k) {
                { const float e3 = f0[4 * k + 3], e2 = f0[4 * k + 2] * e3, e1 = f0[4 * k + 1] * e2, e0 = f0[4 * k] * e1; T[k] = e0; f0[4 * k + 2] = e2; f0[4 * k + 1] = e1; f0[4 * k] = e0; }
                { const float e3 = f1[4 * k + 3], e2 = f1[4 * k + 2] * e3, e1 = f1[4 * k + 1] * e2, e0 = f1[4 * k] * e1; T[4 + k] = e0; f1[4 * k + 2] = e2; f1[4 * k + 1] = e1; f1[4 * k] = e0; }
            }
            float R = 1.f;
#pragma unroll
            for (int k = 7; k >= 0; --k) {
                auto rr = __builtin_amdgcn_permlane32_swap(__float_as_uint(T[k]), __float_as_uint(T[k]), false, false);
                const float tlo = __uint_as_float(rr[0]), thi = __uint_as_float(rr[1]);
                const float base = carry * R * (hi == 0 ? thi : 1.f);
                if (k < 4) { p0[4 * k] *= f0[4 * k] * base; p0[4 * k + 1] *= f0[4 * k + 1] * base; p0[4 * k + 2] *= f0[4 * k + 2] * base; p0[4 * k + 3] *= f0[4 * k + 3] * base; }
                else { p1[4 * (k - 4)] *= f1[4 * (k - 4)] * base; p1[4 * (k - 4) + 1] *= f1[4 * (k - 4) + 1] * base; p1[4 * (k - 4) + 2] *= f1[4 * (k - 4) + 2] * base; p1[4 * (k - 4) + 3] *= f1[4 * (k - 4) + 3] * base; }
                R *= tlo * thi;
            }
            carry *= R;
            bf16x8 pa0, pa1, pa2, pa3;
            PK4(p0, 0, pa0); PK4(p0, 8, pa1); PK4(p1, 0, pa2); PK4(p1, 8, pa3);
            pv_tile<0, false>(o, vb0 + (buf * 2 + hs) * SHM_V, pa0, pa1, pa2, pa3, true);
            if (__all(carry == 0.f)) wdone = true;
        }
        if (lane == 0) flags[par * 8 + wid] = wdone ? 1u : 0u;
        asm volatile("s_waitcnt vmcnt(0)" ::: "memory");
        __syncthreads();
        unsigned alld = 1u;
#pragma unroll
        for (int w = 0; w < 8; ++w) alld &= flags[par * 8 + w];
        if (alld) break;
        buf ^= 1; par ^= 1;
    }
#undef SBP_STAGE
    E.put(o, pr.row0 + w4 * QBLK, pr.aux + hs * 128, lds + wid * OST_WAVE, r32, hi);
    __syncthreads();
}

__device__ __forceinline__ void pv_tile128p(f32x16* o, int vb, bf16x8 pa0, bf16x8 pa1, bf16x8 pa2, bf16x8 pa3) {
#define TRR(dst, base, off) asm volatile("ds_read_b64_tr_b16 %0, %1 offset:%2" : "=&v"(dst) : "v"(base), "i"(off) : "memory")
#define PV_LOAD(S, base, d0) do { constexpr int b_ = v_rd_off(d0, 0, 0); \
        TRR(S[0], base, b_); TRR(S[1], base, b_ + 2048); TRR(S[2], base, b_ + 4096); TRR(S[3], base, b_ + 6144); TRR(S[4], base, b_ + 8192); TRR(S[5], base, b_ + 10240); TRR(S[6], base, b_ + 12288); TRR(S[7], base, b_ + 14336); } while (0)
#define PV_MMA(S, acc) do { \
        acc = __builtin_amdgcn_mfma_f32_32x32x16_bf16(pa0, (bf16x8){S[0][0], S[0][1], S[0][2], S[0][3], S[1][0], S[1][1], S[1][2], S[1][3]}, acc, 0, 0, 0); \
        acc = __builtin_amdgcn_mfma_f32_32x32x16_bf16(pa1, (bf16x8){S[2][0], S[2][1], S[2][2], S[2][3], S[3][0], S[3][1], S[3][2], S[3][3]}, acc, 0, 0, 0); \
        acc = __builtin_amdgcn_mfma_f32_32x32x16_bf16(pa2, (bf16x8){S[4][0], S[4][1], S[4][2], S[4][3], S[5][0], S[5][1], S[5][2], S[5][3]}, acc, 0, 0, 0); \
        acc = __builtin_amdgcn_mfma_f32_32x32x16_bf16(pa3, (bf16x8){S[6][0], S[6][1], S[6][2], S[6][3], S[7][0], S[7][1], S[7][2], S[7][3]}, acc, 0, 0, 0); } while (0)
#define PV_W8() do { asm volatile("s_waitcnt lgkmcnt(8)" ::: "memory"); SBAR(); } while (0)
    s16x4 X[8], Y[8];
    asm volatile("s_waitcnt lgkmcnt(0)" ::: "memory");
    PV_LOAD(X, vb, 0);
    PV_LOAD(Y, vb, 1); PV_W8(); PV_MMA(X, o[0]);
    PV_LOAD(X, vb, 2); PV_W8(); PV_MMA(Y, o[1]);
    PV_LOAD(Y, vb, 3); PV_W8(); PV_MMA(X, o[2]);
    asm volatile("s_waitcnt lgkmcnt(0)" ::: "memory"); SBAR(); PV_MMA(Y, o[3]);
#undef TRR
#undef PV_LOAD
#undef PV_MMA
#undef PV_W8
}
template <bool SLC, int W, int HM, class Epi>
__device__ __forceinline__ void attn_simple(const BlockRef& cur, char* lds, const Epi& E) {
    const int tid = opaque_tid(), wid = __builtin_amdgcn_readfirstlane(tid >> 6), lane = tid & 63, r32 = lane & 31, hi = lane >> 5;
    char* V_lds = lds; char* K_lds = lds + 2 * SHM_V;
    float* ws = (float*)(lds + 2 * SHM_V + 2 * SHM_K) + wid * 64; float* li_l = ws, * al_l = ws + 32;
    const int vb0 = (int)(uintptr_t)V_lds + v_rd_base(lane);
    constexpr int RW = 8 / HM; const int wsub = wid & (RW - 1), hl = wid / RW;
    const int qlo = cur.P0 + wsub * QBLK, qm = qlo + r32 - 4 * hi;
    const int j_lo = swa_jlo(cur.P0, W), NT = cur.P0 / KVBLK + RW * QBLK / KVBLK - j_lo;
    unsigned koff[2], voff[2];
#pragma unroll
    for (int i = 0; i < 2; ++i) {
        const int q = i * 8 + wid;
        { const int row = q * 4 + (lane >> 4), ch = (lane & 15) ^ (row & 7); koff[i] = (unsigned)(row * LDP * 2 + ch * 16); }
        { const int sub = q * 2 + (lane >> 5), kk = (sub >> 2) * 8 + ((lane & 31) >> 2), c = (sub & 3) * 32 + (lane & 3) * 8;
          const int k = (kk & ~0xC) | ((kk & 4) << 1) | ((kk & 8) >> 1); voff[i] = (unsigned)(k * LDP * 2 + c * 2); }
    }
#define AS_STAGE(t_, b_) do { const char* kq_ = (const char*)cur.K + (size_t)(j_lo + (t_)) * KVBLK * (LDP * 2); const char* vq_ = (const char*)cur.V + (size_t)(j_lo + (t_)) * KVBLK * (LDP * 2); \
        _Pragma("unroll") for (int i_ = 0; i_ < 2; ++i_) { \
            glds16(kq_ + koff[i_], K_lds + (b_) * SHM_K + (i_ * 8 + wid) * 1024); glds16(vq_ + voff[i_], V_lds + (b_) * SHM_V + (i_ * 8 + wid) * 1024); } } while (0)
    bf16x8 qr[8];
    { const unsigned qoff = (unsigned)(r32 * LDP + hi * 8) * 2u, qs_ = (unsigned)(wsub * QBLK) * (LDP * 2u) + (unsigned)hl * 256u;
#pragma unroll
      for (int d0 = 0; d0 < 8; ++d0) qr[d0] = bload8(cur.Q, qoff + d0 * 32, qs_); }
    u64 rowmask = ~0ull; if constexpr (SLC) rowmask = cur.M[cur.P0 + wsub * QBLK + r32];
    AS_STAGE(0, 0);
    asm volatile("s_waitcnt vmcnt(0)" ::: "memory");
    __syncthreads();
    float m_reg = -1e30f, l_reg = 0.f; f32x16 o[4] = {};
    int buf = 0;
    for (int t = 0; t < NT; ++t) {
        const int kb = (j_lo + t) * KVBLK;
        if (t + 1 < NT) { if (buf == 0) AS_STAGE(t + 1, 1); else AS_STAGE(t + 1, 0); }
        if (kb <= qlo + QBLK - 1 && kb + KVBLK - 1 >= qlo - W + 1) {
            f32x16 p0, p1; float mn, alpha; bf16x8 pa0, pa1, pa2, pa3;
            qkt<0, false>(p0, p1, K_lds + buf * SHM_K, r32, hi, qr, true);
            if (kb + KVBLK - 1 > qlo || kb <= qlo + QBLK - 1 - W) mask_tile(p0, p1, qm - kb, (unsigned)W);
            if constexpr (SLC) partialSM_sel(p0, p1, m_reg, mn, alpha, ((rowmask >> (j_lo + t)) & 1ull) != 0ull); else partialSM(p0, p1, m_reg, mn, alpha);
            finishSM(p0, p1, alpha, l_reg, pa0, pa1, pa2, pa3);
            if (__any(alpha < 1.f)) { if (hi == 0) al_l[r32] = alpha; asm volatile("s_waitcnt lgkmcnt(0)" ::: "memory");
#pragma unroll
                for (int d_ = 0; d_ < 4; ++d_)
#pragma unroll
                    for (int r = 0; r < 16; ++r) o[d_][r] *= al_l[crow(r, hi)]; }
            pv_tile128p(o, vb0 + buf * SHM_V, pa0, pa1, pa2, pa3);
        }
        asm volatile("s_waitcnt vmcnt(0)" ::: "memory");
        __syncthreads();
        buf ^= 1;
    }
#undef AS_STAGE
    if (hi == 0) li_l[r32] = l_reg; asm volatile("s_waitcnt lgkmcnt(0)" ::: "memory");
    float rli[16];
#pragma unroll
    for (int r = 0; r < 16; ++r) rli[r] = __builtin_amdgcn_rcpf(li_l[crow(r, hi)]);
    if constexpr (HM == 1) E(o, rli, cur, wid, r32, hi);
    else { BlockRef cw = cur; cw.row0 = cur.row0 + (wsub - wid) * QBLK; cw.aux = cur.aux + hl * 128; cw.aux2 = cur.aux2 + hl; E(o, rli, cw, wid, r32, hi); }
    __syncthreads();
}

__device__ __forceinline__ float quad_sum(float x) {
    x += __int_as_float(__builtin_amdgcn_update_dpp(0, __float_as_int(x), 0xB1, 0xF, 0xF, true));
    x += __int_as_float(__builtin_amdgcn_update_dpp(0, __float_as_int(x), 0x4E, 0xF, 0xF, true));
    return x;
}
__device__ __forceinline__ void cmp_unit(const bf16* __restrict__ proj, bf16* __restrict__ ocmp, u64* __restrict__ selm, int bg, int tb, char* lds) {
    const int tid = opaque_tid(), wid = __builtin_amdgcn_readfirstlane(tid >> 6), lane = tid & 63, r32 = lane & 31, hi = lane >> 5;
    const int b = bg >> 1, g = bg & 1, tok0 = tb * 64;
    const int n_max = (tok0 + 32) >> 4;
    const int ntile = (n_max >> 6) + 1;
    char* K_lds = lds; char* V_lds = lds + 4 * SHM_K;
    float* impT = (float*)(lds + LDS_AUX);
    const int tokl = wid * 8 + (r32 >> 2), tpos = tok0 + tokl, head = g * 4 + (r32 & 3);
    bf16x8 qr[8];
    { const bf16* qp = proj + (size_t)(b * SEQ + tpos) * LDP + C_NQ + head * 128 + hi * 8;
#pragma unroll
      for (int d0 = 0; d0 < 8; ++d0) qr[d0] = ld8(qp + d0 * 16); }
    const int nlim = (tpos - 31) >> 4;
    const int vb0 = (int)(uintptr_t)V_lds + v_rd_base(lane);
    constexpr float C2 = 1.4426950408889634f * SCALE;
    float mx = -1e30f, lsum = 0.f;
    for (int t = 0; t < ntile; ++t) {
        f32x16 p0, p1; qkt<0, false>(p0, p1, K_lds + t * SHM_K, r32, hi, qr, true);
        const int nb = t * 64 + 4 * hi; float tm = -1e30f;
#pragma unroll
        for (int r = 0; r < 16; ++r) { const int c = (r & 3) + 8 * (r >> 2);
            if (nb + c <= nlim) tm = fmaxf(tm, p0[r]); if (nb + c + 32 <= nlim) tm = fmaxf(tm, p1[r]); }
        tm = fmaxf(tm, other_half(tm));
        const float mn = fmaxf(mx, tm), mLn = -mn * C2; float ps = 0.f;
#pragma unroll
        for (int r = 0; r < 16; ++r) { const int c = (r & 3) + 8 * (r >> 2);
            const float e0 = __builtin_amdgcn_exp2f(fmaf(p0[r], C2, mLn)), e1 = __builtin_amdgcn_exp2f(fmaf(p1[r], C2, mLn));
            ps += ((nb + c <= nlim) ? e0 : 0.f) + ((nb + c + 32 <= nlim) ? e1 : 0.f); }
        lsum = lsum * __builtin_amdgcn_exp2f((mx - mn) * C2) + ps; mx = mn;
    }
    lsum += other_half(lsum);
    const float inv_l = lsum > 0.f ? 1.0f / lsum : 0.f;
    f32x16 o[4] = {}; float prev_hi_last = 0.f;
    const float mL = -mx * C2;
    for (int t = 0; t < 4; ++t) {
        if (t < ntile) {
            f32x16 p0, p1; qkt<0, false>(p0, p1, K_lds + t * SHM_K, r32, hi, qr, true);
            const int nb = t * 64 + 4 * hi;
#pragma unroll
            for (int r = 0; r < 16; ++r) { const int c = (r & 3) + 8 * (r >> 2);
                const float e0 = __builtin_amdgcn_exp2f(fmaf(p0[r], C2, mL)) * inv_l, e1 = __builtin_amdgcn_exp2f(fmaf(p1[r], C2, mL)) * inv_l;
                p0[r] = (nb + c <= nlim) ? e0 : 0.f; p1[r] = (nb + c + 32 <= nlim) ? e1 : 0.f; }
#pragma unroll
            for (int k = 0; k < 8; ++k) {
                const float gs = (k < 4) ? (p0[4 * k] + p0[4 * k + 1]) + (p0[4 * k + 2] + p0[4 * k + 3]) : (p1[4 * (k - 4)] + p1[4 * (k - 4) + 1]) + (p1[4 * (k - 4) + 2] + p1[4 * (k - 4) + 3]);
                const float last = (k < 4) ? p0[4 * k + 3] : p1[4 * (k - 4) + 3];
                auto rr = __builtin_amdgcn_permlane32_swap(__float_as_uint(last), __float_as_uint(last), false, false);
                const float llo = __uint_as_float(rr[0]), lhi = __uint_as_float(rr[1]);
                float v = gs + (hi ? llo : prev_hi_last);
                prev_hi_last = lhi;
                v = quad_sum(v);
                if ((r32 & 3) == (k >> 1)) impT[tokl * 64 + t * 16 + 2 * k + hi] = v;
            }
            bf16x8 pa0, pa1, pa2, pa3;
            PK4(p0, 0, pa0); PK4(p0, 8, pa1); PK4(p1, 0, pa2); PK4(p1, 8, pa3);
            pv_tile<0, false>(o, vb0 + t * SHM_V, pa0, pa1, pa2, pa3, true);
        } else {
#pragma unroll
            for (int k = 0; k < 8; ++k) if ((r32 & 3) == (k >> 1)) impT[tokl * 64 + t * 16 + 2 * k + hi] = 0.f;
        }
    }
    {
        const size_t rowb = (size_t)(b * SEQ + tok0 + wid * 8);
#pragma unroll
        for (int r = 0; r < 16; ++r) { const int cr = crow(r, hi);
            bf16* op = ocmp + (rowb + (cr >> 2)) * 1024 + (g * 4 + (cr & 3)) * 128;
#pragma unroll
            for (int d0 = 0; d0 < 4; ++d0) { const float v = o[d0][r]; const float vn = __int_as_float(__builtin_amdgcn_update_dpp(0, __float_as_int(v), 0xB1, 0xF, 0xF, true));
                if ((r32 & 1) == 0) *(unsigned*)(op + d0 * 32 + r32) = cvtpk(v, vn); } }
    }
    asm volatile("s_waitcnt lgkmcnt(0)" ::: "memory");
#pragma unroll 1
    for (int tk = 0; tk < 8; ++tk) {
        const float v = impT[(wid * 8 + tk) * 64 + lane];
        unsigned key = (__float_as_uint(v) & ~63u) | (63u - (unsigned)lane);
        if (lane == tb || lane == 0) key = 0xFFFFFFC0u | (63u - (unsigned)lane);
        const bool valid = lane <= tb;
        if (!valid) key = 0u;
        unsigned T = 0u;
#pragma unroll
        for (int bit = 31; bit >= 0; --bit) { const unsigned Tt = T | (1u << bit); if (__popcll(__ballot(key >= Tt)) >= 16) T = Tt; }
        const u64 m = __ballot(valid && key >= T);
        if (lane == 0) selm[(size_t)bg * SEQ + tok0 + wid * 8 + tk] = m;
    }
}
__device__ __forceinline__ void cmp_pair(const bf16* __restrict__ proj, const bf16* __restrict__ kcmp, const bf16* __restrict__ vcmp, bf16* __restrict__ ocmp, u64* __restrict__ selm, int pair, char* lds) {
    const int tid = opaque_tid();
    const int bg = pair >> 5, p = pair & 31, tb_hi = 63 - p, tb_lo = p;
    const int ntile = (((tb_hi * 64 + 32) >> 4) >> 6) + 1;
    char* K_lds = lds; char* V_lds = lds + 4 * SHM_K;
    const int sr = tid >> 4, sc = (tid & 15) * 8, kws = KSWZ(sr, sc * 2), vst0 = v_st(sr, sc), vst1 = vst0 + 8192;
    bf16x8 kr[4][2], vr[4][2];
#pragma unroll
    for (int t = 0; t < 4; ++t) if (t < ntile) {
        const bf16* kp = kcmp + ((size_t)bg * 256 + t * 64) * 128 + sc; const bf16* vp = vcmp + ((size_t)bg * 256 + t * 64) * 128 + sc;
        kr[t][0] = ld8(kp + sr * 128); kr[t][1] = ld8(kp + (32 + sr) * 128); vr[t][0] = ld8(vp + sr * 128); vr[t][1] = ld8(vp + (32 + sr) * 128); }
#pragma unroll
    for (int t = 0; t < 4; ++t) if (t < ntile) {
        *(bf16x8*)(K_lds + t * SHM_K + kws) = kr[t][0]; *(bf16x8*)(K_lds + t * SHM_K + kws + 32 * 256) = kr[t][1];
        *(bf16x8*)(V_lds + t * SHM_V + vst0) = vr[t][0]; *(bf16x8*)(V_lds + t * SHM_V + vst1) = vr[t][1]; }
    __syncthreads();
    cmp_unit(proj, ocmp, selm, bg, tb_hi, lds);
    cmp_unit(proj, ocmp, selm, bg, tb_lo, lds);
    __syncthreads();
}

__device__ __forceinline__ void compress_item(const bf16* __restrict__ proj, const float* __restrict__ pe, const bf16* __restrict__ w1t, const bf16* __restrict__ w2t, bf16* __restrict__ outc, int kv, int bg, int nt, char* lds) {
    const int tid = opaque_tid(), wid = __builtin_amdgcn_readfirstlane(tid >> 6), lane = tid & 63, r32 = lane & 31, hi = lane >> 5;
    const int b = bg >> 1, g = bg & 1, n0 = nt * 32, jb = wid & 3, kh = wid >> 2;
    char* W_lds = lds; char* A_lds = lds + 98304; float* part = (float*)lds; bf16* hid = (bf16*)(lds + 40960); float* peT = (float*)(lds + LDS_AUX);
    unsigned woff[4];
#pragma unroll
    for (int i = 0; i < 4; ++i) { const int j = (i * 8 + wid) * 4 + (lane >> 4), ch = (lane & 15) ^ (j & 7); woff[i] = (unsigned)(j * 4096 * 2 + ch * 16); }
    unsigned aoff_;
    { const int nl = wid * 4 + (lane >> 4); int n = n0 + nl; if (n > 254) n = 254; const int ch = (lane & 15) ^ (nl & 7);
      aoff_ = (unsigned)((16 * n) * LDP * 2 + ch * 16); }
    const char* xbase = (const char*)(proj + (size_t)b * SEQ * LDP + (kv ? C_NVC : C_NKC) + g * 128);
#define CMP_STAGE(l_, bf_) do { \
        _Pragma("unroll") for (int i_ = 0; i_ < 4; ++i_) glds16((const char*)w1t + (size_t)(l_) * 256 + woff[i_], W_lds + (bf_) * 32768 + (i_ * 8 + wid) * 1024); \
        glds16(xbase + (size_t)(l_) * (LDP * 2) + aoff_, A_lds + (bf_) * 8192 + wid * 1024); } while (0)
    CMP_STAGE(0, 0);
    for (int i = tid; i < 32 * 128 / 4; i += 512) ((f32x4*)peT)[i] = ((const f32x4*)pe)[i];
    CMP_STAGE(1, 1);
    asm volatile("s_waitcnt vmcnt(5) lgkmcnt(0)" ::: "memory");
    __builtin_amdgcn_s_barrier();
    f32x16 acc = {};
    const int jrow = jb * 32 + r32;
    int cur = 0, nx1 = 1, nx2 = 2;
    for (int l = 0; l < 32; ++l) {
        if (l + 2 < 32) { if (nx2 == 0) CMP_STAGE(l + 2, 0); else if (nx2 == 1) CMP_STAGE(l + 2, 1); else CMP_STAGE(l + 2, 2); }
        const char* Wb = W_lds + cur * 32768 + jrow * 256; const char* Ab = A_lds + cur * 8192 + r32 * 256; const float* pl = peT + l * 128;
#pragma unroll
        for (int dd = 0; dd < 4; ++dd) { const int d0 = kh * 4 + dd, c = d0 * 2 + hi;
            const bf16x8 wf = *(const bf16x8*)(Wb + ((c ^ (jrow & 7)) << 4));
            const u32x4 xv = *(const u32x4*)(Ab + ((c ^ (r32 & 7)) << 4)); const f32x4 pa = *(const f32x4*)(pl + c * 8), pb = *(const f32x4*)(pl + c * 8 + 4);
            u32x4 aw; aw.x = cvtpk(lo_bf(xv.x) + pa[0], hi_bf(xv.x) + pa[1]); aw.y = cvtpk(lo_bf(xv.y) + pa[2], hi_bf(xv.y) + pa[3]);
            aw.z = cvtpk(lo_bf(xv.z) + pb[0], hi_bf(xv.z) + pb[1]); aw.w = cvtpk(lo_bf(xv.w) + pb[2], hi_bf(xv.w) + pb[3]);
            acc = __builtin_amdgcn_mfma_f32_32x32x16_bf16(wf, *reinterpret_cast<const bf16x8*>(&aw), acc, 0, 0, 0); }
        if (l + 2 < 32) asm volatile("s_waitcnt vmcnt(5) lgkmcnt(0)" ::: "memory");
        else asm volatile("s_waitcnt vmcnt(0) lgkmcnt(0)" ::: "memory");
        __builtin_amdgcn_s_barrier();
        const int t_ = cur; cur = nx1; nx1 = nx2; nx2 = t_;
    }
#undef CMP_STAGE
#pragma unroll
    for (int r = 0; r < 16; ++r) part[(kh * 32 + r32) * 129 + jb * 32 + crow(r, hi)] = acc[r];
    __syncthreads();
    {
        const int row = tid >> 4, c8 = (tid & 15) * 8; float sv[8];
#pragma unroll
        for (int j = 0; j < 8; ++j) sv[j] = part[row * 129 + c8 + j] + part[(32 + row) * 129 + c8 + j];
        u32x4 hw; hw.x = cvtpk(siluf_(sv[0]), siluf_(sv[1])); hw.y = cvtpk(siluf_(sv[2]), siluf_(sv[3])); hw.z = cvtpk(siluf_(sv[4]), siluf_(sv[5])); hw.w = cvtpk(siluf_(sv[6]), siluf_(sv[7]));
        *(u32x4*)((char*)hid + row * 256 + ((c8 * 2) ^ ((row & 7) << 4))) = hw;
    }
    __syncthreads();
    if (wid < 4) {
        f32x16 a2 = {};
#pragma unroll
        for (int k0 = 0; k0 < 8; ++k0) {
            const bf16x8 af = *(const bf16x8*)((char*)hid + r32 * 256 + (((k0 * 16 + hi * 8) * 2) ^ ((r32 & 7) << 4)));
            const bf16x8 bfr = ld8(w2t + (size_t)(wid * 32 + r32) * 128 + k0 * 16 + hi * 8);
            a2 = __builtin_amdgcn_mfma_f32_32x32x16_bf16(af, bfr, a2, 0, 0, 0);
        }
#pragma unroll
        for (int r = 0; r < 16; ++r) { const int nn = n0 + crow(r, hi);
            outc[((size_t)bg * 256 + nn) * 128 + wid * 32 + r32] = (bf16)f2bf(nn < 255 ? a2[r] : 0.f); }
    }
    __syncthreads();
}
#undef PK4

__device__ __forceinline__ float wave_sum(float v) {
#pragma unroll
    for (int o = 32; o >= 1; o >>= 1) v += __shfl_xor(v, o);
    return v;
}
__device__ __forceinline__ void norm_phase(const Params& P, int l, const float* xin) {
    const int tid = opaque_tid(), wid = tid >> 6, lane = tid & 63;
    const float* gpre = P.norm_pre_g + (size_t)l * DM;
    bf16* H = (bf16*)(P.ws + WS_H); unsigned char* H8 = P.ws + WS_H8;
    for (int row = blockIdx.x * 8 + wid; row < MTOK; row += gridDim.x * 8) {
        const float* mod = (const float*)(P.ws + WS_MOD) + ((size_t)l * 4 + (row >> 12)) * 6144;
        const float* xr = xin + (size_t)row * DM;
        f32x4 v[8]; float ss = 0.f;
#pragma unroll
        for (int k = 0; k < 4; ++k) { v[2 * k] = *(const f32x4*)(xr + k * 512 + lane * 8); v[2 * k + 1] = *(const f32x4*)(xr + k * 512 + lane * 8 + 4); }
#pragma unroll
        for (int k = 0; k < 8; ++k) ss += v[k][0] * v[k][0] + v[k][1] * v[k][1] + v[k][2] * v[k][2] + v[k][3] * v[k][3];
        ss = wave_sum(ss);
        const float rs = 1.0f / sqrtf(ss * (1.0f / DM) + 1e-6f);
#pragma unroll
        for (int k = 0; k < 4; ++k) {
            const int col = k * 512 + lane * 8; float o[8];
#pragma unroll
            for (int j = 0; j < 8; ++j) { const float xv = v[2 * k + (j >> 2)][j & 3];
                o[j] = xv * rs * gpre[col + j] * (1.0f + mod[2048 + col + j]) + mod[col + j]; }
            u32x4 w; w.x = pk2(o[0], o[1]); w.y = pk2(o[2], o[3]); w.z = pk2(o[4], o[5]); w.w = pk2(o[6], o[7]);
            *(u32x4*)(H + (size_t)row * DM + col) = w;
            u32x2 w8; w8.x = pk4_fp8(o[0] * F8_SCALE_H, o[1] * F8_SCALE_H, o[2] * F8_SCALE_H, o[3] * F8_SCALE_H); w8.y = pk4_fp8(o[4] * F8_SCALE_H, o[5] * F8_SCALE_H, o[6] * F8_SCALE_H, o[7] * F8_SCALE_H);
            *(u32x2*)(H8 + (size_t)row * DM + col) = w8;
        }
    }
}
__device__ __forceinline__ void post_phase(const Params& P, int l, const float* __restrict__ xin, bool grouped) {
    const int tid = opaque_tid(), wid = tid >> 6, lane = tid & 63;
    const float* __restrict__ gpost = P.norm_post_g + (size_t)l * DM;
    const bf16* __restrict__ OP = (const bf16*)(P.ws + WS_OUTPRE);
    bf16* __restrict__ H = (bf16*)(P.ws + WS_H); unsigned char* __restrict__ H8 = P.ws + WS_H8;
    float* __restrict__ outp = P.out;
    const int stride = grouped ? 8 : (int)gridDim.x * 8;
    int row = grouped ? (int)(blockIdx.x & 7) * (MTOK / 8) + (int)(blockIdx.x >> 3) * 64 + wid : (int)blockIdx.x * 8 + wid;
    const int row_end = grouped ? row - wid + 64 : MTOK;
    u32x4 opn[4]; f32x4 xn[8];
    if (row < row_end) {
#pragma unroll
        for (int k = 0; k < 4; ++k) { opn[k] = *(const u32x4*)(OP + (size_t)row * DM + k * 512 + lane * 8);
            xn[2 * k] = *(const f32x4*)(xin + (size_t)row * DM + k * 512 + lane * 8); xn[2 * k + 1] = *(const f32x4*)(xin + (size_t)row * DM + k * 512 + lane * 8 + 4); }
    }
    for (; row < row_end; row += stride) {
        const float* mod = (const float*)(P.ws + WS_MOD) + ((size_t)l * 4 + (row >> 12)) * 6144;
        float ov[32]; f32x4 xc[8]; float ss = 0.f;
#pragma unroll
        for (int k = 0; k < 4; ++k) { const u32x4 w = opn[k]; xc[2 * k] = xn[2 * k]; xc[2 * k + 1] = xn[2 * k + 1];
            ov[8 * k + 0] = lo_bf(w.x); ov[8 * k + 1] = hi_bf(w.x); ov[8 * k + 2] = lo_bf(w.y); ov[8 * k + 3] = hi_bf(w.y);
            ov[8 * k + 4] = lo_bf(w.z); ov[8 * k + 5] = hi_bf(w.z); ov[8 * k + 6] = lo_bf(w.w); ov[8 * k + 7] = hi_bf(w.w); }
        const int rown = row + stride;
        if (rown < row_end) {
#pragma unroll
            for (int k = 0; k < 4; ++k) { opn[k] = *(const u32x4*)(OP + (size_t)rown * DM + k * 512 + lane * 8);
                xn[2 * k] = *(const f32x4*)(xin + (size_t)rown * DM + k * 512 + lane * 8); xn[2 * k + 1] = *(const f32x4*)(xin + (size_t)rown * DM + k * 512 + lane * 8 + 4); }
        }
#pragma unroll
        for (int j = 0; j < 32; ++j) ss += ov[j] * ov[j];
        ss = wave_sum(ss);
        const float rs = 1.0f / sqrtf(ss * (1.0f / DM) + 1e-6f);
        float* orow = outp + (size_t)row * DM; float ss2 = 0.f;
#pragma unroll
        for (int k = 0; k < 4; ++k) {
            const int col = k * 512 + lane * 8;
#pragma unroll
            for (int j = 0; j < 8; ++j) { const float xv = xc[2 * k + (j >> 2)][j & 3];
                const float nv = xv + mod[4096 + col + j] * (ov[8 * k + j] * rs * gpost[col + j]); ov[8 * k + j] = nv; ss2 += nv * nv; }
            *(f32x4*)(orow + col) = (f32x4){ov[8 * k], ov[8 * k + 1], ov[8 * k + 2], ov[8 * k + 3]};
            *(f32x4*)(orow + col + 4) = (f32x4){ov[8 * k + 4], ov[8 * k + 5], ov[8 * k + 6], ov[8 * k + 7]};
        }
        if (l + 1 < DEPTH) {
            ss2 = wave_sum(ss2);
            const float rs2 = 1.0f / sqrtf(ss2 * (1.0f / DM) + 1e-6f);
            const float* mod2 = mod + 4 * 6144; const float* gpre = P.norm_pre_g + (size_t)(l + 1) * DM;
#pragma unroll
            for (int k = 0; k < 4; ++k) {
                const int col = k * 512 + lane * 8; float o[8];
#pragma unroll
                for (int j = 0; j < 8; ++j) o[j] = ov[8 * k + j] * rs2 * gpre[col + j] * (1.0f + mod2[2048 + col + j]) + mod2[col + j];
                u32x4 w; w.x = pk2(o[0], o[1]); w.y = pk2(o[2], o[3]); w.z = pk2(o[4], o[5]); w.w = pk2(o[6], o[7]);
                *(u32x4*)(H + (size_t)row * DM + col) = w;
                u32x2 w8; w8.x = pk4_fp8(o[0] * F8_SCALE_H, o[1] * F8_SCALE_H, o[2] * F8_SCALE_H, o[3] * F8_SCALE_H); w8.y = pk4_fp8(o[4] * F8_SCALE_H, o[5] * F8_SCALE_H, o[6] * F8_SCALE_H, o[7] * F8_SCALE_H);
                *(u32x2*)(H8 + (size_t)row * DM + col) = w8;
            }
        }
    }
}
__device__ __forceinline__ void diffpost_phase(const Params& P, int l) {
    const int tid = opaque_tid(), hw = tid >> 5, l32 = tid & 31;
    const bf16* O0 = (const bf16*)(P.ws + WS_DIFFO); const bf16* O1 = O0 + (size_t)MTOK * 1024;
    const bf16* proj = (const bf16*)(P.ws + WS_PROJ); bf16* ys = (bf16*)(P.ws + WS_YS);
    const float lam = ((const float*)(P.ws + WS_LAM))[l];
    const float lam_init = 0.8f - 0.6f * expf(-0.3f * (float)l);
    const float* g = P.diff_norm_g + (size_t)l * 256 + l32 * 8;
    float gv[8];
#pragma unroll
    for (int j = 0; j < 8; ++j) gv[j] = g[j] * (1.0f - lam_init);
    for (int v = blockIdx.x * 16 + hw; v < MTOK * 4; v += gridDim.x * 16) {
        const size_t row = (size_t)(v >> 2); const int col = (v & 3) * 256 + l32 * 8;
        const u32x4 a = *(const u32x4*)(O0 + row * 1024 + col), b = *(const u32x4*)(O1 + row * 1024 + col), z = *(const u32x4*)(proj + row * LDP + C_AZ + col);
        float d[8];
        d[0] = lo_bf(a.x) - lam * lo_bf(b.x); d[1] = hi_bf(a.x) - lam * hi_bf(b.x); d[2] = lo_bf(a.y) - lam * lo_bf(b.y); d[3] = hi_bf(a.y) - lam * hi_bf(b.y);
        d[4] = lo_bf(a.z) - lam * lo_bf(b.z); d[5] = hi_bf(a.z) - lam * hi_bf(b.z); d[6] = lo_bf(a.w) - lam * lo_bf(b.w); d[7] = hi_bf(a.w) - lam * hi_bf(b.w);
        float ss = 0.f;
#pragma unroll
        for (int j = 0; j < 8; ++j) ss += d[j] * d[j];
#pragma unroll
        for (int o = 16; o >= 1; o >>= 1) ss += __shfl_xor(ss, o);
        const float rs = 1.0f / sqrtf(ss * (1.0f / 256.0f) + 1e-5f);
        const float zz[8] = {lo_bf(z.x), hi_bf(z.x), lo_bf(z.y), hi_bf(z.y), lo_bf(z.z), hi_bf(z.z), lo_bf(z.w), hi_bf(z.w)};
        float o[8];
#pragma unroll
        for (int j = 0; j < 8; ++j) o[j] = d[j] * rs * gv[j] * siluf_(zz[j]);
        u32x4 w; w.x = pk2(o[0], o[1]); w.y = pk2(o[2], o[3]); w.z = pk2(o[4], o[5]); w.w = pk2(o[6], o[7]);
        *(u32x4*)(ys + row * 1024 + col) = w;
    }
}

__device__ __forceinline__ void conv_tile_load(f32x4 (&r)[8], const float* src, size_t lds_, int nvalid) {
    const int tid = opaque_tid(), c4 = (tid & 31) * 4, rb = tid >> 5;
#pragma unroll
    for (int i = 0; i < 8; ++i) r[i] = (c4 < nvalid) ? __builtin_nontemporal_load((const f32x4*)(src + (size_t)(rb + 16 * i) * lds_ + c4)) : (f32x4){0.f, 0.f, 0.f, 0.f};
}
__device__ __forceinline__ void conv_tile_store(const f32x4 (&r)[8], bf16* dst, size_t ldd, char* lds, unsigned char* dst8) {
    const int tid = opaque_tid(), c4 = (tid & 31) * 4, rb = tid >> 5;
    float* T = (float*)lds;
#pragma unroll
    for (int i = 0; i < 8; ++i) { const int k = rb + 16 * i; *(f32x4*)(T + k * 128 + (c4 ^ (((k >> 3) & 7) << 2))) = r[i]; }
    __syncthreads();
    const int kc = tid & 15;
#pragma unroll
    for (int i = 0; i < 4; ++i) { const int n = (tid >> 4) + 32 * i; float v[8];
#pragma unroll
        for (int j = 0; j < 8; ++j) v[j] = T[(8 * kc + j) * 128 + (n ^ ((kc & 7) << 2))];
        if (dst8) { u32x2 w8; w8.x = pk4_fp8(v[0] * F8_SCALE_W, v[1] * F8_SCALE_W, v[2] * F8_SCALE_W, v[3] * F8_SCALE_W); w8.y = pk4_fp8(v[4] * F8_SCALE_W, v[5] * F8_SCALE_W, v[6] * F8_SCALE_W, v[7] * F8_SCALE_W);
                    *(u32x2*)(dst8 + (size_t)n * ldd + 8 * kc) = w8; }
        else { u32x4 w; w.x = pk2(v[0], v[1]); w.y = pk2(v[2], v[3]); w.z = pk2(v[4], v[5]); w.w = pk2(v[6], v[7]);
               *(u32x4*)(dst + (size_t)n * ldd + 8 * kc) = w; } }
    __syncthreads();
}
struct ConvTile { const float* src; bf16* dst; unsigned char* dst8; size_t lds_, ldd; int nvalid; };
constexpr int CT_WIN1 = 16 * 142, CT_WBR1 = 8 * 16, CT_WOUT1 = 16 * 16, CT_W1 = 8 * 32, CT_W2 = 8;
__device__ __forceinline__ ConvTile conv_win(const Params& P, int l, int r) { ConvTile c; c.dst8 = nullptr;
    const int nt = r / 16, kt = r % 16; const int n0 = nt * 128;
    int s0, nv = 128; if (n0 < C_NZ) s0 = n0; else if (n0 < C_SQ) s0 = 6680 + (n0 - C_NZ); else if (n0 < C_NG) s0 = 7704 + (n0 - C_SQ);
    else if (n0 < C_MG) { s0 = 6656 + (n0 - C_NG); nv = (n0 == C_NG) ? 24 : 0; if (nv == 0) s0 = 0; } else s0 = 11800 + (n0 - C_MG);
    c.src = P.w_in + ((size_t)l * DM + kt * 128) * N_IN + s0; c.lds_ = N_IN; c.nvalid = nv; c.ldd = DM;
    c.dst = (bf16*)(P.ws + WS_WIN) + ((size_t)l * LDP + n0) * DM + kt * 128;
    if (n0 >= C_MG) c.dst8 = P.ws + WS_WG8 + ((size_t)l * N_F8 + (n0 - C_MG)) * DM + kt * 128;
    return c; }
__device__ __forceinline__ ConvTile conv_wbr(const Params& P, int m, int r) { ConvTile c; c.dst8 = nullptr; const int nt = r / 8, kt = r % 8;
    c.src = P.w_branch + ((size_t)m * 1024 + kt * 128) * DM + nt * 128; c.lds_ = DM; c.nvalid = 128;
    c.dst = (bf16*)(P.ws + WS_WBR) + ((size_t)m * DM + nt * 128) * 1024 + kt * 128; c.ldd = 1024; return c; }
__device__ __forceinline__ ConvTile conv_wout(const Params& P, int l, int r) { ConvTile c; c.dst8 = nullptr; const int nt = r / 16, kt = r % 16;
    c.src = P.w_out + ((size_t)l * DM + kt * 128) * DM + nt * 128; c.lds_ = DM; c.nvalid = 128;
    c.dst = (bf16*)(P.ws + WS_WOUT) + ((size_t)l * DM + nt * 128) * DM + kt * 128; c.ldd = DM; return c; }
__device__ __forceinline__ ConvTile conv_cmpw(const Params& P, int t) { ConvTile c; c.dst8 = nullptr;
    if (t < CT_W1) { const int kv = t / 128, r = t % 128, l = r / 32, kt = r % 32;
        c.src = (kv ? P.w1_v : P.w1_k) + ((size_t)l * 4096 + kt * 128) * 128; c.lds_ = 128; c.nvalid = 128;
        c.dst = (bf16*)(P.ws + (kv ? WS_W1V : WS_W1K)) + (size_t)l * 128 * 4096 + kt * 128; c.ldd = 4096; return c; }
    t -= CT_W1;
    { const int kv = t / 4, l = t % 4;
        c.src = (kv ? P.w2_v : P.w2_k) + (size_t)l * 128 * 128; c.lds_ = 128; c.nvalid = 128;
        c.dst = (bf16*)(P.ws + (kv ? WS_W2V : WS_W2K)) + (size_t)l * 128 * 128; c.ldd = 128; return c; }
}
constexpr int CT_PRO = CT_WIN1 + CT_W1 + CT_W2;
__device__ __forceinline__ ConvTile conv_decode_pro(const Params& P, int t) { if (t < CT_WIN1) return conv_win(P, 0, t); return conv_cmpw(P, t - CT_WIN1); }
constexpr int CT_DEF_A = 3 * CT_WBR1 + CT_WOUT1, CT_DEF = CT_DEF_A + CT_WIN1, CONV_TPI = 4;
__device__ __forceinline__ constexpr int conv_def_items(int l) { return ((l + 1 < DEPTH ? CT_DEF : CT_DEF_A) + CONV_TPI - 1) / CONV_TPI; }
__device__ __forceinline__ ConvTile conv_decode_def(const Params& P, int l, int t) {
    if (t < 3 * CT_WBR1) return conv_wbr(P, l * 3 + t / CT_WBR1, t % CT_WBR1);
    t -= 3 * CT_WBR1; if (t < CT_WOUT1) return conv_wout(P, l, t);
    return conv_win(P, l + 1, t - CT_WOUT1); }
__device__ __forceinline__ void conv_item(const Params& P, int l, int item, char* lds) {
    const int nt_ = (l + 1 < DEPTH) ? CT_DEF : CT_DEF_A, t0 = item * CONV_TPI, t1 = (t0 + CONV_TPI < nt_) ? t0 + CONV_TPI : nt_;
    f32x4 r[8]; ConvTile c = conv_decode_def(P, l, t0); conv_tile_load(r, c.src, c.lds_, c.nvalid);
    for (int t = t0; t < t1; ++t) {
        ConvTile cn = c; f32x4 rn[8];
        if (t + 1 < t1) { cn = conv_decode_def(P, l, t + 1); conv_tile_load(rn, cn.src, cn.lds_, cn.nvalid); }
        conv_tile_store(r, c.dst, c.ldd, lds, c.dst8);
        if (t + 1 < t1) {
#pragma unroll
            for (int i = 0; i < 8; ++i) r[i] = rn[i]; }
        c = cn;
    }
}
__device__ __forceinline__ void prologue_phase(const Params& P, char* lds) {
    const int tid = opaque_tid();
    {
        f32x4 r[8]; int t = blockIdx.x;
        ConvTile c = {}; if (t < CT_PRO) { c = conv_decode_pro(P, t); conv_tile_load(r, c.src, c.lds_, c.nvalid); }
        while (t < CT_PRO) {
            const int tn = t + gridDim.x; ConvTile cn = c; f32x4 rn[8];
            if (tn < CT_PRO) { cn = conv_decode_pro(P, tn); conv_tile_load(rn, cn.src, cn.lds_, cn.nvalid); }
            conv_tile_store(r, c.dst, c.ldd, lds, c.dst8);
            if (tn < CT_PRO) {
#pragma unroll
                for (int i = 0; i < 8; ++i) r[i] = rn[i]; }
            c = cn; t = tn;
        }
    }
    {
        float* sl = (float*)lds;
        float* modp = (float*)(P.ws + WS_MODP);
        for (int it = blockIdx.x; it < 4 * 32 * 12; it += gridDim.x) {
            const int l = it / 384, r = it % 384, kc = r / 12, jb = r % 12, j = jb * 512 + tid;
            __syncthreads();
            if (tid < 256) { const int b = tid >> 6, k = tid & 63; sl[tid] = siluf_(P.c[(size_t)b * DM + kc * 64 + k]); }
            __syncthreads();
            const float* w = P.w_ada + ((size_t)l * DM + kc * 64) * 6144 + j;
            float a0 = 0.f, a1 = 0.f, a2 = 0.f, a3 = 0.f;
#pragma unroll 16
            for (int k = 0; k < 64; ++k) { const float wv = w[(size_t)k * 6144]; a0 += sl[k] * wv; a1 += sl[64 + k] * wv; a2 += sl[128 + k] * wv; a3 += sl[192 + k] * wv; }
            float* mp = modp + (((size_t)l * 32 + kc) * 4) * 6144 + j;
            mp[0] = a0; mp[6144] = a1; mp[2 * 6144] = a2; mp[3 * 6144] = a3;
        }
        __syncthreads();
    }
    {
        float* rope = (float*)(P.ws + WS_ROPE);
        for (int i = blockIdx.x * 512 + tid; i < SEQ * 16; i += gridDim.x * 512) {
            const int pos = i >> 4, fi = i & 15;
            const float inv = powf(500000.0f, -(float)(2 * fi) / 32.0f);
            const float ang = (float)pos * inv;
            rope[pos * 32 + fi] = cosf(ang); rope[pos * 32 + 16 + fi] = sinf(ang);
        }
    }
}
__device__ __forceinline__ void modreduce_phase(const Params& P) {
    const int tid = opaque_tid();
    const float* modp = (const float*)(P.ws + WS_MODP); float* mod = (float*)(P.ws + WS_MOD);
    for (int i = blockIdx.x * 512 + tid; i < 4 * 4 * 6144; i += gridDim.x * 512) {
        const int l = i / (4 * 6144), r = i % (4 * 6144), b = r / 6144, j = r % 6144;
        float s = P.b_ada[(size_t)l * 6144 + j];
        for (int kc = 0; kc < 32; ++kc) s += modp[(((size_t)l * 32 + kc) * 4 + b) * 6144 + j];
        mod[i] = s;
    }
    if (blockIdx.x == 0 && tid < 256) {
        const int l = tid >> 6, lane = tid & 63;
        float s1 = P.lq1[l * 128 + lane] * P.lk1[l * 128 + lane] + P.lq1[l * 128 + 64 + lane] * P.lk1[l * 128 + 64 + lane];
        float s2 = P.lq2[l * 128 + lane] * P.lk2[l * 128 + lane] + P.lq2[l * 128 + 64 + lane] * P.lk2[l * 128 + 64 + lane];
        s1 = wave_sum(s1); s2 = wave_sum(s2);
        if (lane == 0) ((float*)(P.ws + WS_LAM))[l] = expf(s1) - expf(s2) + (0.8f - 0.6f * expf(-0.3f * (float)l));
    }
}

__device__ __forceinline__ BlockRef diff_ref(const bf16* proj, int item, int pass) {
    const int bh = item >> 3, x = item & 7, b = bh >> 4, hh = bh & 15, h = hh >> 2, c = (hh >> 1) & 1, vh = hh & 1;
    const int qb = pass ? 15 - x : x;
    BlockRef r; const bf16* base = proj + (size_t)b * SEQ * LDP;
    r.Q = base + (size_t)qb * QB * LDP + C_AQ + (h * 2 + c) * 128; r.K = base + C_AK + (h * 2 + c) * 128; r.V = base + C_AV + h * 256 + vh * 128;
    r.M = nullptr; r.P0 = qb * QB; r.row0 = b * SEQ + qb * QB + c * MTOK; r.aux = h * 256 + vh * 128; r.aux2 = 0; return r;
}
__device__ __forceinline__ BlockRef win_ref(const bf16* proj, int item, int pass) {
    const int bg = item >> 5, x = item & 31, qb = pass ? 63 - x : x, b = bg >> 1, g = bg & 1, head = g * 4;
    BlockRef r; const bf16* base = proj + (size_t)b * SEQ * LDP;
    r.Q = base + (size_t)qb * 64 * LDP + C_NQ + head * 128; r.K = base + C_NKW + g * 128; r.V = base + C_NVW + g * 128;
    r.M = nullptr; r.P0 = qb * 64; r.row0 = b * SEQ + qb * 64; r.aux = head * 128; r.aux2 = head; return r;
}
__device__ __forceinline__ BlockRef slc_ref(const bf16* proj, const u64* selm, int item, int pass) {
    const int bg = item >> 5, x = item & 31, b = bg >> 1, g = bg & 1, head = g * 4;
    const int qb = pass ? 63 - x : x;
    BlockRef r; const bf16* base = proj + (size_t)b * SEQ * LDP;
    r.Q = base + (size_t)qb * 64 * LDP + C_NQ + head * 128; r.K = base + C_NKS + g * 128; r.V = base + C_NVS + g * 128;
    r.M = selm + (size_t)(b * 2 + g) * SEQ; r.P0 = qb * 64; r.row0 = b * SEQ + qb * 64; r.aux = head * 128; r.aux2 = head; return r;
}
__device__ __forceinline__ BlockRef sb_ref(const bf16* proj, int blk) {
    const int bh = blk >> 4, qb = blk & 15, b = bh >> 3, head = bh & 7;
    BlockRef r; const bf16* base = proj + (size_t)b * SEQ * LDP;
    r.Q = base + (size_t)qb * QB * LDP + C_SQ + head * 128; r.K = base + C_SK + head * 128; r.V = base + C_SV + head * 128;
    r.M = nullptr; r.P0 = qb * QB; r.row0 = b * SEQ + qb * QB; r.aux = head * 128; r.aux2 = head; return r;
}

constexpr int N_PHASES = 3 + 7 * DEPTH;
typedef const __attribute__((address_space(4))) Params* kparams_t;
__device__ __forceinline__ kparams_t kparams() { kparams_t p = (kparams_t)__builtin_amdgcn_kernarg_segment_ptr(); asm volatile("" : "+s"(p)); return p; }
__device__ __forceinline__ Params load_params(kparams_t k) { Params p;
    p.x = k->x; p.c = k->c; p.norm_pre_g = k->norm_pre_g; p.norm_post_g = k->norm_post_g; p.w_ada = k->w_ada; p.b_ada = k->b_ada; p.w_in = k->w_in;
    p.lq1 = k->lq1; p.lk1 = k->lk1; p.lq2 = k->lq2; p.lk2 = k->lk2; p.diff_norm_g = k->diff_norm_g;
    p.pe_k = k->pe_k; p.w1_k = k->w1_k; p.w2_k = k->w2_k; p.pe_v = k->pe_v; p.w1_v = k->w1_v; p.w2_v = k->w2_v; p.w_branch = k->w_branch; p.w_out = k->w_out;
    p.out = k->out; p.ws = k->ws; return p; }
template <int MODE> __global__ void __launch_bounds__(512, 2) hybrid_fwd(Params Parg, int ph_lo, int ph_hi) {
    extern __shared__ __attribute__((aligned(16))) unsigned char lds_raw[];
    char* lds = (char*)lds_raw;
    (void)Parg;
    { const int tid = threadIdx.x;
      if (tid < 64) ((volatile unsigned*)(lds + LDS_CTL))[tid] = 0u; }
    __syncthreads();
    const bool one = (ph_hi - ph_lo) > 1;
    if (one) (void)xcd_barrier_post((unsigned*)(kparams()->ws + WS_CTL) + CW_BAR, (volatile LAS unsigned*)(lds + LDS_CTL));
#define IN(k) (ph_lo <= (k) && (k) < ph_hi)
#define TY(t) (MODE < 0 || MODE == (t) || ((t) == 4 && MODE >= 10 && MODE < 14))
#define SUB(s_) (MODE < 10 || MODE == 10 + (s_))
#define SEAM(k) do { if ((k) + 1 < ph_hi) { XcdBarrier b_; b_.bar = (unsigned*)(kparams()->ws + WS_CTL) + CW_BAR; b_.x = xb_xcc_id(); b_.st = (volatile LAS unsigned*)(lds + LDS_CTL); xcd_barrier(b_); } } while (0)
#define LOCAL_SEAM(k) do { if ((k) + 1 < ph_hi) { asm volatile("s_waitcnt vmcnt(0)" ::: "memory"); __syncthreads(); \
        if (threadIdx.x == 0) { __builtin_amdgcn_fence(__ATOMIC_ACQUIRE, "agent"); asm volatile("s_waitcnt vmcnt(0)" ::: "memory"); } __syncthreads(); } } while (0)
#define GROUP_SEAM(k, use_) do { if ((k) + 1 < ph_hi) { if (grp_ok) { unsigned* ctl_ = (unsigned*)(kparams()->ws + WS_CTL); group_barrier(ctl_ + CW_BAR, ctl_ + CW_GRP + 64 * (blockIdx.x & 7), 32u * (unsigned)(use_)); } else SEAM(k); } } while (0)
#define REP(id) for (int rep_ = 0; rep_ < ((((PROBE_DUP_MASK) >> (id)) & 1) ? 2 : 1); ++rep_)
#define KP() const Params P = load_params(kparams()); bf16* proj = (bf16*)(P.ws + WS_PROJ); const int G = gridDim.x, c = blockIdx.x; (void)proj; (void)G; (void)c
    if constexpr (TY(0)) if (IN(0)) { { KP(); REP(0) prologue_phase(P, lds); } SEAM(0); }
    if constexpr (TY(1)) if (IN(1)) { { KP(); REP(1) modreduce_phase(P); } SEAM(1); }
    if constexpr (TY(2)) if (IN(2)) { { KP(); REP(2) norm_phase(P, 0, P.x); } SEAM(2); }

    const bool grp_ok = gridDim.x == 256;
    for (int l = 0; l < DEPTH; ++l) {
        const int pb = 3 + 7 * l;
        if constexpr (TY(3)) if (IN(pb + 0)) {
            { KP();
            pg8::Gemm g{(const pg8::bf16_t*)(P.ws + WS_H), (const pg8::bf16_t*)(P.ws + WS_WIN) + (size_t)l * LDP * DM, MTOK, N_BF, DM};
            pg8::StaticOrder S; S.init(MTOK, N_BF, G, c);
            pg8::EpiProj E{(pg8::bf16_t*)proj, (const float*)(P.ws + WS_ROPE)};
            REP(3) pg8::gemm_phase<pg8::EpiProj, pg8::StaticOrder, true, true>((PG8_LAS unsigned char*)lds_raw, g, S, E);
            pg8::Gemm g8{(const pg8::bf16_t*)(P.ws + WS_H8), (const pg8::bf16_t*)(P.ws + WS_WG8 + (size_t)l * N_F8 * DM), MTOK, N_F8, DM / 2};
            pg8::StaticOrder S8; S8.init(MTOK, N_F8, G, c);
            pg8::EpiGate8 E8{(pg8::bf16_t*)proj};
            REP(3) pg8::gemm_phase<pg8::EpiGate8, pg8::StaticOrder, false, true, true>((PG8_LAS unsigned char*)lds_raw, g8, S8, E8); }
            SEAM(pb + 0);
        }
        if constexpr (TY(4)) if (IN(pb + 1)) {
            if constexpr (SUB(0)) REP(10) {
                KP();
                for (int L = c; L < 256; L += G) {
                    const int bhc = L >> 3, x = L & 7, b = bhc >> 3, h = (bhc >> 1) & 3, cm = bhc & 1;
                    const bf16* base = proj + (size_t)b * SEQ * LDP;
                    for (int pass = 0; pass < 2; ++pass) {
                        const int qb = pass ? 15 - x : x;
                        BlockRef r; r.Q = base + (size_t)qb * QB * LDP + C_AQ + (h * 2 + cm) * 128; r.K = base + C_AK + (h * 2 + cm) * 128; r.V = base + C_AV + h * 256;
                        r.M = nullptr; r.P0 = qb * QB; r.row0 = b * SEQ + qb * QB + cm * MTOK; r.aux = h * 256; r.aux2 = 0;
                        diff_block(r, (bf16*)(P.ws + WS_DIFFO), lds);
                    }
                    wg_publish((unsigned*)(P.ws + WS_CTL) + CW_DIFFD);
                }
            }
            if constexpr (SUB(1)) REP(11) {
                KP();
                EpiAttnStore E{(bf16*)(P.ws + WS_OWIN), 1024, lds};
                for (int L0 = c; L0 < 256; L0 += G) { const int L = L0;
                    for (int pass = 0; pass < 2; ++pass) { const BlockRef cur = win_ref(proj, L, pass); attn_simple<false, 512, 4, EpiAttnStore>(cur, lds, E); } }
            }
            if constexpr (SUB(2)) {
                KP();
                EpiSb E{proj, (bf16*)(P.ws + WS_YS) + (size_t)2 * MTOK * 1024, lds};
                unsigned* qctr = (unsigned*)(P.ws + WS_CTL) + CW_QUEUE + 64 * l;
                volatile unsigned* qslot = (volatile unsigned*)(lds + LDS_CTL + 64);
                const bool t0 = threadIdx.x == 0;
                if (t0) *qslot = __hip_atomic_fetch_add(qctr, 1u, __ATOMIC_RELAXED, __HIP_MEMORY_SCOPE_AGENT);
                __syncthreads(); unsigned it = *qslot; __syncthreads();
                const unsigned nq = 640u + (unsigned)conv_def_items(l);
                while (it < nq) {
                    unsigned nx = 0u; if (t0) nx = __hip_atomic_fetch_add(qctr, 1u, __ATOMIC_RELAXED, __HIP_MEMORY_SCOPE_AGENT);
                    if (it < 128u) { const int kv = (int)it >> 6, bg = ((int)it >> 3) & 7, nt = (int)it & 7;
                        compress_item(proj, (kv ? P.pe_v : P.pe_k) + (size_t)l * 32 * 128, (const bf16*)(P.ws + (kv ? WS_W1V : WS_W1K)) + (size_t)l * 128 * 4096,
                                      (const bf16*)(P.ws + (kv ? WS_W2V : WS_W2K)) + (size_t)l * 128 * 128, (bf16*)(P.ws + (kv ? WS_VCMP : WS_KCMP)), kv, bg, nt, lds);
                        wg_publish((unsigned*)(P.ws + WS_CTL) + CW_CMPD + 64 * bg); }
                    else if (it >= 640u) conv_item(P, l, (int)it - 640, lds);
                    else { const int idx = (int)it - 128, b = idx >> 7, hp = (idx >> 5) & 3, qh = 31 - (idx & 31);
                        const bf16* base = proj + (size_t)b * SEQ * LDP + hp * 256;
                        SbPairRef pr; pr.Q = base + (size_t)qh * 128 * LDP + C_SQ; pr.K = base + C_SK; pr.V = base + C_SV; pr.P0 = qh * 128; pr.row0 = b * SEQ + qh * 128; pr.aux = hp * 256;
                        sb_pair(pr, lds, E); }
                    if (t0) *qslot = nx;
                    __syncthreads(); it = *qslot; __syncthreads();
                }
            }
            LOCAL_SEAM(pb + 1);
        }
        if constexpr (TY(5)) if (IN(pb + 2)) {
            { KP(); REP(5) for (int it = c; it < 256; it += G) {
                unsigned* ctl_ = (unsigned*)(P.ws + WS_CTL); wg_await(ctl_ + CW_BAR, ctl_ + CW_CMPD + 64 * (it >> 5), 16u * (unsigned)(l + 1));
                cmp_pair(proj, (const bf16*)(P.ws + WS_KCMP), (const bf16*)(P.ws + WS_VCMP), (bf16*)(P.ws + WS_OCMP), (u64*)(P.ws + WS_SELM), it, lds); } }
            LOCAL_SEAM(pb + 2);
        }
        if constexpr (TY(6)) if (IN(pb + 3)) {
            { KP();
            EpiNsaCombine E{proj, (const bf16*)(P.ws + WS_OCMP), (const bf16*)(P.ws + WS_OWIN), (bf16*)(P.ws + WS_YS) + (size_t)MTOK * 1024, lds};
            const u64* selm = (const u64*)(P.ws + WS_SELM);
            REP(6) { for (int L = c; L < 256; L += G) {
                for (int pass = 0; pass < 2; ++pass) { const BlockRef cur = slc_ref(proj, selm, L, pass); attn_simple<true, 1 << 30, 4, EpiNsaCombine>(cur, lds, E); }
            } } }
            { KP(); unsigned* ctl_ = (unsigned*)(P.ws + WS_CTL); wg_await(ctl_ + CW_BAR, ctl_ + CW_DIFFD, 256u * (unsigned)(l + 1));
              REP(14) diffpost_phase(P, l); }
            SEAM(pb + 3);
        }
        if constexpr (TY(7)) if (IN(pb + 4)) {
            { KP();
            pg8::Gemm g{(const pg8::bf16_t*)(P.ws + WS_YS), (const pg8::bf16_t*)(P.ws + WS_WBR) + (size_t)l * 3 * DM * 1024, 3 * MTOK, 3 * DM, 1024};
            pg8::BranchOrder S{G, c};
            pg8::EpiBranch E{(const pg8::bf16_t*)proj, (pg8::bf16_t*)(P.ws + WS_MERGED)};
            REP(7) pg8::gemm_phase<pg8::EpiBranch, pg8::BranchOrder, false, true>((PG8_LAS unsigned char*)lds_raw, g, S, E); }
            GROUP_SEAM(pb + 4, 3 * l + 1);
        }
        if constexpr (TY(8)) if (IN(pb + 5)) {
            { KP();
            pg8::Gemm g{(const pg8::bf16_t*)(P.ws + WS_MERGED), (const pg8::bf16_t*)(P.ws + WS_WOUT) + (size_t)l * DM * DM, MTOK, DM, DM};
            pg8::StaticOrder S; S.init(MTOK, DM, G, c);
            pg8::EpiPlain E{(pg8::bf16_t*)(P.ws + WS_OUTPRE), DM};
            REP(8) pg8::gemm_phase<pg8::EpiPlain, pg8::StaticOrder, false, true>((PG8_LAS unsigned char*)lds_raw, g, S, E); }
            GROUP_SEAM(pb + 5, 3 * l + 2);
        }
        if constexpr (TY(9)) if (IN(pb + 6)) {
            { KP(); post_phase(P, l, l == 0 ? P.x : P.out, grp_ok); }
            GROUP_SEAM(pb + 6, 3 * l + 3);
        }
    }
#undef IN
#undef TY
#undef SUB
#undef SEAM
#undef REP
#undef KP
}

#if MK_ONE_LAUNCH
static hipError_t set_attrs() { return hipFuncSetAttribute((const void*)hybrid_fwd<-1>, hipFuncAttributeMaxDynamicSharedMemorySize, LDS_BYTES); }
#else
template <int T> static hipError_t set_attr1() { return hipFuncSetAttribute((const void*)hybrid_fwd<T>, hipFuncAttributeMaxDynamicSharedMemorySize, LDS_BYTES); }
static hipError_t set_attrs() { hipError_t e = hipSuccess, r;
    r = set_attr1<0>(); if (r != hipSuccess) e = r; r = set_attr1<1>(); if (r != hipSuccess) e = r; r = set_attr1<2>(); if (r != hipSuccess) e = r; r = set_attr1<3>(); if (r != hipSuccess) e = r;
    r = set_attr1<5>(); if (r != hipSuccess) e = r; r = set_attr1<6>(); if (r != hipSuccess) e = r; r = set_attr1<7>(); if (r != hipSuccess) e = r;
    r = set_attr1<8>(); if (r != hipSuccess) e = r; r = set_attr1<9>(); if (r != hipSuccess) e = r;
    r = set_attr1<10>(); if (r != hipSuccess) e = r; r = set_attr1<11>(); if (r != hipSuccess) e = r; r = set_attr1<12>(); if (r != hipSuccess) e = r; r = set_attr1<13>(); if (r != hipSuccess) e = r; return e; }
static void launch_phase(int ty, int grid, hipStream_t stream, const Params& p, int k) {
    switch (ty) {
    case 0: hipLaunchKernelGGL(hybrid_fwd<0>, dim3(grid), dim3(512), LDS_BYTES, stream, p, k, k + 1); break;
    case 1: hipLaunchKernelGGL(hybrid_fwd<1>, dim3(grid), dim3(512), LDS_BYTES, stream, p, k, k + 1); break;
    case 2: hipLaunchKernelGGL(hybrid_fwd<2>, dim3(grid), dim3(512), LDS_BYTES, stream, p, k, k + 1); break;
    case 3: hipLaunchKernelGGL(hybrid_fwd<3>, dim3(grid), dim3(512), LDS_BYTES, stream, p, k, k + 1); break;
    case 4: hipLaunchKernelGGL(hybrid_fwd<10>, dim3(grid), dim3(512), LDS_BYTES, stream, p, k, k + 1);
            hipLaunchKernelGGL(hybrid_fwd<11>, dim3(grid), dim3(512), LDS_BYTES, stream, p, k, k + 1);
            hipLaunchKernelGGL(hybrid_fwd<12>, dim3(grid), dim3(512), LDS_BYTES, stream, p, k, k + 1);
            hipLaunchKernelGGL(hybrid_fwd<13>, dim3(grid), dim3(512), LDS_BYTES, stream, p, k, k + 1); break;
    case 5: hipLaunchKernelGGL(hybrid_fwd<5>, dim3(grid), dim3(512), LDS_BYTES, stream, p, k, k + 1); break;
    case 6: hipLaunchKernelGGL(hybrid_fwd<6>, dim3(grid), dim3(512), LDS_BYTES, stream, p, k, k + 1); break;
    case 7: hipLaunchKernelGGL(hybrid_fwd<7>, dim3(grid), dim3(512), LDS_BYTES, stream, p, k, k + 1); break;
    case 8: hipLaunchKernelGGL(hybrid_fwd<8>, dim3(grid), dim3(512), LDS_BYTES, stream, p, k, k + 1); break;
    default: hipLaunchKernelGGL(hybrid_fwd<9>, dim3(grid), dim3(512), LDS_BYTES, stream, p, k, k + 1); break;
    }
}
#endif
extern "C" void kernel_launch(void* const* d_in, const int* in_sizes, int n_in, void* d_out, int out_size, void* d_ws, size_t ws_size, hipStream_t stream) {
    static int grid = 0;
    if (grid == 0) {
        if (n_in != 20 || out_size != MTOK * DM || ws_size < WS_END) { fprintf(stderr, "kernel_launch: unexpected shapes (n_in %d, out %d, ws %zu < %zu)\n", n_in, out_size, ws_size, (size_t)WS_END); grid = -1; return; }
        int dev = 0, cus = 0, per_cu = 0;
        if (hipGetDevice(&dev) != hipSuccess || hipDeviceGetAttribute(&cus, hipDeviceAttributeMultiprocessorCount, dev) != hipSuccess) { grid = -1; return; }
        if (set_attrs() != hipSuccess) { fprintf(stderr, "kernel_launch: hipFuncSetAttribute failed\n"); grid = -1; return; }
        (void)per_cu;
        (void)hipGetLastError();
        grid = cus;
    }
    if (grid < 0) return;
    (void)hipMemsetAsync((char*)d_ws + WS_CTL, 0, CTL_BYTES, stream);
    Params p{};
    p.x = (const float*)d_in[0]; p.c = (const float*)d_in[1]; p.norm_pre_g = (const float*)d_in[2]; p.norm_post_g = (const float*)d_in[3];
    p.w_ada = (const float*)d_in[4]; p.b_ada = (const float*)d_in[5]; p.w_in = (const float*)d_in[6];
    p.lq1 = (const float*)d_in[7]; p.lk1 = (const float*)d_in[8]; p.lq2 = (const float*)d_in[9]; p.lk2 = (const float*)d_in[10]; p.diff_norm_g = (const float*)d_in[11];
    p.pe_k = (const float*)d_in[12]; p.w1_k = (const float*)d_in[13]; p.w2_k = (const float*)d_in[14]; p.pe_v = (const float*)d_in[15]; p.w1_v = (const float*)d_in[16]; p.w2_v = (const float*)d_in[17];
    p.w_branch = (const float*)d_in[18]; p.w_out = (const float*)d_in[19];
    p.out = (float*)d_out; p.ws = (unsigned char*)d_ws;
#if MK_ONE_LAUNCH
    hipLaunchKernelGGL(hybrid_fwd<-1>, dim3(grid), dim3(512), LDS_BYTES, stream, p, 0, N_PHASES);
#else
    for (int k = 0; k < N_PHASES; ++k) launch_phase(k < 3 ? k : 3 + (k - 3) % 7, grid, stream, p, k);
#endif
}
```

```cpp
#include <hip/hip_runtime.h>
#include <cstdio>
#include <cstdint>

#ifndef MK_ONE_LAUNCH
#define MK_ONE_LAUNCH 1
#endif
#ifndef PROBE_DUP_MASK
#define PROBE_DUP_MASK 0
#endif

namespace pg8 {
#define PG8_LAS __attribute__((address_space(3)))
typedef unsigned short bf16_t;
typedef short bf16x8 __attribute__((ext_vector_type(8)));
typedef float f32x4 __attribute__((ext_vector_type(4)));
typedef unsigned u32x4 __attribute__((ext_vector_type(4)));
constexpr int BM = 256, BK = 64, HALF = 128, HTB = HALF * BK * 2  , STAGE_BYTES = 8 * HTB, NXCD = 8, WGM = 8;

__host__ __device__ __forceinline__ int lds_byte(int r, int c) { const int st = (r >> 4) * 2 + (c >> 5), rr = r & 15, cc = c & 31, ob = rr * 64 + cc * 2; return st * 1024 + (ob ^ (((ob >> 9) & 1) << 5)); }
__host__ __device__ __forceinline__ void stage_rc(int b, int& R, int& C) { const int st = b / 1024, sb = b % 1024, swz = sb ^ (((sb >> 9) & 1) << 5); R = (st >> 1) * 16 + swz / 64; C = (st & 1) * 32 + (swz % 64) / 2; }
__host__ __device__ __forceinline__ int perm32(int rho) { const int n = rho >> 4, i = rho & 15; return 8 * (i >> 2) + 4 * n + (i & 3); }

struct Unit { int pm, pn; };
struct Gemm { const bf16_t* A; const bf16_t* Bt; int M, N, K; };

struct StaticOrder {
    int nM, nN, nwg, G, c;
    __host__ __device__ void init(int M, int N, int G_, int c_) { nM = M / BM; nN = N / BM; nwg = nM * nN; G = G_; c = c_; }
    __host__ __device__ bool next(int i, Unit& u) const {
        const long L = (long)i * G + c; if (L >= nwg) return false;
        int wgid = (int)L; { const int q = nwg / NXCD, r = nwg % NXCD, xcd = wgid % NXCD, off = wgid / NXCD; wgid = (xcd < r ? xcd * (q + 1) : r * (q + 1) + (xcd - r) * q) + off; }
        const int nig = WGM * nN, gid = wgid / nig, fm = gid * WGM, gsz = (nM - fm) < WGM ? (nM - fm) : WGM;
        u.pm = fm + ((wgid % nig) % gsz); u.pn = (wgid % nig) / gsz; return true;
    }
    __device__ __forceinline__ void a_ready(const Unit&) const {}
    __device__ __forceinline__ void done(const Unit&) const {}
};

__device__ __forceinline__ unsigned cvt_pk_bf16(float lo, float hi) { unsigned r; asm volatile("v_cvt_pk_bf16_f32 %0, %1, %2" : "=v"(r) : "v"(lo), "v"(hi)); return r; }
typedef int pg8_v8i32 __attribute__((ext_vector_type(8))); typedef int pg8_v4i32 __attribute__((ext_vector_type(4)));
__device__ __forceinline__ pg8_v8i32 pg8_cat8(bf16x8 lo, bf16x8 hi) { const pg8_v4i32 a = __builtin_bit_cast(pg8_v4i32, lo), b = __builtin_bit_cast(pg8_v4i32, hi); return __builtin_shufflevector(a, b, 0, 1, 2, 3, 4, 5, 6, 7); }
template <class Epi, class Sched, bool ALIGN_EPI = false, bool SP2 = false, bool F8 = false>
__device__ __forceinline__ void gemm_phase(PG8_LAS unsigned char* lds, const Gemm g, const Sched& S, const Epi& E) {
    int tid_ = threadIdx.x; asm volatile("" : "+v"(tid_)); const int tid = tid_, wid = __builtin_amdgcn_readfirstlane(tid >> 6), lane = tid & 63, wr = wid >> 2, wc = wid & 3, fr = lane & 15, fq = lane >> 4;
    const int K = g.K, nt = K / BK;
    unsigned voffA[2], voffB[2];
#pragma unroll
    for (int i = 0; i < 2; ++i) { int R, C; stage_rc(tid * 16 + i * 8192, R, C); const int Rb = Epi::PERM ? ((R & ~31) + perm32(R & 31)) : R;
        voffA[i] = (unsigned)(R * K + C) * 2u; voffB[i] = (unsigned)(Rb * K + C) * 2u; }
    const __amdgpu_buffer_rsrc_t rsrc_voffA = __builtin_amdgcn_make_buffer_rsrc((void*)g.A, 0, 0x7fffffff, 0x00020000), rsrc_voffB = __builtin_amdgcn_make_buffer_rsrc((void*)g.Bt, 0, 0x7fffffff, 0x00020000);
    const unsigned kstep = (unsigned)(BK * 2);
    const unsigned hstep = (unsigned)(HALF * K * 2);
    const unsigned tstep = 2u * hstep;
    const unsigned ldsw = (unsigned)wid * 1024u;
    const int aoff = lds_byte(wr * 64 + fr, fq * 8), boff = lds_byte(wc * 32 + fr, fq * 8);
#define PG8_SA(b, h) (((b) * 2 + (h)) * HTB)
#define PG8_SB(b, h) ((4 + (b) * 2 + (h)) * HTB)
#define PG8_STAGE(bufoff, gbase, voff) do { _Pragma("unroll") for (int _i = 0; _i < 2; ++_i) \
        __builtin_amdgcn_raw_ptr_buffer_load_lds(rsrc_##voff, (PG8_LAS void*)(lds + (bufoff) + ldsw + _i * 8192), 16, (int)(voff)[_i], (int)(unsigned)(gbase), 0, 0); } while (0)
#define PG8_LD8(addr_) __builtin_shufflevector(*(const PG8_LAS pg8_v4i32*)(addr_), *(const PG8_LAS pg8_v4i32*)((addr_) + 1024), 0, 1, 2, 3, 4, 5, 6, 7)
#define PG8_LDA(dst, b, h) do { if constexpr (F8) { _Pragma("unroll") for (int m = 0; m < 4; ++m) dst##8[m] = PG8_LD8(lds + PG8_SA(b, h) + aoff + m * 2048); } \
        else { _Pragma("unroll") for (int m = 0; m < 4; ++m) _Pragma("unroll") for (int k = 0; k < 2; ++k) dst[m][k] = *(const PG8_LAS bf16x8*)(lds + PG8_SA(b, h) + aoff + m * 2048 + k * 1024); } } while (0)
#define PG8_LDB(dst, b, h) do { if constexpr (F8) { _Pragma("unroll") for (int n = 0; n < 2; ++n) dst##8[n] = PG8_LD8(lds + PG8_SB(b, h) + boff + n * 2048); } \
        else { _Pragma("unroll") for (int n = 0; n < 2; ++n) _Pragma("unroll") for (int k = 0; k < 2; ++k) dst[n][k] = *(const PG8_LAS bf16x8*)(lds + PG8_SB(b, h) + boff + n * 2048 + k * 1024); } } while (0)
#define PG8_MMA(ai, bj, At, Bt) do { __builtin_amdgcn_s_setprio(1); \
        if constexpr (F8) { _Pragma("unroll") for (int m = 0; m < 4; ++m) _Pragma("unroll") for (int n = 0; n < 2; ++n) \
            asm volatile("v_mfma_scale_f32_16x16x128_f8f6f4 %0, %1, %2, %0, %3, %3 op_sel_hi:[0,0,0]" : "+v"(acc[ai][bj][m][n]) : "v"(Bt##8[n]), "v"(At##8[m]), "v"(sc8_)); } \
        else { _Pragma("unroll") for (int m = 0; m < 4; ++m) _Pragma("unroll") for (int n = 0; n < 2; ++n) _Pragma("unroll") for (int k = 0; k < 2; ++k) \
            acc[ai][bj][m][n] = __builtin_amdgcn_mfma_f32_16x16x32_bf16(Bt[n][k], At[m][k], acc[ai][bj][m][n], 0, 0, 0); } \
        __builtin_amdgcn_s_setprio(0); } while (0)
#define PG8_WAIT_V(n) asm volatile("s_waitcnt vmcnt(" #n ")" ::: "memory")
#define PG8_WAIT_L(n) asm volatile("s_waitcnt lgkmcnt(" #n ")" ::: "memory")
#define PG8_BAR __builtin_amdgcn_s_barrier()
#define PG8_SCHED __builtin_amdgcn_sched_barrier(0)
    Unit cur, nxt; int ui = 0;
    if (!S.next(0, cur)) return;
    f32x4 acc[2][2][4][2];
#pragma unroll
    for (int a = 0; a < 2; ++a)
#pragma unroll
        for (int b = 0; b < 2; ++b)
#pragma unroll
            for (int m = 0; m < 4; ++m)
#pragma unroll
                for (int n = 0; n < 2; ++n) acc[a][b][m][n] = (f32x4){0.f, 0.f, 0.f, 0.f};
    const int sc8_ = 0x7F7F7F7F;
    bf16x8 At[4][2], B0[2][2], B1[2][2]; pg8_v8i32 At8[4], B08[2], B18[2];
    unsigned cA = (unsigned)cur.pm * tstep, cB = (unsigned)cur.pn * tstep;
    S.a_ready(cur);
    if constexpr (SP2) {
        PG8_STAGE(PG8_SB(0, 0), cB, voffB); PG8_STAGE(PG8_SB(0, 1), cB + hstep, voffB); PG8_STAGE(PG8_SA(0, 0), cA, voffA); PG8_STAGE(PG8_SA(0, 1), cA + hstep, voffA);
        if (wr == 1) PG8_BAR;
        PG8_WAIT_V(2); PG8_BAR;
        PG8_STAGE(PG8_SB(1, 0), cB + kstep, voffB); PG8_STAGE(PG8_SA(1, 0), cA + kstep, voffA); PG8_STAGE(PG8_SB(1, 1), cB + hstep + kstep, voffB);
        PG8_WAIT_V(6); PG8_BAR;
    } else {
        PG8_STAGE(PG8_SB(0, 0), cB, voffB); PG8_STAGE(PG8_SA(0, 0), cA, voffA); PG8_STAGE(PG8_SB(0, 1), cB + hstep, voffB); PG8_STAGE(PG8_SA(0, 1), cA + hstep, voffA);
        if (wr == 1) PG8_BAR;
        PG8_WAIT_V(4); PG8_BAR;
        PG8_STAGE(PG8_SB(1, 0), cB + kstep, voffB); PG8_STAGE(PG8_SA(1, 0), cA + kstep, voffA); PG8_STAGE(PG8_SB(1, 1), cB + hstep + kstep, voffB);
        PG8_WAIT_V(6); PG8_BAR;
    }
    for (;;) {
        const bool has_next = S.next(ui + 1, nxt);
        const unsigned nA = has_next ? (unsigned)nxt.pm * tstep : cA, nB = has_next ? (unsigned)nxt.pn * tstep : cB;
        for (int t = 0; t < nt; t += 2) {
            const bool last = (t == nt - 2);
            const unsigned a1 = cA + (unsigned)(t + 1) * kstep;
            const unsigned a2 = last ? nA : cA + (unsigned)(t + 2) * kstep, b2 = last ? nB : cB + (unsigned)(t + 2) * kstep;
            const unsigned a3 = a2 + kstep, b3 = b2 + kstep;
            if (last && has_next) S.a_ready(nxt);
            if constexpr (SP2) {
            PG8_LDB(B0, 0, 0); PG8_LDB(B1, 0, 1); PG8_SCHED; PG8_LDA(At, 0, 0); PG8_STAGE(PG8_SA(1, 1), a1 + hstep, voffA);
            PG8_WAIT_V(8); PG8_WAIT_L(0); PG8_BAR; PG8_MMA(0, 0, At, B0); PG8_MMA(0, 1, At, B1); PG8_BAR; PG8_SCHED;
            PG8_LDA(At, 0, 1); PG8_STAGE(PG8_SB(0, 0), b2, voffB); PG8_STAGE(PG8_SB(0, 1), b2 + hstep, voffB); PG8_STAGE(PG8_SA(0, 0), a2, voffA);
            PG8_WAIT_V(8); PG8_WAIT_L(0); PG8_BAR; PG8_MMA(1, 0, At, B0); PG8_MMA(1, 1, At, B1); PG8_BAR; PG8_SCHED;
            PG8_LDB(B0, 1, 0); PG8_LDB(B1, 1, 1); PG8_SCHED; PG8_LDA(At, 1, 0); PG8_STAGE(PG8_SA(0, 1), a2 + hstep, voffA);
            PG8_WAIT_V(8); PG8_WAIT_L(0); PG8_BAR; PG8_MMA(0, 0, At, B0); PG8_MMA(0, 1, At, B1); PG8_BAR; PG8_SCHED;
            PG8_LDA(At, 1, 1); PG8_STAGE(PG8_SB(1, 0), b3, voffB); PG8_STAGE(PG8_SB(1, 1), b3 + hstep, voffB); PG8_STAGE(PG8_SA(1, 0), a3, voffA);
            PG8_WAIT_V(8); PG8_WAIT_L(0); PG8_BAR; PG8_MMA(1, 0, At, B0); PG8_MMA(1, 1, At, B1); PG8_BAR; PG8_SCHED;
            } else {
            PG8_LDB(B0, 0, 0); PG8_SCHED; PG8_LDA(At, 0, 0); PG8_STAGE(PG8_SA(1, 1), a1 + hstep, voffA);
            PG8_WAIT_L(8); PG8_BAR; PG8_WAIT_L(0); PG8_MMA(0, 0, At, B0); PG8_BAR; PG8_SCHED;
            PG8_LDB(B1, 0, 1); PG8_STAGE(PG8_SB(0, 0), b2, voffB);
            PG8_BAR; PG8_WAIT_L(0); PG8_MMA(0, 1, At, B1); PG8_BAR;
            PG8_LDA(At, 0, 1); PG8_STAGE(PG8_SA(0, 0), a2, voffA);
            PG8_BAR; PG8_WAIT_L(0); PG8_MMA(1, 0, At, B0); PG8_BAR; PG8_SCHED;
            PG8_STAGE(PG8_SB(0, 1), b2 + hstep, voffB);
            PG8_WAIT_V(6); PG8_BAR; PG8_MMA(1, 1, At, B1); PG8_BAR;
            PG8_LDB(B0, 1, 0); PG8_SCHED; PG8_LDA(At, 1, 0); PG8_STAGE(PG8_SA(0, 1), a2 + hstep, voffA);
            PG8_WAIT_L(8); PG8_BAR; PG8_WAIT_L(0); PG8_MMA(0, 0, At, B0); PG8_BAR; PG8_SCHED;
            PG8_LDB(B1, 1, 1); PG8_STAGE(PG8_SB(1, 0), b3, voffB);
            PG8_BAR; PG8_WAIT_L(0); PG8_MMA(0, 1, At, B1); PG8_BAR;
            PG8_LDA(At, 1, 1); PG8_STAGE(PG8_SA(1, 0), a3, voffA);
            PG8_BAR; PG8_WAIT_L(0); PG8_MMA(1, 0, At, B0); PG8_BAR; PG8_SCHED;
            PG8_STAGE(PG8_SB(1, 1), b3 + hstep, voffB);
            PG8_WAIT_V(6); PG8_BAR; PG8_MMA(1, 1, At, B1); PG8_BAR;
            }
        }
        if constexpr (ALIGN_EPI) { if (wr == 0) PG8_BAR; }
        if constexpr (F8) asm volatile("s_nop 15\n\ts_nop 15" ::: "memory");
        if constexpr (!Epi::AFTER_DRAIN) { E(acc, cur, wr, wc, fr, fq); S.done(cur); }
        if (!has_next) break;
#pragma unroll
        for (int a = 0; a < 2; ++a)
#pragma unroll
            for (int b = 0; b < 2; ++b)
#pragma unroll
                for (int m = 0; m < 4; ++m)
#pragma unroll
                    for (int n = 0; n < 2; ++n) acc[a][b][m][n] = (f32x4){0.f, 0.f, 0.f, 0.f};
        cur = nxt; cA = nA; cB = nB; ++ui;
        if constexpr (ALIGN_EPI) { if (wr == 1) PG8_BAR; }
    }
    PG8_WAIT_V(0);
    if constexpr (!ALIGN_EPI) { if (wr == 0) PG8_BAR; }
    PG8_BAR;
    if constexpr (Epi::AFTER_DRAIN) { E.fused(acc, cur, wr, wc, fr, fq, lds, wid, lane); S.done(cur); }
#undef PG8_SA
#undef PG8_SB
#undef PG8_STAGE
#undef PG8_LDA
#undef PG8_LD8
#undef PG8_LDB
#undef PG8_MMA
#undef PG8_WAIT_V
#undef PG8_WAIT_L
#undef PG8_BAR
#undef PG8_SCHED
}
}
#define XB_TMO      128
#define XB_XCNT(j)  (256  + 64 * (j))
#define XB_XSUB(j)  (1280 + 64 * (j))
#define XB_XGEN(j)  (2304 + 64 * (j))
#define XB_TOP      3328
#define XB_TOPGEN   3392
#define XCD_BAR_WORDS 3456
#define XB_SPIN_CAP (1u << 18)
#define LAS __attribute__((address_space(3)))

__device__ __forceinline__ unsigned xb_ld(unsigned* p)              { return __hip_atomic_load(p, __ATOMIC_RELAXED, __HIP_MEMORY_SCOPE_AGENT); }
__device__ __forceinline__ unsigned xb_add(unsigned* p, unsigned v) { return __hip_atomic_fetch_add(p, v, __ATOMIC_RELAXED, __HIP_MEMORY_SCOPE_AGENT); }
__device__ __forceinline__ unsigned xb_xcc_id() { return (unsigned)__builtin_amdgcn_s_getreg((3 << 11) | 20) & 0xFu; }
#define XB_SPIN(cond, bar) do { unsigned _sp = 0; while (cond) { __builtin_amdgcn_s_sleep(1); \
    if ((++_sp & 255u) == 0u) { if (xb_ld(&(bar)[XB_TMO])) break; if (_sp > XB_SPIN_CAP) { atomicAdd(&(bar)[XB_TMO], 1u); break; } } } } while (0)

struct XcdBarrier {
    unsigned* bar; unsigned x;
    volatile LAS unsigned* st;
};

__device__ __forceinline__ XcdBarrier xcd_barrier_post(unsigned* bar, volatile LAS unsigned* st) {
    XcdBarrier b; b.bar = bar; b.x = xb_xcc_id(); b.st = st;
    if (threadIdx.x == 0) (void)xb_add(&bar[XB_XCNT(b.x)], 1u);
    return b;
}
__device__ __forceinline__ void xcd_barrier_complete(unsigned* bar, unsigned x, unsigned& nloc, unsigned& nx) {
    const unsigned G = gridDim.x * gridDim.y * gridDim.z;
    unsigned sum, cnt, mine, sp = 0u;
    for (;;) {
        sum = 0u; cnt = 0u; mine = 0u;
#pragma unroll
        for (unsigned j = 0; j < 16; ++j) { const unsigned c = xb_ld(&bar[XB_XCNT(j)]); sum += c; cnt += (c > 0u) ? 1u : 0u; mine = (j == x) ? c : mine; }
        if (sum == G) break;
        __builtin_amdgcn_s_sleep(1);
        if ((++sp & 255u) == 0u) { if (xb_ld(&bar[XB_TMO])) break; if (sp > XB_SPIN_CAP) { atomicAdd(&bar[XB_TMO], 1u); break; } }
    }
    nloc = mine > 0u ? mine : 1u; nx = cnt > 0u ? cnt : 1u;
}

__device__ __forceinline__ void xcd_barrier(const XcdBarrier& b) {
    asm volatile("s_waitcnt vmcnt(0)" ::: "memory");
    __syncthreads();
    if (threadIdx.x == 0) {
        unsigned* bar = b.bar;
        __builtin_amdgcn_s_waitcnt(0);
        unsigned nloc = b.st[0], nx = b.st[1];
        if (nloc == 0u) { xcd_barrier_complete(bar, b.x, nloc, nx); b.st[0] = nloc; b.st[1] = nx; }
        const unsigned old = xb_add(&bar[XB_XSUB(b.x)], 1u);
        const unsigned gen = old / nloc;
        if (old + 1u == (gen + 1u) * nloc) {
            __builtin_amdgcn_fence(__ATOMIC_RELEASE, "agent");
            asm volatile("s_waitcnt vmcnt(0)" ::: "memory");
            const unsigned og = xb_add(&bar[XB_TOP], 1u);
            const unsigned tg = og / nx;
            if (og + 1u == (tg + 1u) * nx) xb_add(&bar[XB_TOPGEN], 1u);
            else XB_SPIN(xb_ld(&bar[XB_TOPGEN]) == tg, bar);
            __builtin_amdgcn_fence(__ATOMIC_ACQUIRE, "agent");
            xb_add(&bar[XB_XGEN(b.x)], 1u);
            asm volatile("s_waitcnt vmcnt(0)" ::: "memory");
        } else {
            XB_SPIN(xb_ld(&bar[XB_XGEN(b.x)]) == gen, bar);
            __builtin_amdgcn_fence(__ATOMIC_ACQUIRE, "agent");
            asm volatile("s_waitcnt vmcnt(0)" ::: "memory");
        }
    }
    __syncthreads();
}

__device__ __forceinline__ void group_barrier(unsigned* bar, unsigned* ctr, unsigned target, unsigned* xmask, volatile LAS unsigned* st) {
    asm volatile("s_waitcnt vmcnt(0)" ::: "memory");
    __syncthreads();
    if (threadIdx.x == 0) {
        __builtin_amdgcn_s_waitcnt(0);
        unsigned mode = st[5];
        if (mode == 0u) { mode = (__popc(xb_ld(xmask)) == 1) ? 1u : 2u; st[5] = mode; }
        if (mode != 1u) { __builtin_amdgcn_fence(__ATOMIC_RELEASE, "agent"); asm volatile("s_waitcnt vmcnt(0)" ::: "memory"); }
        (void)xb_add(ctr, 1u);
        XB_SPIN(xb_ld(ctr) < target, bar);
        __builtin_amdgcn_fence(__ATOMIC_ACQUIRE, "agent");
        asm volatile("s_waitcnt vmcnt(0)" ::: "memory");
    }
    __syncthreads();
}

typedef unsigned short bf16;
typedef unsigned long long u64;
constexpr int NBATCH = 4, SEQ = 4096, DM = 2048, MTOK = NBATCH * SEQ, DEPTH = 4;
constexpr int N_IN = 17944, LDP = 18176;
constexpr int C_AQ = 0, C_AK = 1024, C_AV = 2048, C_AZ = 3072;
constexpr int C_NQ = 4096, C_NKC = 5120, C_NVC = 5376, C_NKS = 5632, C_NVS = 5888, C_NKW = 6144, C_NVW = 6400, C_NZ = 6656;
constexpr int C_SQ = 7680, C_SK = 8704, C_SV = 9728, C_SZ = 10752, C_NG = 11776, C_MG = 12032;
constexpr int N_BF = 12032, N_F8 = 6144;
constexpr float F8_SCALE_H = 32.f, F8_SCALE_W = 2048.f, F8_UNSCALE = 1.0f / (32.f * 2048.f);
constexpr u64 ROPE_BLOCKS = 0xFFFFull | (0x3FFull << 32) | (3ull << 44) | (3ull << 48);

constexpr size_t MiB = 1u << 20;
constexpr size_t WS_CTL = 0;
constexpr size_t CTL_BYTES = 1 * MiB;
constexpr size_t WS_ROPE = 1 * MiB;
constexpr size_t WS_MOD = 2 * MiB;
constexpr size_t WS_LAM = 3 * MiB;
constexpr size_t WS_MODP = 4 * MiB;
constexpr size_t WS_KCMP = 20 * MiB;
constexpr size_t WS_VCMP = 21 * MiB;
constexpr size_t WS_SELM = 22 * MiB;
constexpr size_t WS_W1K = 24 * MiB;
constexpr size_t WS_W1V = 28 * MiB;
constexpr size_t WS_W2K = 32 * MiB;
constexpr size_t WS_W2V = 33 * MiB;
constexpr size_t WS_WOUT = 34 * MiB;
constexpr size_t WS_WBR = 66 * MiB;
constexpr size_t WS_WIN = 114 * MiB;
constexpr size_t WS_H = 398 * MiB;
constexpr size_t WS_PROJ = 462 * MiB;
constexpr size_t WS_DIFFO = 1030 * MiB;
constexpr size_t WS_YS = 1094 * MiB;
constexpr size_t WS_OWIN = 1190 * MiB;
constexpr size_t WS_OCMP = 1222 * MiB;
constexpr size_t WS_WG8 = 1254 * MiB;
constexpr size_t WS_H8 = 1302 * MiB;
constexpr size_t WS_MERGED = 1382 * MiB;
constexpr size_t WS_OUTPRE = 1446 * MiB;
constexpr size_t WS_END = 1510 * MiB;

constexpr int CW_TMO = 0;
constexpr int CW_QUEUE = 8192;
constexpr int CW_GXM = 5632;
constexpr int CW_GRP = 5120;
constexpr int CW_BAR = 1024;

constexpr int LDS_MAIN = 131072;
constexpr int LDS_AUX = 131072;
constexpr int LDS_CTL = 147456;
constexpr int LDS_BYTES = 147712;

#define GAS __attribute__((address_space(1)))
typedef float f32x2 __attribute__((ext_vector_type(2)));
typedef unsigned u32x2 __attribute__((ext_vector_type(2)));
__device__ __forceinline__ float bf2f(unsigned short b) { return __uint_as_float(((unsigned)b) << 16); }
__device__ __forceinline__ unsigned f2bf(float f) { unsigned u = __float_as_uint(f); return (u + 0x7fffu + ((u >> 16) & 1u)) >> 16; }
__device__ __forceinline__ unsigned pk2(float lo, float hi) { unsigned r; asm volatile("v_cvt_pk_bf16_f32 %0, %1, %2" : "=v"(r) : "v"(lo), "v"(hi)); return r; }
__device__ __forceinline__ float clamp8(float x) { return fminf(fmaxf(x, -448.f), 448.f); }
__device__ __forceinline__ unsigned pk4_fp8(float a, float b, float c, float d) {
    int w = __builtin_amdgcn_cvt_pk_fp8_f32(clamp8(a), clamp8(b), 0, false); w = __builtin_amdgcn_cvt_pk_fp8_f32(clamp8(c), clamp8(d), w, true); return (unsigned)w; }
__device__ __forceinline__ float lo_bf(unsigned w) { return __uint_as_float(w << 16); }
__device__ __forceinline__ float hi_bf(unsigned w) { return __uint_as_float(w & 0xffff0000u); }
__device__ __forceinline__ float sigmoidf_(float x) { return __builtin_amdgcn_rcpf(1.0f + __builtin_amdgcn_exp2f(-1.4426950408889634f * x)); }
__device__ __forceinline__ float siluf_(float x) { return x * sigmoidf_(x); }
__device__ __forceinline__ float other_half(float x) {
    auto rr = __builtin_amdgcn_permlane32_swap(__float_as_uint(x), __float_as_uint(x), false, false);
    return __uint_as_float((__lane_id() & 32) ? rr[0] : rr[1]);
}

__device__ __forceinline__ int opaque_tid() { const int w = __builtin_amdgcn_readfirstlane((int)threadIdx.x >> 6);
    int t = w * 64 + (int)__builtin_amdgcn_mbcnt_hi(~0u, __builtin_amdgcn_mbcnt_lo(~0u, 0u)); asm volatile("" : "+v"(t)); return t; }
struct Params {
    const float* x; const float* c; const float* norm_pre_g; const float* norm_post_g; const float* w_ada; const float* b_ada; const float* w_in;
    const float* lq1; const float* lk1; const float* lq2; const float* lk2; const float* diff_norm_g;
    const float* pe_k; const float* w1_k; const float* w2_k; const float* pe_v; const float* w1_v; const float* w2_v; const float* w_branch; const float* w_out;
    float* out; unsigned char* ws;
};

namespace pg8 {
struct EpiProj {
    static constexpr bool PERM = true, AFTER_DRAIN = false;
    bf16_t* __restrict__ O; const float* __restrict__ rope;
    __device__ __forceinline__ void operator()(const f32x4 (&acc)[2][2][4][2], const Unit& u, int wr, int wc, int fr, int fq) const {
        run(acc, u, wr, wc, fr, fq); if constexpr (((PROBE_DUP_MASK) >> 15) & 1) { asm volatile("" ::: "memory"); run(acc, u, wr, wc, fr, fq); } }
    __device__ __forceinline__ void run(const f32x4 (&acc)[2][2][4][2], const Unit& u, int wr, int wc, int fr, int fq) const {
        const int row0 = u.pm * BM + wr * 64 + fr, col0 = u.pn * BM + wc * 32 + 8 * fq;
        const bool rot = wc == 0 && u.pn < 32 && ((ROPE_BLOCKS >> (2 * u.pn)) & 1ull);
        const float sg = (fq < 2) ? -1.f : 1.f;
#pragma unroll
        for (int ai = 0; ai < 2; ++ai) {
            f32x4 c0[4], c1[4], s0[4], s1[4];
            if (rot) {
#pragma unroll
                for (int m = 0; m < 4; ++m) { const float* cs = rope + (size_t)((row0 + ai * HALF + m * 16) & (SEQ - 1)) * 32 + 8 * (fq & 1);
                    c0[m] = *(const f32x4*)cs; c1[m] = *(const f32x4*)(cs + 4); s0[m] = *(const f32x4*)(cs + 16); s1[m] = *(const f32x4*)(cs + 20); }
                asm volatile("" ::: "memory");
            }
#pragma unroll
            for (int m = 0; m < 4; ++m) {
                const int row = row0 + ai * HALF + m * 16;
                bf16_t* rowp = O + (size_t)row * LDP + col0;
#pragma unroll
                for (int bj = 0; bj < 2; ++bj) {
                    f32x4 v0 = acc[ai][bj][m][0], v1 = acc[ai][bj][m][1];
                    if (rot) {
                        f32x4 o0, o1;
#pragma unroll
                        for (int j = 0; j < 4; ++j) { o0[j] = other_half(v0[j]); o1[j] = other_half(v1[j]); }
                        v0 = v0 * c0[m] + sg * (o0 * s0[m]); v1 = v1 * c1[m] + sg * (o1 * s1[m]);
                    }
                    u32x4 w; w.x = cvt_pk_bf16(v0[0], v0[1]); w.y = cvt_pk_bf16(v0[2], v0[3]); w.z = cvt_pk_bf16(v1[0], v1[1]); w.w = cvt_pk_bf16(v1[2], v1[3]);
                    *(u32x4*)(rowp + bj * HALF) = w;
                }
            }
        }
    }
};
struct EpiPlain {
    static constexpr bool PERM = true, AFTER_DRAIN = false;
    bf16_t* O; int ldc;
    __device__ __forceinline__ void operator()(const f32x4 (&acc)[2][2][4][2], const Unit& u, int wr, int wc, int fr, int fq) const {
        const int row0 = u.pm * BM + wr * 64 + fr, col0 = u.pn * BM + wc * 32 + 8 * fq;
#pragma unroll
        for (int ai = 0; ai < 2; ++ai)
#pragma unroll
            for (int m = 0; m < 4; ++m) {
                bf16_t* rowp = O + (size_t)(row0 + ai * HALF + m * 16) * ldc + col0;
#pragma unroll
                for (int bj = 0; bj < 2; ++bj) {
                    const f32x4 v0 = acc[ai][bj][m][0], v1 = acc[ai][bj][m][1];
                    u32x4 w; w.x = cvt_pk_bf16(v0[0], v0[1]); w.y = cvt_pk_bf16(v0[2], v0[3]); w.z = cvt_pk_bf16(v1[0], v1[1]); w.w = cvt_pk_bf16(v1[2], v1[3]);
                    *(u32x4*)(rowp + bj * HALF) = w;
                }
            }
    }
};
struct EpiGate8 {
    static constexpr bool PERM = true, AFTER_DRAIN = false;
    bf16_t* O;
    __device__ __forceinline__ void operator()(const f32x4 (&acc)[2][2][4][2], const Unit& u, int wr, int wc, int fr, int fq) const {
        const int row0 = u.pm * BM + wr * 64 + fr, col0 = C_MG + u.pn * BM + wc * 32 + 8 * fq;
#pragma unroll
        for (int ai = 0; ai < 2; ++ai)
#pragma unroll
            for (int m = 0; m < 4; ++m) {
                bf16_t* rowp = O + (size_t)(row0 + ai * HALF + m * 16) * LDP + col0;
#pragma unroll
                for (int bj = 0; bj < 2; ++bj) {
                    const f32x4 v0 = acc[ai][bj][m][0] * F8_UNSCALE, v1 = acc[ai][bj][m][1] * F8_UNSCALE;
                    u32x4 w; w.x = cvt_pk_bf16(v0[0], v0[1]); w.y = cvt_pk_bf16(v0[2], v0[3]); w.z = cvt_pk_bf16(v1[0], v1[1]); w.w = cvt_pk_bf16(v1[2], v1[3]);
                    *(u32x4*)(rowp + bj * HALF) = w;
                }
            }
    }
};
struct EpiBranch {
    static constexpr bool PERM = true, AFTER_DRAIN = false;
    const bf16_t* __restrict__ proj; bf16_t* merged;
    __device__ __forceinline__ void operator()(const f32x4 (&acc)[2][2][4][2], const Unit& u, int wr, int wc, int fr, int fq) const {
        const int n = u.pm >> 6, pm = u.pm & 63, pn = u.pn & 7;
        const int row0 = pm * BM + wr * 64 + fr, col0 = pn * BM + wc * 32 + 8 * fq;
        const unsigned goff = (unsigned)(row0 * LDP + C_MG + n * DM + col0) * 2u, toff = (unsigned)(row0 * DM + col0) * 2u;
#pragma unroll
        for (int ai = 0; ai < 2; ++ai) {
            u32x4 g[4][2], t[4][2];
#pragma unroll
            for (int m = 0; m < 4; ++m)
#pragma unroll
                for (int bj = 0; bj < 2; ++bj) { const int dr = ai * HALF + m * 16;
                    g[m][bj] = *(const u32x4*)((const char*)proj + goff + (unsigned)(dr * LDP + bj * HALF) * 2u);
                    if (n > 0) t[m][bj] = *(const u32x4*)((const char*)merged + toff + (unsigned)(dr * DM + bj * HALF) * 2u); }
            asm volatile("" ::: "memory");
#pragma unroll
            for (int m = 0; m < 4; ++m)
#pragma unroll
                for (int bj = 0; bj < 2; ++bj) { const int dr = ai * HALF + m * 16;
                    const u32x4 gg = g[m][bj];
                    f32x4 v0 = acc[ai][bj][m][0], v1 = acc[ai][bj][m][1];
                    v0[0] *= sigmoidf_(lo_bf(gg.x)); v0[1] *= sigmoidf_(hi_bf(gg.x)); v0[2] *= sigmoidf_(lo_bf(gg.y)); v0[3] *= sigmoidf_(hi_bf(gg.y));
                    v1[0] *= sigmoidf_(lo_bf(gg.z)); v1[1] *= sigmoidf_(hi_bf(gg.z)); v1[2] *= sigmoidf_(lo_bf(gg.w)); v1[3] *= sigmoidf_(hi_bf(gg.w));
                    if (n > 0) { const u32x4 tt = t[m][bj];
                        v0[0] += lo_bf(tt.x); v0[1] += hi_bf(tt.x); v0[2] += lo_bf(tt.y); v0[3] += hi_bf(tt.y); v1[0] += lo_bf(tt.z); v1[1] += hi_bf(tt.z); v1[2] += lo_bf(tt.w); v1[3] += hi_bf(tt.w); }
                    u32x4 w; w.x = cvt_pk_bf16(v0[0], v0[1]); w.y = cvt_pk_bf16(v0[2], v0[3]); w.z = cvt_pk_bf16(v1[0], v1[1]); w.w = cvt_pk_bf16(v1[2], v1[3]);
                    *(u32x4*)((char*)merged + toff + (unsigned)(dr * DM + bj * HALF) * 2u) = w;
                }
        }
    }
};
struct BranchOrder {
    int G, c;
    __device__ bool next(int i, Unit& u) const {
        const int ts = i / 3, n = i - ts * 3; const long L = (long)ts * G + c; constexpr int nM = 64, nN = 8, nwg = nM * nN;
        if (L >= nwg) return false;
        int wgid = (int)L; { const int q = nwg / NXCD, xcd = wgid % NXCD, off = wgid / NXCD; wgid = xcd * q + off; }
        const int nig = WGM * nN, gid = wgid / nig, fm = gid * WGM;
        u.pm = n * 64 + fm + ((wgid % nig) % WGM); u.pn = n * 8 + (wgid % nig) / WGM; return true;
    }
    __device__ __forceinline__ void a_ready(const Unit&) const {}
    __device__ __forceinline__ void done(const Unit&) const {}
};
}

typedef short bf16x8 __attribute__((ext_vector_type(8)));
typedef short s16x4 __attribute__((ext_vector_type(4)));
typedef float f32x16 __attribute__((ext_vector_type(16)));
typedef float f32x4 __attribute__((ext_vector_type(4)));
typedef unsigned u32x4 __attribute__((ext_vector_type(4)));
template <class A, class Bt> struct same_t { static constexpr bool v = false; };
template <class A> struct same_t<A, A> { static constexpr bool v = true; };
constexpr int D = 128;
constexpr float SCALE = 0.08838834764831845f;
constexpr float THR = 8.f;
constexpr int NW = 8, QBLK = 32, KVBLK = 64, QB = NW * QBLK;
constexpr int SHM_V = KVBLK * D * 2, SHM_K = KVBLK * D * 2;
#define KSWZ(row, colB) ((row) * 256 + ((colB) ^ (((row) & 7) << 4)))
#define SBAR() __builtin_amdgcn_sched_barrier(0)
__device__ __forceinline__ int v_st(int k, int c) { const int kk = (k & ~0xC) | ((k & 4) << 1) | ((k & 8) >> 1); return ((kk >> 3) * 4 + (c >> 5)) * 512 + ((kk & 7) * 32 + (c & 31)) * 2; }
__device__ __forceinline__ int v_rd_base(int lane) { return ((lane & 3) << 3) | (((lane >> 2) & 3) << 6) | (((lane >> 4) & 1) << 5) | (((lane >> 5) & 1) << 8); }
constexpr int v_rd_off(int d0, int ks, int half) { return d0 * 512 + ks * 4096 + half * 2048; }
__device__ __forceinline__ int crow(int r, int hi) { return (r & 3) + 8 * (r >> 2) + 4 * hi; }
__device__ __forceinline__ unsigned cvtpk(float lo, float hi) {
    unsigned r; asm volatile("v_cvt_pk_bf16_f32 %0, %1, %2" : "=v"(r) : "v"(lo), "v"(hi)); return r;
}
__device__ __forceinline__ bf16x8 pack8(f32x4 a, f32x4 b) {
    u32x4 w = {cvtpk(a[0], a[1]), cvtpk(a[2], a[3]), cvtpk(b[0], b[1]), cvtpk(b[2], b[3])};
    return *reinterpret_cast<bf16x8*>(&w);
}
template <class T> __device__ __forceinline__ bf16x8 load8(const T* p) {
    if constexpr (same_t<T, float>::v) { return pack8(*(const f32x4*)p, *(const f32x4*)(p + 4)); }
    else { return *reinterpret_cast<const bf16x8*>(p); }
}
__device__ __forceinline__ void mask_tile(f32x16& p0, f32x16& p1, int dq, unsigned W) {
    const float NEG = -__builtin_inff();
#pragma unroll
    for (int r = 0; r < 16; ++r) {
        const int c = (r & 3) + 8 * (r >> 2);
        if ((unsigned)(dq - c) >= W) p0[r] = NEG;
        if ((unsigned)(dq - c - 32) >= W) p1[r] = NEG;
    }
}
__device__ __forceinline__ void partialSM(f32x16& p0, f32x16& p1, float& m_reg, float& mn, float& alpha) {
    float pmax = p0[0]; for (int r = 1; r < 16; ++r) pmax = fmaxf(pmax, p0[r]); for (int r = 0; r < 16; ++r) pmax = fmaxf(pmax, p1[r]);
    { auto rr = __builtin_amdgcn_permlane32_swap(__float_as_uint(pmax), __float_as_uint(pmax), false, false);
      pmax = fmaxf(__uint_as_float(rr[0]), __uint_as_float(rr[1])); }
    constexpr float C2 = 1.4426950408889634f * SCALE;
    if (__builtin_expect(__all((pmax - m_reg) * SCALE <= THR), 1)) { mn = m_reg; alpha = 1.f; }
    else { mn = fmaxf(m_reg, pmax); alpha = __builtin_amdgcn_exp2f((m_reg - mn) * C2); m_reg = mn; }
    const float mnL = -mn * C2;
    for (int r = 0; r < 16; ++r) p0[r] = fmaf(p0[r], C2, mnL); for (int r = 0; r < 16; ++r) p1[r] = fmaf(p1[r], C2, mnL);
    for (int r = 0; r < 16; ++r) p0[r] = __builtin_amdgcn_exp2f(p0[r]);
}
__device__ __forceinline__ void finishSM(f32x16& p0, f32x16& p1, float alpha, float& l_reg, bf16x8& pa0, bf16x8& pa1, bf16x8& pa2, bf16x8& pa3) {
    for (int r = 0; r < 16; ++r) p1[r] = __builtin_amdgcn_exp2f(p1[r]);
    float ps = 0; for (int r = 0; r < 16; ++r) ps += p0[r]; for (int r = 0; r < 16; ++r) ps += p1[r];
    { auto rr = __builtin_amdgcn_permlane32_swap(__float_as_uint(ps), __float_as_uint(ps), false, false);
      ps = __uint_as_float(rr[0]) + __uint_as_float(rr[1]); }
    l_reg = l_reg * alpha + ps;
#define PK4(P, B_, OUT) do { unsigned a0 = cvtpk(P[B_+0], P[B_+1]), a1 = cvtpk(P[B_+2], P[B_+3]);                          \
        unsigned b0 = cvtpk(P[B_+4], P[B_+5]), b1 = cvtpk(P[B_+6], P[B_+7]);                                             \
        auto r0 = __builtin_amdgcn_permlane32_swap(a0, b0, false, false); auto r1 = __builtin_amdgcn_permlane32_swap(a1, b1, false, false); \
        u32x4 w = {r0[0], r1[0], r0[1], r1[1]}; OUT = *reinterpret_cast<bf16x8*>(&w); } while (0)
    PK4(p0, 0, pa0); PK4(p0, 8, pa1); PK4(p1, 0, pa2); PK4(p1, 8, pa3);
#undef PK4
}
template <int KB, bool SK>
__device__ __forceinline__ void qkt(f32x16& p0, f32x16& p1, const char* K_lds, int r32, int hi, const bf16x8* qr, bool act) {
    if (SK && !act) { const float NEG = -__builtin_inff();
#pragma unroll
        for (int r = 0; r < 16; ++r) { p0[r] = NEG; p1[r] = NEG; } return; }
    p0 = f32x16{}; p1 = f32x16{};
    const char* kb[4];
#pragma unroll
    for (int dd = 0; dd < 4; ++dd) kb[dd] = K_lds + KB * SHM_K + KSWZ(r32, (dd * 16 + hi * 8) * 2);
#pragma unroll
    for (int d0 = 0; d0 < 8; ++d0) { const char* a = kb[d0 & 3] + (d0 >> 2) * 128;
        bf16x8 b0 = *reinterpret_cast<const bf16x8*>(a);
        bf16x8 b1 = *reinterpret_cast<const bf16x8*>(a + 32 * 256);
        p0 = __builtin_amdgcn_mfma_f32_32x32x16_bf16(b0, qr[d0], p0, 0, 0, 0);
        p1 = __builtin_amdgcn_mfma_f32_32x32x16_bf16(b1, qr[d0], p1, 0, 0, 0); }
}
template <int VB, bool SK>
__device__ __forceinline__ void pv_tile(f32x16* o, int vb0, bf16x8 pa0, bf16x8 pa1, bf16x8 pa2, bf16x8 pa3, bool act) {
    if (SK && !act) return;
#define TRRD(dst, off) asm volatile("ds_read_b64_tr_b16 %0, %1 offset:%2" : "=&v"(dst) : "v"(vb0), "i"(off) : "memory")
#define PV_D0(d0) do { s16x4 l0, l1, l2, l3, h0, h1, h2, h3; constexpr int b_ = VB * SHM_V + v_rd_off(d0, 0, 0);     \
        TRRD(l0, b_); TRRD(h0, b_ + 2048); TRRD(l1, b_ + 4096); TRRD(h1, b_ + 6144); TRRD(l2, b_ + 8192); TRRD(h2, b_ + 10240); TRRD(l3, b_ + 12288); TRRD(h3, b_ + 14336); \
        asm volatile("s_waitcnt lgkmcnt(0)" ::: "memory"); SBAR();                 \
        o[d0] = __builtin_amdgcn_mfma_f32_32x32x16_bf16(pa0, (bf16x8){l0[0], l0[1], l0[2], l0[3], h0[0], h0[1], h0[2], h0[3]}, o[d0], 0, 0, 0);   \
        o[d0] = __builtin_amdgcn_mfma_f32_32x32x16_bf16(pa1, (bf16x8){l1[0], l1[1], l1[2], l1[3], h1[0], h1[1], h1[2], h1[3]}, o[d0], 0, 0, 0);   \
        o[d0] = __builtin_amdgcn_mfma_f32_32x32x16_bf16(pa2, (bf16x8){l2[0], l2[1], l2[2], l2[3], h2[0], h2[1], h2[2], h2[3]}, o[d0], 0, 0, 0);   \
        o[d0] = __builtin_amdgcn_mfma_f32_32x32x16_bf16(pa3, (bf16x8){l3[0], l3[1], l3[2], l3[3], h3[0], h3[1], h3[2], h3[3]}, o[d0], 0, 0, 0); } while (0)
    PV_D0(0); PV_D0(1); PV_D0(2); PV_D0(3);
#undef PV_D0
#undef TRRD
}

__device__ __forceinline__ bf16x8 ld8(const bf16* p) { return *reinterpret_cast<const bf16x8*>(p); }
__device__ __forceinline__ bf16x8 bload8(const void* base, unsigned voff, unsigned soff) {
    const __amdgpu_buffer_rsrc_t r = __builtin_amdgcn_make_buffer_rsrc((void*)base, 0, 0x7fffffff, 0x00020000);
    u32x4 v = __builtin_amdgcn_raw_buffer_load_b128(r, (int)voff, (int)soff, 0);
    return *reinterpret_cast<bf16x8*>(&v);
}

struct BlockRef { const bf16* Q; const bf16* K; const bf16* V; const u64* M; int P0; int row0; int aux; int aux2; };
struct Seam { bf16x8 qr[8]; bf16x8 st_v0, st_v1, st_k0, st_k1; };
__device__ __forceinline__ int swa_jlo(int P0, int W) { const int lowk = P0 - W + 1; return lowk > 0 ? lowk / KVBLK : 0; }
#define TILEP(p, k0) ((const char*)(p) + (size_t)(k0) * (LDP * 2))
#define VMW() asm volatile("s_waitcnt vmcnt(0)" ::: "memory")
#define VMWN(n) asm volatile("s_waitcnt vmcnt(%0)" :: "i"(n) : "memory")
#define SLOAD_H(Kp, Vp, k0) do { const unsigned so_ = (unsigned)(k0) * (LDP * 2u);                                   \
                         S.st_v0 = bload8(Vp, roff0, so_); S.st_v1 = bload8(Vp, roff0, so_ + 32u * LDP * 2u);              \
                         S.st_k0 = bload8(Kp, roff0, so_); S.st_k1 = bload8(Kp, roff0, so_ + 32u * LDP * 2u); } while (0)
#define SWRITE_HK(bf) do { *(bf16x8*)(K_lds + (bf) * SHM_K + kws) = S.st_k0; *(bf16x8*)(K_lds + (bf) * SHM_K + kws + 32 * 256) = S.st_k1; } while (0)
#define SWRITE_HV(bf) do { *(bf16x8*)(V_lds + (bf) * SHM_V + vst0) = S.st_v0; *(bf16x8*)(V_lds + (bf) * SHM_V + vst1) = S.st_v1; } while (0)
#define SWRITE_H(bf) do { SWRITE_HV(bf); SWRITE_HK(bf); } while (0)
__device__ __forceinline__ void attn_prime(const BlockRef& cur, int W, char* lds, Seam& S) {
    const int tid = opaque_tid(), wid = __builtin_amdgcn_readfirstlane(tid >> 6), lane = tid & 63, r32 = lane & 31, hi = lane >> 5;
    const int sr = tid >> 4, sc = (tid & 15) * 8, kws = KSWZ(sr, sc * 2); char* K_lds = lds + 2 * SHM_V;
    const unsigned roff0 = (unsigned)(sr * LDP + sc) * 2u, qoff = (unsigned)(r32 * LDP + hi * 8) * 2u;
    const int kb0 = swa_jlo(cur.P0, W) * KVBLK;
    { const unsigned qs_ = (unsigned)(wid * QBLK) * (LDP * 2u);
#pragma unroll
    for (int d0 = 0; d0 < 8; ++d0) S.qr[d0] = bload8(cur.Q, qoff + d0 * 32, qs_); }
    SLOAD_H(cur.K, cur.V, kb0); VMW(); SWRITE_HK(0);
    __syncthreads();
}

__device__ __forceinline__ void partialSM_sel(f32x16& p0, f32x16& p1, float& m_reg, float& mn, float& alpha, bool sel) {
    const float NEG = -__builtin_inff();
    float pmax = p0[0]; for (int r = 1; r < 16; ++r) pmax = fmaxf(pmax, p0[r]); for (int r = 0; r < 16; ++r) pmax = fmaxf(pmax, p1[r]);
    { auto rr = __builtin_amdgcn_permlane32_swap(__float_as_uint(pmax), __float_as_uint(pmax), false, false);
      pmax = fmaxf(__uint_as_float(rr[0]), __uint_as_float(rr[1])); }
    pmax = sel ? pmax : NEG;
    constexpr float C2 = 1.4426950408889634f * SCALE;
    if (__builtin_expect(__all((pmax - m_reg) * SCALE <= THR), 1)) { mn = m_reg; alpha = 1.f; }
    else { mn = fmaxf(m_reg, pmax); alpha = __builtin_amdgcn_exp2f((m_reg - mn) * C2); m_reg = mn; }
    const float mnL = sel ? -mn * C2 : NEG;
    for (int r = 0; r < 16; ++r) p0[r] = fmaf(p0[r], C2, mnL); for (int r = 0; r < 16; ++r) p1[r] = fmaf(p1[r], C2, mnL);
    for (int r = 0; r < 16; ++r) p0[r] = __builtin_amdgcn_exp2f(p0[r]);
}
template <bool SK, bool SLC, class Epi>
__device__ __forceinline__ void attn_block(const BlockRef& cur, const BlockRef& nxt, int skv, int W, char* lds, Seam& S, const Epi& E) {
    const int tid = opaque_tid(), wid = __builtin_amdgcn_readfirstlane(tid >> 6), lane = tid & 63, r32 = lane & 31, hi = lane >> 5;
    const int j_lo = swa_jlo(cur.P0, W);
    int j_hi = (cur.P0 + QB - 1) / KVBLK + 1; if (j_hi > skv / KVBLK) j_hi = skv / KVBLK;
    const int NT = j_hi - j_lo;
    const int kbn = swa_jlo(nxt.P0, W) * KVBLK;
    const int qlo = cur.P0 + wid * QBLK, qm = qlo + r32 - 4 * hi;
    char* V_lds = lds; char* K_lds = lds + 2 * SHM_V;
    float* ws = (float*)(lds + 2 * SHM_V + 2 * SHM_K) + wid * 64; float* li_l = ws, * al_l = ws + 32;
    float m_reg = -1e30f, l_reg = 0; f32x16 o[4] = {};
    const int sr = tid >> 4, sc = (tid & 15) * 8, vst0 = v_st(sr, sc), vst1 = vst0 + 8192, kws = KSWZ(sr, sc * 2);
    const unsigned roff0 = (unsigned)(sr * LDP + sc) * 2u, qoff = (unsigned)(r32 * LDP + hi * 8) * 2u;
    const int vb0 = (int)(uintptr_t)V_lds + v_rd_base(lane);
    const bf16* Kh = cur.K; const bf16* Vh = cur.V;
    u64 rowmask = ~0ull; if constexpr (SLC) rowmask = cur.M[cur.P0 + wid * QBLK + r32];
#define RESC(a) do { if (__any((a) < 1.f)) { if (hi == 0) al_l[r32] = (a); asm volatile("s_waitcnt lgkmcnt(0)" ::: "memory");              \
                     for (int d_ = 0; d_ < 4; ++d_) for (int r = 0; r < 16; ++r) o[d_][r] *= al_l[crow(r, hi)]; } } while (0)
#define KBASE(t) ((j_lo + (t)) * KVBLK)
#define ACT(t) (KBASE(t) <= qlo + QBLK - 1 && KBASE(t) + KVBLK - 1 >= qlo - W + 1)
#define MASKT(P0_, P1_, t) do { const int kb_ = KBASE(t); if ((!SK || ACT(t)) && (kb_ + KVBLK - 1 > qlo || kb_ <= qlo + QBLK - 1 - W)) mask_tile(P0_, P1_, qm - kb_, (unsigned)W); } while (0)
#define PSM(P0_, P1_, mn_, al_, t) do { if constexpr (SLC) partialSM_sel(P0_, P1_, m_reg, mn_, al_, ((rowmask >> (j_lo + (t))) & 1ull) != 0ull); else partialSM(P0_, P1_, m_reg, mn_, al_); } while (0)
    constexpr int NQL = 8;
#define SEAM_K0() do { VMWN(NQL); SWRITE_HK(0); SBAR(); } while (0)
    f32x16 pA0, pA1, pB0, pB1; float mnA, mnB, alA, alB; bf16x8 pa0, pa1, pa2, pa3;
    SWRITE_HV(0); SBAR();
    if (NT > 1) { SLOAD_H(Kh, Vh, KBASE(1)); }
    SBAR(); qkt<0, SK>(pA0, pA1, K_lds, r32, hi, S.qr, ACT(0));
    MASKT(pA0, pA1, 0); PSM(pA0, pA1, mnA, alA, 0);
    if (NT > 1) { VMW(); SWRITE_H(1); }
    __syncthreads();
#define HALF_STEP(PX0, PX1, mnX, alX, PY0, PY1, alY, t, KB, VB, SB) do {                                                      \
        SBAR(); qkt<KB, SK>(PX0, PX1, K_lds, r32, hi, S.qr, ACT(t));                                             \
        finishSM(PY0, PY1, alY, l_reg, pa0, pa1, pa2, pa3); SBAR();                                                           \
        if ((t) + 1 < NT) { SLOAD_H(Kh, Vh, KBASE((t) + 1)); SBAR(); }                                               \
        pv_tile<VB, SK>(o, vb0, pa0, pa1, pa2, pa3, ACT((t) - 1)); MASKT(PX0, PX1, (t)); PSM(PX0, PX1, mnX, alX, (t));                                        \
        __syncthreads();                                                                                                      \
        if ((t) + 1 < NT) { VMW(); SWRITE_H(SB); }                                                                          \
        RESC(alX); __syncthreads(); } while (0)
    for (int t = 1; t + 1 < NT; t += 2) {
        HALF_STEP(pB0, pB1, mnB, alB, pA0, pA1, alA, t, 1, 0, 0);
        HALF_STEP(pA0, pA1, mnA, alA, pB0, pB1, alB, t + 1, 0, 1, 1);
    }
    const bool even = (NT & 1) == 0;
    if (even) { SBAR(); qkt<1, SK>(pB0, pB1, K_lds, r32, hi, S.qr, ACT(NT - 1)); SBAR(); }
    SLOAD_H(nxt.K, nxt.V, kbn); SBAR();
    { const unsigned qs_ = (unsigned)(wid * QBLK) * (LDP * 2u);
#pragma unroll
    for (int d0 = 0; d0 < 8; ++d0) S.qr[d0] = bload8(nxt.Q, qoff + d0 * 32, qs_); }
    SBAR();
    finishSM(pA0, pA1, alA, l_reg, pa0, pa1, pa2, pa3); SBAR();
    pv_tile<0, SK>(o, vb0, pa0, pa1, pa2, pa3, ACT(even ? NT - 2 : NT - 1));
    if (even) { MASKT(pB0, pB1, NT - 1); PSM(pB0, pB1, mnB, alB, NT - 1); __syncthreads(); RESC(alB);
        finishSM(pB0, pB1, alB, l_reg, pa0, pa1, pa2, pa3); SBAR(); pv_tile<1, SK>(o, vb0, pa0, pa1, pa2, pa3, ACT(NT - 1)); }
    SBAR(); SEAM_K0();
    if (hi == 0) li_l[r32] = l_reg; asm volatile("s_waitcnt lgkmcnt(0)" ::: "memory");
    float rli[16];
#pragma unroll
    for (int r = 0; r < 16; ++r) rli[r] = __builtin_amdgcn_rcpf(li_l[crow(r, hi)]);
    E(o, rli, cur, wid, r32, hi);
    __syncthreads();
#undef RESC
#undef KBASE
#undef ACT
#undef MASKT
#undef PSM
#undef SEAM_K0
#undef HALF_STEP
}


constexpr int OST_PITCH = 272, OST_WAVE = 32 * OST_PITCH, OST_BASE = 73728;
__device__ __forceinline__ void ost_put(char* scr, const f32x16* o, const float (&sc)[16], int r32, int hi) {
#pragma unroll
    for (int r = 0; r < 16; r += 2) {
        char* rp = scr + crow(r, hi) * OST_PITCH + r32 * 2;
#pragma unroll
        for (int d0 = 0; d0 < 4; ++d0) { const unsigned w = cvtpk(o[d0][r] * sc[r], o[d0][r + 1] * sc[r + 1]);
            *(unsigned short*)(rp + d0 * 64) = (unsigned short)w; *(unsigned short*)(rp + OST_PITCH + d0 * 64) = (unsigned short)(w >> 16); }
    }
}
__device__ __forceinline__ u32x4 ost_get(const char* scr, int q, int lane) { return *(const u32x4*)(scr + (q * 4 + (lane >> 4)) * OST_PITCH + (lane & 15) * 16); }

struct EpiAttnStore {
    bf16* O; int ldo; char* lds;
    __device__ __forceinline__ void operator()(const f32x16 (&o)[4], const float (&rli)[16], const BlockRef& cur, int wid, int r32, int hi) const {
        int lane = hi * 32 + r32; asm volatile("" : "+v"(lane));
        char* scr = lds + OST_BASE + wid * OST_WAVE;
        ost_put(scr, o, rli, r32, hi);
        char* Ow = (char*)(O + (size_t)(cur.row0 + wid * QBLK) * ldo + cur.aux);
        const unsigned loff = (unsigned)((lane >> 4) * ldo + (lane & 15) * 8) * 2u;
#pragma unroll
        for (int q = 0; q < 8; ++q) *(u32x4*)(Ow + (size_t)(q * 4 * ldo) * 2 + loff) = ost_get(scr, q, lane);
    }
};
struct EpiNsaCombine {
    const bf16* __restrict__ proj; const bf16* __restrict__ ocmp; const bf16* __restrict__ owin; bf16* __restrict__ ys; char* lds;
    __device__ __forceinline__ void operator()(const f32x16 (&o)[4], const float (&rli)[16], const BlockRef& cur, int wid, int r32, int hi) const {
        int lane = hi * 32 + r32; asm volatile("" : "+v"(lane));
        char* scr = lds + OST_BASE + wid * OST_WAVE;
        ost_put(scr, o, rli, r32, hi);
        const int rowb = cur.row0 + wid * QBLK + (lane >> 4), colb = cur.aux + (lane & 15) * 8;
#pragma unroll
        for (int qh = 0; qh < 2; ++qh) {
            u32x4 oc[4], ow[4], zz[4]; unsigned short gq[4][3];
#pragma unroll
            for (int qi = 0; qi < 4; ++qi) { const size_t row = (size_t)(rowb + (qh * 4 + qi) * 4);
                oc[qi] = *(const u32x4*)(ocmp + row * 1024 + colb); ow[qi] = *(const u32x4*)(owin + row * 1024 + colb); zz[qi] = *(const u32x4*)(proj + row * LDP + C_NZ + colb);
                const bf16* gp = proj + row * LDP + C_NG + cur.aux2 * 3; gq[qi][0] = gp[0]; gq[qi][1] = gp[1]; gq[qi][2] = gp[2]; }
            asm volatile("" ::: "memory");
#pragma unroll
            for (int qi = 0; qi < 4; ++qi) { const size_t row = (size_t)(rowb + (qh * 4 + qi) * 4);
                const u32x4 os = ost_get(scr, qh * 4 + qi, lane);
                const float g0 = sigmoidf_(bf2f(gq[qi][0])), g1 = sigmoidf_(bf2f(gq[qi][1])), g2 = sigmoidf_(bf2f(gq[qi][2]));
                const unsigned ocw[4] = {oc[qi].x, oc[qi].y, oc[qi].z, oc[qi].w}, oww[4] = {ow[qi].x, ow[qi].y, ow[qi].z, ow[qi].w}, zw[4] = {zz[qi].x, zz[qi].y, zz[qi].z, zz[qi].w}, osw[4] = {os.x, os.y, os.z, os.w};
                unsigned res[4];
#pragma unroll
                for (int j = 0; j < 4; ++j) {
                    const float a = (g0 * lo_bf(ocw[j]) + g1 * lo_bf(osw[j]) + g2 * lo_bf(oww[j])) * siluf_(lo_bf(zw[j]));
                    const float b2 = (g0 * hi_bf(ocw[j]) + g1 * hi_bf(osw[j]) + g2 * hi_bf(oww[j])) * siluf_(hi_bf(zw[j]));
                    res[j] = cvtpk(a, b2); }
                *(u32x4*)(ys + row * 1024 + colb) = (u32x4){res[0], res[1], res[2], res[3]}; }
        }
    }
};

template <class Epi>
__device__ __forceinline__ void sb_block(const BlockRef& cur, char* lds, const Epi& E) {
    const int tid = opaque_tid(), wid = __builtin_amdgcn_readfirstlane(tid >> 6), lane = tid & 63, r32 = lane & 31, hi = lane >> 5;
    char* V_lds = lds; char* K_lds = lds + 2 * SHM_V;
    volatile unsigned* flags = (volatile unsigned*)(lds + 2 * SHM_V + 2 * SHM_K + 4096);
    const int sr = tid >> 4, sc = (tid & 15) * 8, vst0 = v_st(sr, sc), vst1 = vst0 + 8192, kws = KSWZ(sr, sc * 2);
    const unsigned roff0 = (unsigned)(sr * LDP + sc) * 2u, qoff = (unsigned)(r32 * LDP + hi * 8) * 2u;
    const int vb0 = (int)(uintptr_t)V_lds + v_rd_base(lane);
    const int qlo = cur.P0 + wid * QBLK, qpos = qlo + r32;
    const int j_hi = cur.P0 / KVBLK + 4;
    Seam S;
    { const unsigned qs_ = (unsigned)(wid * QBLK) * (LDP * 2u);
#pragma unroll
    for (int d0 = 0; d0 < 8; ++d0) S.qr[d0] = bload8(cur.Q, qoff + d0 * 32, qs_); }
    SLOAD_H(cur.K, cur.V, (j_hi - 1) * KVBLK); VMW(); SWRITE_H(0);
    if (tid < 16) flags[tid] = 0u;
    __syncthreads();
    float carry = 1.f; f32x16 o[4] = {}; bool wdone = false; int buf = 0, par = 0;
    for (int j = j_hi - 1; j >= 0; --j) {
        const int kb = j * KVBLK;
        if (j > 0) { SLOAD_H(cur.K, cur.V, kb - KVBLK); }
        const bool act = (kb < qlo + QBLK - 1) && !wdone;
        if (act) {
            f32x16 p0, p1;
            qkt<0, false>(p0, p1, K_lds + buf * SHM_K, r32, hi, S.qr, true);
            const int dq = qpos - kb - 4 * hi;
            f32x16 f0, f1;
#pragma unroll
            for (int r = 0; r < 16; ++r) {
                const int c = (r & 3) + 8 * (r >> 2);
                const float u0 = __builtin_amdgcn_exp2f(fminf(p0[r] * SCALE, 80.f) * 1.4426950408889634f), u1 = __builtin_amdgcn_exp2f(fminf(p1[r] * SCALE, 80.f) * 1.4426950408889634f);
                const float r0 = __builtin_amdgcn_rcpf(1.0f + u0), r1 = __builtin_amdgcn_rcpf(1.0f + u1);
                const bool s0 = c < dq, s1 = c + 32 < dq;
                f0[r] = s0 ? r0 : 1.f; f1[r] = s1 ? r1 : 1.f;
                p0[r] = s0 ? u0 * r0 : 0.f; p1[r] = s1 ? u1 * r1 : 0.f;
            }
            float T[8];
#pragma unroll
            for (int k = 0; k < 4; ++k) {
                { const float e2 = f0[4 * k + 3], e1 = f0[4 * k + 2] * e2, e0 = f0[4 * k + 1] * e1; T[k] = f0[4 * k] * e0; f0[4 * k + 3] = 1.f; f0[4 * k + 2] = e2; f0[4 * k + 1] = e1; f0[4 * k] = e0; }
                { const float e2 = f1[4 * k + 3], e1 = f1[4 * k + 2] * e2, e0 = f1[4 * k + 1] * e1; T[4 + k] = f1[4 * k] * e0; f1[4 * k + 3] = 1.f; f1[4 * k + 2] = e2; f1[4 * k + 1] = e1; f1[4 * k] = e0; }
            }
            float R = 1.f;
#pragma unroll
            for (int k = 7; k >= 0; --k) {
                auto rr = __builtin_amdgcn_permlane32_swap(__float_as_uint(T[k]), __float_as_uint(T[k]), false, false);
                const float tlo = __uint_as_float(rr[0]), thi = __uint_as_float(rr[1]);
                const float base = carry * R * (hi == 0 ? thi : 1.f);
                if (k < 4) { p0[4 * k] *= f0[4 * k] * base; p0[4 * k + 1] *= f0[4 * k + 1] * base; p0[4 * k + 2] *= f0[4 * k + 2] * base; p0[4 * k + 3] *= base; }
                else { p1[4 * (k - 4)] *= f1[4 * (k - 4)] * base; p1[4 * (k - 4) + 1] *= f1[4 * (k - 4) + 1] * base; p1[4 * (k - 4) + 2] *= f1[4 * (k - 4) + 2] * base; p1[4 * (k - 4) + 3] *= base; }
                R *= tlo * thi;
            }
            carry *= R;
            bf16x8 pa0, pa1, pa2, pa3;
#define PK4(P, B_, OUT) do { unsigned a0 = cvtpk(P[B_+0], P[B_+1]), a1 = cvtpk(P[B_+2], P[B_+3]);                          \
        unsigned b0 = cvtpk(P[B_+4], P[B_+5]), b1 = cvtpk(P[B_+6], P[B_+7]);                                             \
        auto r0 = __builtin_amdgcn_permlane32_swap(a0, b0, false, false); auto r1 = __builtin_amdgcn_permlane32_swap(a1, b1, false, false); \
        u32x4 w = {r0[0], r1[0], r0[1], r1[1]}; OUT = *reinterpret_cast<bf16x8*>(&w); } while (0)
            PK4(p0, 0, pa0); PK4(p0, 8, pa1); PK4(p1, 0, pa2); PK4(p1, 8, pa3);
            pv_tile<0, false>(o, vb0 + buf * SHM_V, pa0, pa1, pa2, pa3, true);
            if (__all(carry == 0.f)) wdone = true;
        }
        if (lane == 0) flags[par * 8 + wid] = wdone ? 1u : 0u;
        if (j > 0) { VMW(); if (buf == 0) { SWRITE_H(1); } else { SWRITE_H(0); } }
        __syncthreads();
        unsigned alld = 1u;
#pragma unroll
        for (int w = 0; w < 8; ++w) alld &= flags[par * 8 + w];
        if (alld) break;
        buf ^= 1; par ^= 1;
    }
    float rli[16];
#pragma unroll
    for (int r = 0; r < 16; ++r) rli[r] = 1.f;
    E(o, rli, cur, wid, r32, hi);
    __syncthreads();
}
struct EpiSb {
    const bf16* __restrict__ proj; bf16* __restrict__ ys; char* lds;
    __device__ __forceinline__ void put(const f32x16 (&o)[4], int row_w, int col0, char* scr, int r32, int hi) const {
        int lane = hi * 32 + r32; asm volatile("" : "+v"(lane));
        float one[16];
#pragma unroll
        for (int r = 0; r < 16; ++r) one[r] = 1.f;
        ost_put(scr, o, one, r32, hi);
        const int rowb = row_w + (lane >> 4), colb = col0 + (lane & 15) * 8;
        u32x4 zz[8];
#pragma unroll
        for (int q = 0; q < 8; ++q) zz[q] = *(const u32x4*)(proj + (size_t)(rowb + q * 4) * LDP + C_SZ + colb);
        asm volatile("" ::: "memory");
#pragma unroll
        for (int q = 0; q < 8; ++q) { const u32x4 os = ost_get(scr, q, lane);
            const unsigned zw[4] = {zz[q].x, zz[q].y, zz[q].z, zz[q].w}, osw[4] = {os.x, os.y, os.z, os.w}; unsigned res[4];
#pragma unroll
            for (int j = 0; j < 4; ++j) res[j] = cvtpk(lo_bf(osw[j]) * siluf_(lo_bf(zw[j])), hi_bf(osw[j]) * siluf_(hi_bf(zw[j])));
            *(u32x4*)(ys + (size_t)(rowb + q * 4) * 1024 + colb) = (u32x4){res[0], res[1], res[2], res[3]}; }
    }
    __device__ __forceinline__ void operator()(const f32x16 (&o)[4], const float (&rli)[16], const BlockRef& cur, int wid, int r32, int hi) const {
        put(o, cur.row0 + wid * QBLK, cur.aux, lds + OST_BASE + wid * OST_WAVE, r32, hi);
    }
};

__device__ __forceinline__ void glds16(const void* gsrc, char* lds_dst) {
    __builtin_amdgcn_global_load_lds((const unsigned*)gsrc, (__attribute__((address_space(3))) unsigned*)lds_dst, 16, 0, 0);
}

__device__ __forceinline__ void pv_tile256(f32x16* o, int vbA, int vbB, bf16x8 pa0, bf16x8 pa1, bf16x8 pa2, bf16x8 pa3) {
#define TRR(dst, base, off) asm volatile("ds_read_b64_tr_b16 %0, %1 offset:%2" : "=&v"(dst) : "v"(base), "i"(off) : "memory")
#define PV_LOAD(S, base, d0) do { constexpr int b_ = v_rd_off(d0, 0, 0); \
        TRR(S[0], base, b_); TRR(S[1], base, b_ + 2048); TRR(S[2], base, b_ + 4096); TRR(S[3], base, b_ + 6144); TRR(S[4], base, b_ + 8192); TRR(S[5], base, b_ + 10240); TRR(S[6], base, b_ + 12288); TRR(S[7], base, b_ + 14336); } while (0)
#define PV_MMA(S, acc) do { \
        acc = __builtin_amdgcn_mfma_f32_32x32x16_bf16(pa0, (bf16x8){S[0][0], S[0][1], S[0][2], S[0][3], S[1][0], S[1][1], S[1][2], S[1][3]}, acc, 0, 0, 0); \
        acc = __builtin_amdgcn_mfma_f32_32x32x16_bf16(pa1, (bf16x8){S[2][0], S[2][1], S[2][2], S[2][3], S[3][0], S[3][1], S[3][2], S[3][3]}, acc, 0, 0, 0); \
        acc = __builtin_amdgcn_mfma_f32_32x32x16_bf16(pa2, (bf16x8){S[4][0], S[4][1], S[4][2], S[4][3], S[5][0], S[5][1], S[5][2], S[5][3]}, acc, 0, 0, 0); \
        acc = __builtin_amdgcn_mfma_f32_32x32x16_bf16(pa3, (bf16x8){S[6][0], S[6][1], S[6][2], S[6][3], S[7][0], S[7][1], S[7][2], S[7][3]}, acc, 0, 0, 0); } while (0)
#define PV_W8() do { asm volatile("s_waitcnt lgkmcnt(8)" ::: "memory"); SBAR(); } while (0)
    s16x4 X[8], Y[8];
    asm volatile("s_waitcnt lgkmcnt(0)" ::: "memory");
    PV_LOAD(X, vbA, 0);
    PV_LOAD(Y, vbA, 1); PV_W8(); PV_MMA(X, o[0]);
    PV_LOAD(X, vbA, 2); PV_W8(); PV_MMA(Y, o[1]);
    PV_LOAD(Y, vbA, 3); PV_W8(); PV_MMA(X, o[2]);
    PV_LOAD(X, vbB, 0); PV_W8(); PV_MMA(Y, o[3]);
    PV_LOAD(Y, vbB, 1); PV_W8(); PV_MMA(X, o[4]);
    PV_LOAD(X, vbB, 2); PV_W8(); PV_MMA(Y, o[5]);
    PV_LOAD(Y, vbB, 3); PV_W8(); PV_MMA(X, o[6]);
    asm volatile("s_waitcnt lgkmcnt(0)" ::: "memory"); SBAR(); PV_MMA(Y, o[7]);
#undef TRR
#undef PV_LOAD
#undef PV_MMA
#undef PV_W8
}
__device__ __forceinline__ void diff_block(const BlockRef& cur, bf16* __restrict__ O, char* lds) {
    const int tid = opaque_tid(), wid = __builtin_amdgcn_readfirstlane(tid >> 6), lane = tid & 63, r32 = lane & 31, hi = lane >> 5;
    char* V_lds = lds; char* K_lds = lds + 4 * SHM_V;
    float* ws = (float*)(lds + 4 * SHM_V + 2 * SHM_K) + wid * 64; float* li_l = ws, * al_l = ws + 32;
    const int vb0 = (int)(uintptr_t)V_lds + v_rd_base(lane);
    const int qlo = cur.P0 + wid * QBLK, qm = qlo + r32 - 4 * hi;
    const int NT = cur.P0 / KVBLK + 4;
    unsigned koff[2], voff[2];
#pragma unroll
    for (int i = 0; i < 2; ++i) {
        const int q = i * 8 + wid;
        { const int row = q * 4 + (lane >> 4), ch = (lane & 15) ^ (row & 7); koff[i] = (unsigned)(row * LDP * 2 + ch * 16); }
        { const int sub = q * 2 + (lane >> 5), kk = (sub >> 2) * 8 + ((lane & 31) >> 2), c = (sub & 3) * 32 + (lane & 3) * 8;
          const int k = (kk & ~0xC) | ((kk & 4) << 1) | ((kk & 8) >> 1); voff[i] = (unsigned)(k * LDP * 2 + c * 2); }
    }
#define DIFF_STAGE(t_, b_) do { const char* kq_ = (const char*)cur.K + (size_t)(t_) * KVBLK * (LDP * 2); const char* vq_ = (const char*)cur.V + (size_t)(t_) * KVBLK * (LDP * 2); \
        _Pragma("unroll") for (int i_ = 0; i_ < 2; ++i_) { \
            glds16(kq_ + koff[i_], K_lds + (b_) * SHM_K + (i_ * 8 + wid) * 1024); \
            glds16(vq_ + voff[i_], V_lds + ((b_) * 2) * SHM_V + (i_ * 8 + wid) * 1024); \
            glds16(vq_ + 256 + voff[i_], V_lds + ((b_) * 2 + 1) * SHM_V + (i_ * 8 + wid) * 1024); } } while (0)
    bf16x8 qr[8];
    { const unsigned qoff = (unsigned)(r32 * LDP + hi * 8) * 2u, qs_ = (unsigned)(wid * QBLK) * (LDP * 2u);
#pragma unroll
      for (int d0 = 0; d0 < 8; ++d0) qr[d0] = bload8(cur.Q, qoff + d0 * 32, qs_); }
    DIFF_STAGE(0, 0);
    asm volatile("s_waitcnt vmcnt(0)" ::: "memory");
    __syncthreads();
    float m_reg = -1e30f, l_reg = 0.f; f32x16 o[8] = {};
    int buf = 0;
    for (int t = 0; t < NT; ++t) {
        const int kb = t * KVBLK;
        if (t + 1 < NT) { if (buf == 0) DIFF_STAGE(t + 1, 1); else DIFF_STAGE(t + 1, 0); }
        if (kb <= qlo + QBLK - 1) {
            f32x16 p0, p1; float mn, alpha; bf16x8 pa0, pa1, pa2, pa3;
            qkt<0, false>(p0, p1, K_lds + buf * SHM_K, r32, hi, qr, true);
            if (kb + KVBLK - 1 > qlo) mask_tile(p0, p1, qm - kb, 1u << 30);
            partialSM(p0, p1, m_reg, mn, alpha);
            finishSM(p0, p1, alpha, l_reg, pa0, pa1, pa2, pa3);
            if (__any(alpha < 1.f)) { if (hi == 0) al_l[r32] = alpha; asm volatile("s_waitcnt lgkmcnt(0)" ::: "memory");
#pragma unroll
                for (int d_ = 0; d_ < 8; ++d_)
#pragma unroll
                    for (int r = 0; r < 16; ++r) o[d_][r] *= al_l[crow(r, hi)]; }
            pv_tile256(o, vb0 + (buf * 2) * SHM_V, vb0 + (buf * 2 + 1) * SHM_V, pa0, pa1, pa2, pa3);
        }
        asm volatile("s_waitcnt vmcnt(0)" ::: "memory");
        __syncthreads();
        buf ^= 1;
    }
#undef DIFF_STAGE
    if (hi == 0) li_l[r32] = l_reg; asm volatile("s_waitcnt lgkmcnt(0)" ::: "memory");
    float rl[16];
#pragma unroll
    for (int r = 0; r < 16; ++r) rl[r] = __builtin_amdgcn_rcpf(li_l[crow(r, hi)]);
    char* scr = lds + wid * OST_WAVE;
    char* Ow = (char*)(O + (size_t)(cur.row0 + wid * QBLK) * 1024 + cur.aux);
    const unsigned loff = (unsigned)((lane >> 4) * 1024 + (lane & 15) * 8) * 2u;
#pragma unroll
    for (int h = 0; h < 2; ++h) {
        ost_put(scr, o + 4 * h, rl, r32, hi);
#pragma unroll
        for (int q = 0; q < 8; ++q) *(u32x4*)(Ow + (size_t)(q * 4 * 1024 + h * 128) * 2 + loff) = ost_get(scr, q, lane);
    }
    __syncthreads();
}

struct SbPairRef { const bf16* Q; const bf16* K; const bf16* V; int P0; int row0; int aux; };
__device__ __forceinline__ void sb_pair(const SbPairRef& pr, char* lds, const EpiSb& E) {
    const int tid = opaque_tid(), wid = __builtin_amdgcn_readfirstlane(tid >> 6), lane = tid & 63, r32 = lane & 31, hi = lane >> 5;
    const int hs = wid >> 2, w4 = wid & 3;
    char* V_lds = lds; char* K_lds = lds + 4 * SHM_V;
    volatile unsigned* flags = (volatile unsigned*)(lds + LDS_AUX + 4096);
    const int vb0 = (int)(uintptr_t)V_lds + v_rd_base(lane);
    const int qlo = pr.P0 + w4 * QBLK, qpos = qlo + r32;
    const int j_hi = pr.P0 / KVBLK + 2;
    unsigned koff[2], voff[2];
#pragma unroll
    for (int i = 0; i < 2; ++i) {
        const int q = i * 8 + wid;
        { const int row = q * 4 + (lane >> 4), ch = (lane & 15) ^ (row & 7); koff[i] = (unsigned)(row * LDP * 2 + ch * 16); }
        { const int sub = q * 2 + (lane >> 5), kk = (sub >> 2) * 8 + ((lane & 31) >> 2), c = (sub & 3) * 32 + (lane & 3) * 8;
          const int k = (kk & ~0xC) | ((kk & 4) << 1) | ((kk & 8) >> 1); voff[i] = (unsigned)(k * LDP * 2 + c * 2); }
    }
#define SBP_STAGE(t_, b_) do { const char* kq_ = (const char*)pr.K + (size_t)(t_) * KVBLK * (LDP * 2); const char* vq_ = (const char*)pr.V + (size_t)(t_) * KVBLK * (LDP * 2); \
        _Pragma("unroll") for (int i_ = 0; i_ < 2; ++i_) { \
            glds16(kq_ + koff[i_], K_lds + ((b_) * 2) * SHM_K + (i_ * 8 + wid) * 1024); glds16(kq_ + 256 + koff[i_], K_lds + ((b_) * 2 + 1) * SHM_K + (i_ * 8 + wid) * 1024); \
            glds16(vq_ + voff[i_], V_lds + ((b_) * 2) * SHM_V + (i_ * 8 + wid) * 1024); glds16(vq_ + 256 + voff[i_], V_lds + ((b_) * 2 + 1) * SHM_V + (i_ * 8 + wid) * 1024); } } while (0)
    bf16x8 qr[8];
    { const unsigned qoff = (unsigned)(r32 * LDP + hi * 8) * 2u + (unsigned)hs * 256u, qs_ = (unsigned)(w4 * QBLK) * (LDP * 2u);
#pragma unroll
      for (int d0 = 0; d0 < 8; ++d0) qr[d0] = bload8(pr.Q, qoff + d0 * 32, qs_); }
    SBP_STAGE(j_hi - 1, 0);
    if (tid < 16) flags[tid] = 0u;
    asm volatile("s_waitcnt vmcnt(0)" ::: "memory");
    __syncthreads();
    float carry = 1.f; f32x16 o[4] = {}; bool wdone = false; int buf = 0, par = 0;
    for (int j = j_hi - 1; j >= 0; --j) {
        const int kb = j * KVBLK;
        if (j > 0) { if (buf == 0) SBP_STAGE(j - 1, 1); else SBP_STAGE(j - 1, 0); }
        const bool act = (kb < qlo + QBLK - 1) && !wdone;
        if (act) {
            f32x16 p0, p1;
            qkt<0, false>(p0, p1, K_lds + (buf * 2 + hs) * SHM_K, r32, hi, qr, true);
            const int dq = qpos - kb - 4 * hi;
            f32x16 f0, f1;
            constexpr float CS = SCALE * 1.4426950408889634f, CCL = 80.f * 1.4426950408889634f;
            if (kb + KVBLK - 1 >= qlo) {
#pragma unroll
                for (int r = 0; r < 16; ++r) {
                    const int c = (r & 3) + 8 * (r >> 2);
                    const float u0 = __builtin_amdgcn_exp2f(fminf(p0[r] * CS, CCL)), u1 = __builtin_amdgcn_exp2f(fminf(p1[r] * CS, CCL));
                    const float r0 = __builtin_amdgcn_rcpf(1.0f + u0), r1 = __builtin_amdgcn_rcpf(1.0f + u1);
                    const bool s0 = c < dq, s1 = c + 32 < dq;
                    f0[r] = s0 ? r0 : 1.f; f1[r] = s1 ? r1 : 1.f;
                    p0[r] = s0 ? u0 : 0.f; p1[r] = s1 ? u1 : 0.f;
                }
            } else {
#pragma unroll
                for (int r = 0; r < 16; ++r) {
                    const float u0 = __builtin_amdgcn_exp2f(fminf(p0[r] * CS, CCL)), u1 = __builtin_amdgcn_exp2f(fminf(p1[r] * CS, CCL));
                    f0[r] = __builtin_amdgcn_rcpf(1.0f + u0); f1[r] = __builtin_amdgcn_rcpf(1.0f + u1);
                    p0[r] = u0; p1[r] = u1;
                }
            }
            float T[8];
#pragma unroll
            for (int k = 0; k < 4; ++k) {
                { const float e3 = f0[4 * k + 3], e2 = f0[4 * k + 2] * e3, e1 = f0[4 * k + 1] * e2, e0 = f0[4 * k] * e1; T[k] = e0; f0[4 * k + 2] = e2; f0[4 * k + 1] = e1; f0[4 * k] = e0; }
                { const float e3 = f1[4 * k + 3], e2 = f1[4 * k + 2] * e3, e1 = f1[4 * k + 1] * e2, e0 = f1[4 * k] * e1; T[4 + k] = e0; f1[4 * k + 2] = e2; f1[4 * k + 1] = e1; f1[4 * k] = e0; }
            }
            float R = 1.f;
#pragma unroll
            for (int k = 7; k >= 0; --k) {
                auto rr = __builtin_amdgcn_permlane32_swap(__float_as_uint(T[k]), __float_as_uint(T[k]), false, false);
                const float tlo = __uint_as_float(rr[0]), thi = __uint_as_float(rr[1]);
                const float base = carry * R * (hi == 0 ? thi : 1.f);
                if (k < 4) { p0[4 * k] *= f0[4 * k] * base; p0[4 * k + 1] *= f0[4 * k + 1] * base; p0[4 * k + 2] *= f0[4 * k + 2] * base; p0[4 * k + 3] *= f0[4 * k + 3] * base; }
                else { p1[4 * (k - 4)] *= f1[4 * (k - 4)] * base; p1[4 * (k - 4) + 1] *= f1[4 * (k - 4) + 1] * base; p1[4 * (k - 4) + 2] *= f1[4 * (k - 4) + 2] * base; p1[4 * (k - 4) + 3] *= f1[4 * (k - 4) + 3] * base; }
                R *= tlo * thi;
            }
            carry *= R;
            bf16x8 pa0, pa1, pa2, pa3;
            PK4(p0, 0, pa0); PK4(p0, 8, pa1); PK4(p1, 0, pa2); PK4(p1, 8, pa3);
            pv_tile<0, false>(o, vb0 + (buf * 2 + hs) * SHM_V, pa0, pa1, pa2, pa3, true);
            if (__all(carry == 0.f)) wdone = true;
        }
        if (lane == 0) flags[par * 8 + wid] = wdone ? 1u : 0u;
        asm volatile("s_waitcnt vmcnt(0)" ::: "memory");
        __syncthreads();
        unsigned alld = 1u;
#pragma unroll
        for (int w = 0; w < 8; ++w) alld &= flags[par * 8 + w];
        if (alld) break;
        buf ^= 1; par ^= 1;
    }
#undef SBP_STAGE
    E.put(o, pr.row0 + w4 * QBLK, pr.aux + hs * 128, lds + wid * OST_WAVE, r32, hi);
    __syncthreads();
}

__device__ __forceinline__ void pv_tile128p(f32x16* o, int vb, bf16x8 pa0, bf16x8 pa1, bf16x8 pa2, bf16x8 pa3) {
#define TRR(dst, base, off) asm volatile("ds_read_b64_tr_b16 %0, %1 offset:%2" : "=&v"(dst) : "v"(base), "i"(off) : "memory")
#define PV_LOAD(S, base, d0) do { constexpr int b_ = v_rd_off(d0, 0, 0); \
        TRR(S[0], base, b_); TRR(S[1], base, b_ + 2048); TRR(S[2], base, b_ + 4096); TRR(S[3], base, b_ + 6144); TRR(S[4], base, b_ + 8192); TRR(S[5], base, b_ + 10240); TRR(S[6], base, b_ + 12288); TRR(S[7], base, b_ + 14336); } while (0)
#define PV_MMA(S, acc) do { \
        acc = __builtin_amdgcn_mfma_f32_32x32x16_bf16(pa0, (bf16x8){S[0][0], S[0][1], S[0][2], S[0][3], S[1][0], S[1][1], S[1][2], S[1][3]}, acc, 0, 0, 0); \
        acc = __builtin_amdgcn_mfma_f32_32x32x16_bf16(pa1, (bf16x8){S[2][0], S[2][1], S[2][2], S[2][3], S[3][0], S[3][1], S[3][2], S[3][3]}, acc, 0, 0, 0); \
        acc = __builtin_amdgcn_mfma_f32_32x32x16_bf16(pa2, (bf16x8){S[4][0], S[4][1], S[4][2], S[4][3], S[5][0], S[5][1], S[5][2], S[5][3]}, acc, 0, 0, 0); \
        acc = __builtin_amdgcn_mfma_f32_32x32x16_bf16(pa3, (bf16x8){S[6][0], S[6][1], S[6][2], S[6][3], S[7][0], S[7][1], S[7][2], S[7][3]}, acc, 0, 0, 0); } while (0)
#define PV_W8() do { asm volatile("s_waitcnt lgkmcnt(8)" ::: "memory"); SBAR(); } while (0)
    s16x4 X[8], Y[8];
    asm volatile("s_waitcnt lgkmcnt(0)" ::: "memory");
    PV_LOAD(X, vb, 0);
    PV_LOAD(Y, vb, 1); PV_W8(); PV_MMA(X, o[0]);
    PV_LOAD(X, vb, 2); PV_W8(); PV_MMA(Y, o[1]);
    PV_LOAD(Y, vb, 3); PV_W8(); PV_MMA(X, o[2]);
    asm volatile("s_waitcnt lgkmcnt(0)" ::: "memory"); SBAR(); PV_MMA(Y, o[3]);
#undef TRR
#undef PV_LOAD
#undef PV_MMA
#undef PV_W8
}
template <bool SLC, int W, int HM, class Epi>
__device__ __forceinline__ void attn_simple(const BlockRef& cur, char* lds, const Epi& E) {
    const int tid = opaque_tid(), wid = __builtin_amdgcn_readfirstlane(tid >> 6), lane = tid & 63, r32 = lane & 31, hi = lane >> 5;
    char* V_lds = lds; char* K_lds = lds + 2 * SHM_V;
    float* ws = (float*)(lds + 2 * SHM_V + 2 * SHM_K) + wid * 64; float* li_l = ws, * al_l = ws + 32;
    const int vb0 = (int)(uintptr_t)V_lds + v_rd_base(lane);
    constexpr int RW = 8 / HM; const int wsub = wid & (RW - 1), hl = wid / RW;
    const int qlo = cur.P0 + wsub * QBLK, qm = qlo + r32 - 4 * hi;
    const int j_lo = swa_jlo(cur.P0, W), NT = cur.P0 / KVBLK + RW * QBLK / KVBLK - j_lo;
    unsigned koff[2], voff[2];
#pragma unroll
    for (int i = 0; i < 2; ++i) {
        const int q = i * 8 + wid;
        { const int row = q * 4 + (lane >> 4), ch = (lane & 15) ^ (row & 7); koff[i] = (unsigned)(row * LDP * 2 + ch * 16); }
        { const int sub = q * 2 + (lane >> 5), kk = (sub >> 2) * 8 + ((lane & 31) >> 2), c = (sub & 3) * 32 + (lane & 3) * 8;
          const int k = (kk & ~0xC) | ((kk & 4) << 1) | ((kk & 8) >> 1); voff[i] = (unsigned)(k * LDP * 2 + c * 2); }
    }
#define AS_STAGE(t_, b_) do { const char* kq_ = (const char*)cur.K + (size_t)(j_lo + (t_)) * KVBLK * (LDP * 2); const char* vq_ = (const char*)cur.V + (size_t)(j_lo + (t_)) * KVBLK * (LDP * 2); \
        _Pragma("unroll") for (int i_ = 0; i_ < 2; ++i_) { \
            glds16(kq_ + koff[i_], K_lds + (b_) * SHM_K + (i_ * 8 + wid) * 1024); glds16(vq_ + voff[i_], V_lds + (b_) * SHM_V + (i_ * 8 + wid) * 1024); } } while (0)
    bf16x8 qr[8];
    { const unsigned qoff = (unsigned)(r32 * LDP + hi * 8) * 2u, qs_ = (unsigned)(wsub * QBLK) * (LDP * 2u) + (unsigned)hl * 256u;
#pragma unroll
      for (int d0 = 0; d0 < 8; ++d0) qr[d0] = bload8(cur.Q, qoff + d0 * 32, qs_); }
    u64 rowmask = ~0ull; if constexpr (SLC) rowmask = cur.M[cur.P0 + wsub * QBLK + r32];
    AS_STAGE(0, 0);
    asm volatile("s_waitcnt vmcnt(0)" ::: "memory");
    __syncthreads();
    float m_reg = -1e30f, l_reg = 0.f; f32x16 o[4] = {};
    int buf = 0;
    for (int t = 0; t < NT; ++t) {
        const int kb = (j_lo + t) * KVBLK;
        if (t + 1 < NT) { if (buf == 0) AS_STAGE(t + 1, 1); else AS_STAGE(t + 1, 0); }
        if (kb <= qlo + QBLK - 1 && kb + KVBLK - 1 >= qlo - W + 1) {
            f32x16 p0, p1; float mn, alpha; bf16x8 pa0, pa1, pa2, pa3;
            qkt<0, false>(p0, p1, K_lds + buf * SHM_K, r32, hi, qr, true);
            if (kb + KVBLK - 1 > qlo || kb <= qlo + QBLK - 1 - W) mask_tile(p0, p1, qm - kb, (unsigned)W);
            if constexpr (SLC) partialSM_sel(p0, p1, m_reg, mn, alpha, ((rowmask >> (j_lo + t)) & 1ull) != 0ull); else partialSM(p0, p1, m_reg, mn, alpha);
            finishSM(p0, p1, alpha, l_reg, pa0, pa1, pa2, pa3);
            if (__any(alpha < 1.f)) { if (hi == 0) al_l[r32] = alpha; asm volatile("s_waitcnt lgkmcnt(0)" ::: "memory");
#pragma unroll
                for (int d_ = 0; d_ < 4; ++d_)
#pragma unroll
                    for (int r = 0; r < 16; ++r) o[d_][r] *= al_l[crow(r, hi)]; }
            pv_tile128p(o, vb0 + buf * SHM_V, pa0, pa1, pa2, pa3);
        }
        asm volatile("s_waitcnt vmcnt(0)" ::: "memory");
        __syncthreads();
        buf ^= 1;
    }
#undef AS_STAGE
    if (hi == 0) li_l[r32] = l_reg; asm volatile("s_waitcnt lgkmcnt(0)" ::: "memory");
    float rli[16];
#pragma unroll
    for (int r = 0; r < 16; ++r) rli[r] = __builtin_amdgcn_rcpf(li_l[crow(r, hi)]);
    if constexpr (HM == 1) E(o, rli, cur, wid, r32, hi);
    else { BlockRef cw = cur; cw.row0 = cur.row0 + (wsub - wid) * QBLK; cw.aux = cur.aux + hl * 128; cw.aux2 = cur.aux2 + hl; E(o, rli, cw, wid, r32, hi); }
    __syncthreads();
}

__device__ __forceinline__ float quad_sum(float x) {
    x += __int_as_float(__builtin_amdgcn_update_dpp(0, __float_as_int(x), 0xB1, 0xF, 0xF, true));
    x += __int_as_float(__builtin_amdgcn_update_dpp(0, __float_as_int(x), 0x4E, 0xF, 0xF, true));
    return x;
}
__device__ __forceinline__ void cmp_unit(const bf16* __restrict__ proj, bf16* __restrict__ ocmp, u64* __restrict__ selm, int bg, int tb, char* lds) {
    const int tid = opaque_tid(), wid = __builtin_amdgcn_readfirstlane(tid >> 6), lane = tid & 63, r32 = lane & 31, hi = lane >> 5;
    const int b = bg >> 1, g = bg & 1, tok0 = tb * 64;
    const int n_max = (tok0 + 32) >> 4;
    const int ntile = (n_max >> 6) + 1;
    char* K_lds = lds; char* V_lds = lds + 4 * SHM_K;
    float* impT = (float*)(lds + LDS_AUX);
    const int tokl = wid * 8 + (r32 >> 2), tpos = tok0 + tokl, head = g * 4 + (r32 & 3);
    bf16x8 qr[8];
    { const bf16* qp = proj + (size_t)(b * SEQ + tpos) * LDP + C_NQ + head * 128 + hi * 8;
#pragma unroll
      for (int d0 = 0; d0 < 8; ++d0) qr[d0] = ld8(qp + d0 * 16); }
    const int nlim = (tpos - 31) >> 4;
    const int vb0 = (int)(uintptr_t)V_lds + v_rd_base(lane);
    constexpr float C2 = 1.4426950408889634f * SCALE;
    float mx = -1e30f, lsum = 0.f;
    for (int t = 0; t < ntile; ++t) {
        f32x16 p0, p1; qkt<0, false>(p0, p1, K_lds + t * SHM_K, r32, hi, qr, true);
        const int nb = t * 64 + 4 * hi; float tm = -1e30f;
#pragma unroll
        for (int r = 0; r < 16; ++r) { const int c = (r & 3) + 8 * (r >> 2);
            if (nb + c <= nlim) tm = fmaxf(tm, p0[r]); if (nb + c + 32 <= nlim) tm = fmaxf(tm, p1[r]); }
        tm = fmaxf(tm, other_half(tm));
        const float mn = fmaxf(mx, tm), mLn = -mn * C2; float ps = 0.f;
#pragma unroll
        for (int r = 0; r < 16; ++r) { const int c = (r & 3) + 8 * (r >> 2);
            const float e0 = __builtin_amdgcn_exp2f(fmaf(p0[r], C2, mLn)), e1 = __builtin_amdgcn_exp2f(fmaf(p1[r], C2, mLn));
            ps += ((nb + c <= nlim) ? e0 : 0.f) + ((nb + c + 32 <= nlim) ? e1 : 0.f); }
        lsum = lsum * __builtin_amdgcn_exp2f((mx - mn) * C2) + ps; mx = mn;
    }
    lsum += other_half(lsum);
    const float inv_l = lsum > 0.f ? 1.0f / lsum : 0.f;
    f32x16 o[4] = {}; float prev_hi_last = 0.f;
    const float mL = -mx * C2;
    for (int t = 0; t < 4; ++t) {
        if (t < ntile) {
            f32x16 p0, p1; qkt<0, false>(p0, p1, K_lds + t * SHM_K, r32, hi, qr, true);
            const int nb = t * 64 + 4 * hi;
#pragma unroll
            for (int r = 0; r < 16; ++r) { const int c = (r & 3) + 8 * (r >> 2);
                const float e0 = __builtin_amdgcn_exp2f(fmaf(p0[r], C2, mL)) * inv_l, e1 = __builtin_amdgcn_exp2f(fmaf(p1[r], C2, mL)) * inv_l;
                p0[r] = (nb + c <= nlim) ? e0 : 0.f; p1[r] = (nb + c + 32 <= nlim) ? e1 : 0.f; }
#pragma unroll
            for (int k = 0; k < 8; ++k) {
                const float gs = (k < 4) ? (p0[4 * k] + p0[4 * k + 1]) + (p0[4 * k + 2] + p0[4 * k + 3]) : (p1[4 * (k - 4)] + p1[4 * (k - 4) + 1]) + (p1[4 * (k - 4) + 2] + p1[4 * (k - 4) + 3]);
                const float last = (k < 4) ? p0[4 * k + 3] : p1[4 * (k - 4) + 3];
                auto rr = __builtin_amdgcn_permlane32_swap(__float_as_uint(last), __float_as_uint(last), false, false);
                const float llo = __uint_as_float(rr[0]), lhi = __uint_as_float(rr[1]);
                float v = gs + (hi ? llo : prev_hi_last);
                prev_hi_last = lhi;
                v = quad_sum(v);
                if ((r32 & 3) == (k >> 1)) impT[tokl * 64 + t * 16 + 2 * k + hi] = v;
            }
            bf16x8 pa0, pa1, pa2, pa3;
            PK4(p0, 0, pa0); PK4(p0, 8, pa1); PK4(p1, 0, pa2); PK4(p1, 8, pa3);
            pv_tile<0, false>(o, vb0 + t * SHM_V, pa0, pa1, pa2, pa3, true);
        } else {
#pragma unroll
            for (int k = 0; k < 8; ++k) if ((r32 & 3) == (k >> 1)) impT[tokl * 64 + t * 16 + 2 * k + hi] = 0.f;
        }
    }
    {
        const size_t rowb = (size_t)(b * SEQ + tok0 + wid * 8);
#pragma unroll
        for (int r = 0; r < 16; ++r) { const int cr = crow(r, hi);
            bf16* op = ocmp + (rowb + (cr >> 2)) * 1024 + (g * 4 + (cr & 3)) * 128;
#pragma unroll
            for (int d0 = 0; d0 < 4; ++d0) { const float v = o[d0][r]; const float vn = __int_as_float(__builtin_amdgcn_update_dpp(0, __float_as_int(v), 0xB1, 0xF, 0xF, true));
                if ((r32 & 1) == 0) *(unsigned*)(op + d0 * 32 + r32) = cvtpk(v, vn); } }
    }
    asm volatile("s_waitcnt lgkmcnt(0)" ::: "memory");
#pragma unroll 1
    for (int tk = 0; tk < 8; ++tk) {
        const float v = impT[(wid * 8 + tk) * 64 + lane];
        unsigned key = (__float_as_uint(v) & ~63u) | (63u - (unsigned)lane);
        if (lane == tb || lane == 0) key = 0xFFFFFFC0u | (63u - (unsigned)lane);
        const bool valid = lane <= tb;
        if (!valid) key = 0u;
        unsigned T = 0u;
#pragma unroll
        for (int bit = 31; bit >= 0; --bit) { const unsigned Tt = T | (1u << bit); if (__popcll(__ballot(key >= Tt)) >= 16) T = Tt; }
        const u64 m = __ballot(valid && key >= T);
        if (lane == 0) selm[(size_t)bg * SEQ + tok0 + wid * 8 + tk] = m;
    }
}
__device__ __forceinline__ void cmp_pair(const bf16* __restrict__ proj, const bf16* __restrict__ kcmp, const bf16* __restrict__ vcmp, bf16* __restrict__ ocmp, u64* __restrict__ selm, int pair, char* lds) {
    const int tid = opaque_tid();
    const int bg = pair >> 5, p = pair & 31, tb_hi = 63 - p, tb_lo = p;
    const int ntile = (((tb_hi * 64 + 32) >> 4) >> 6) + 1;
    char* K_lds = lds; char* V_lds = lds + 4 * SHM_K;
    const int sr = tid >> 4, sc = (tid & 15) * 8, kws = KSWZ(sr, sc * 2), vst0 = v_st(sr, sc), vst1 = vst0 + 8192;
    bf16x8 kr[4][2], vr[4][2];
#pragma unroll
    for (int t = 0; t < 4; ++t) if (t < ntile) {
        const bf16* kp = kcmp + ((size_t)bg * 256 + t * 64) * 128 + sc; const bf16* vp = vcmp + ((size_t)bg * 256 + t * 64) * 128 + sc;
        kr[t][0] = ld8(kp + sr * 128); kr[t][1] = ld8(kp + (32 + sr) * 128); vr[t][0] = ld8(vp + sr * 128); vr[t][1] = ld8(vp + (32 + sr) * 128); }
#pragma unroll
    for (int t = 0; t < 4; ++t) if (t < ntile) {
        *(bf16x8*)(K_lds + t * SHM_K + kws) = kr[t][0]; *(bf16x8*)(K_lds + t * SHM_K + kws + 32 * 256) = kr[t][1];
        *(bf16x8*)(V_lds + t * SHM_V + vst0) = vr[t][0]; *(bf16x8*)(V_lds + t * SHM_V + vst1) = vr[t][1]; }
    __syncthreads();
    cmp_unit(proj, ocmp, selm, bg, tb_hi, lds);
    cmp_unit(proj, ocmp, selm, bg, tb_lo, lds);
    __syncthreads();
}

__device__ __forceinline__ void compress_item(const bf16* __restrict__ proj, const float* __restrict__ pe, const bf16* __restrict__ w1t, const bf16* __restrict__ w2t, bf16* __restrict__ outc, int kv, int bg, int nt, char* lds) {
    const int tid = opaque_tid(), wid = __builtin_amdgcn_readfirstlane(tid >> 6), lane = tid & 63, r32 = lane & 31, hi = lane >> 5;
    const int b = bg >> 1, g = bg & 1, n0 = nt * 32, jb = wid & 3, kh = wid >> 2;
    char* W_lds = lds; char* A_lds = lds + 98304; float* part = (float*)lds; bf16* hid = (bf16*)(lds + 40960); float* peT = (float*)(lds + LDS_AUX);
    unsigned woff[4];
#pragma unroll
    for (int i = 0; i < 4; ++i) { const int j = (i * 8 + wid) * 4 + (lane >> 4), ch = (lane & 15) ^ (j & 7); woff[i] = (unsigned)(j * 4096 * 2 + ch * 16); }
    unsigned aoff_;
    { const int nl = wid * 4 + (lane >> 4); int n = n0 + nl; if (n > 254) n = 254; const int ch = (lane & 15) ^ (nl & 7);
      aoff_ = (unsigned)((16 * n) * LDP * 2 + ch * 16); }
    const char* xbase = (const char*)(proj + (size_t)b * SEQ * LDP + (kv ? C_NVC : C_NKC) + g * 128);
#define CMP_STAGE(l_, bf_) do { \
        _Pragma("unroll") for (int i_ = 0; i_ < 4; ++i_) glds16((const char*)w1t + (size_t)(l_) * 256 + woff[i_], W_lds + (bf_) * 32768 + (i_ * 8 + wid) * 1024); \
        glds16(xbase + (size_t)(l_) * (LDP * 2) + aoff_, A_lds + (bf_) * 8192 + wid * 1024); } while (0)
    CMP_STAGE(0, 0);
    for (int i = tid; i < 32 * 128 / 4; i += 512) ((f32x4*)peT)[i] = ((const f32x4*)pe)[i];
    CMP_STAGE(1, 1);
    asm volatile("s_waitcnt vmcnt(5) lgkmcnt(0)" ::: "memory");
    __builtin_amdgcn_s_barrier();
    f32x16 acc = {};
    const int jrow = jb * 32 + r32;
    int cur = 0, nx1 = 1, nx2 = 2;
    for (int l = 0; l < 32; ++l) {
        if (l + 2 < 32) { if (nx2 == 0) CMP_STAGE(l + 2, 0); else if (nx2 == 1) CMP_STAGE(l + 2, 1); else CMP_STAGE(l + 2, 2); }
        const char* Wb = W_lds + cur * 32768 + jrow * 256; const char* Ab = A_lds + cur * 8192 + r32 * 256; const float* pl = peT + l * 128;
#pragma unroll
        for (int dd = 0; dd < 4; ++dd) { const int d0 = kh * 4 + dd, c = d0 * 2 + hi;
            const bf16x8 wf = *(const bf16x8*)(Wb + ((c ^ (jrow & 7)) << 4));
            const u32x4 xv = *(const u32x4*)(Ab + ((c ^ (r32 & 7)) << 4)); const f32x4 pa = *(const f32x4*)(pl + c * 8), pb = *(const f32x4*)(pl + c * 8 + 4);
            u32x4 aw; aw.x = cvtpk(lo_bf(xv.x) + pa[0], hi_bf(xv.x) + pa[1]); aw.y = cvtpk(lo_bf(xv.y) + pa[2], hi_bf(xv.y) + pa[3]);
            aw.z = cvtpk(lo_bf(xv.z) + pb[0], hi_bf(xv.z) + pb[1]); aw.w = cvtpk(lo_bf(xv.w) + pb[2], hi_bf(xv.w) + pb[3]);
            acc = __builtin_amdgcn_mfma_f32_32x32x16_bf16(wf, *reinterpret_cast<const bf16x8*>(&aw), acc, 0, 0, 0); }
        if (l + 2 < 32) asm volatile("s_waitcnt vmcnt(5) lgkmcnt(0)" ::: "memory");
        else asm volatile("s_waitcnt vmcnt(0) lgkmcnt(0)" ::: "memory");
        __builtin_amdgcn_s_barrier();
        const int t_ = cur; cur = nx1; nx1 = nx2; nx2 = t_;
    }
#undef CMP_STAGE
#pragma unroll
    for (int r = 0; r < 16; ++r) part[(kh * 32 + r32) * 129 + jb * 32 + crow(r, hi)] = acc[r];
    __syncthreads();
    {
        const int row = tid >> 4, c8 = (tid & 15) * 8; float sv[8];
#pragma unroll
        for (int j = 0; j < 8; ++j) sv[j] = part[row * 129 + c8 + j] + part[(32 + row) * 129 + c8 + j];
        u32x4 hw; hw.x = cvtpk(siluf_(sv[0]), siluf_(sv[1])); hw.y = cvtpk(siluf_(sv[2]), siluf_(sv[3])); hw.z = cvtpk(siluf_(sv[4]), siluf_(sv[5])); hw.w = cvtpk(siluf_(sv[6]), siluf_(sv[7]));
        *(u32x4*)((char*)hid + row * 256 + ((c8 * 2) ^ ((row & 7) << 4))) = hw;
    }
    __syncthreads();
    if (wid < 4) {
        f32x16 a2 = {};
#pragma unroll
        for (int k0 = 0; k0 < 8; ++k0) {
            const bf16x8 af = *(const bf16x8*)((char*)hid + r32 * 256 + (((k0 * 16 + hi * 8) * 2) ^ ((r32 & 7) << 4)));
            const bf16x8 bfr = ld8(w2t + (size_t)(wid * 32 + r32) * 128 + k0 * 16 + hi * 8);
            a2 = __builtin_amdgcn_mfma_f32_32x32x16_bf16(af, bfr, a2, 0, 0, 0);
        }
#pragma unroll
        for (int r = 0; r < 16; ++r) { const int nn = n0 + crow(r, hi);
            outc[((size_t)bg * 256 + nn) * 128 + wid * 32 + r32] = (bf16)f2bf(nn < 255 ? a2[r] : 0.f); }
    }
    __syncthreads();
}
#undef PK4

__device__ __forceinline__ float wave_sum(float v) {
#pragma unroll
    for (int o = 32; o >= 1; o >>= 1) v += __shfl_xor(v, o);
    return v;
}
__device__ __forceinline__ void norm_phase(const Params& P, int l, const float* xin) {
    const int tid = opaque_tid(), wid = tid >> 6, lane = tid & 63;
    const float* gpre = P.norm_pre_g + (size_t)l * DM;
    bf16* H = (bf16*)(P.ws + WS_H); unsigned char* H8 = P.ws + WS_H8;
    for (int row = blockIdx.x * 8 + wid; row < MTOK; row += gridDim.x * 8) {
        const float* mod = (const float*)(P.ws + WS_MOD) + ((size_t)l * 4 + (row >> 12)) * 6144;
        const float* xr = xin + (size_t)row * DM;
        f32x4 v[8]; float ss = 0.f;
#pragma unroll
        for (int k = 0; k < 4; ++k) { v[2 * k] = *(const f32x4*)(xr + k * 512 + lane * 8); v[2 * k + 1] = *(const f32x4*)(xr + k * 512 + lane * 8 + 4); }
#pragma unroll
        for (int k = 0; k < 8; ++k) ss += v[k][0] * v[k][0] + v[k][1] * v[k][1] + v[k][2] * v[k][2] + v[k][3] * v[k][3];
        ss = wave_sum(ss);
        const float rs = 1.0f / sqrtf(ss * (1.0f / DM) + 1e-6f);
#pragma unroll
        for (int k = 0; k < 4; ++k) {
            const int col = k * 512 + lane * 8; float o[8];
#pragma unroll
            for (int j = 0; j < 8; ++j) { const float xv = v[2 * k + (j >> 2)][j & 3];
                o[j] = xv * rs * gpre[col + j] * (1.0f + mod[2048 + col + j]) + mod[col + j]; }
            u32x4 w; w.x = pk2(o[0], o[1]); w.y = pk2(o[2], o[3]); w.z = pk2(o[4], o[5]); w.w = pk2(o[6], o[7]);
            *(u32x4*)(H + (size_t)row * DM + col) = w;
            u32x2 w8; w8.x = pk4_fp8(o[0] * F8_SCALE_H, o[1] * F8_SCALE_H, o[2] * F8_SCALE_H, o[3] * F8_SCALE_H); w8.y = pk4_fp8(o[4] * F8_SCALE_H, o[5] * F8_SCALE_H, o[6] * F8_SCALE_H, o[7] * F8_SCALE_H);
            *(u32x2*)(H8 + (size_t)row * DM + col) = w8;
        }
    }
}
__device__ __forceinline__ void post_phase(const Params& P, int l, const float* __restrict__ xin, bool grouped) {
    const int tid = opaque_tid(), wid = tid >> 6, lane = tid & 63;
    const float* __restrict__ gpost = P.norm_post_g + (size_t)l * DM;
    const bf16* __restrict__ OP = (const bf16*)(P.ws + WS_OUTPRE);
    bf16* __restrict__ H = (bf16*)(P.ws + WS_H); unsigned char* __restrict__ H8 = P.ws + WS_H8;
    float* __restrict__ outp = P.out;
    const int stride = grouped ? 8 : (int)gridDim.x * 8;
    int row = grouped ? (int)(blockIdx.x & 7) * (MTOK / 8) + (int)(blockIdx.x >> 3) * 64 + wid : (int)blockIdx.x * 8 + wid;
    const int row_end = grouped ? row - wid + 64 : MTOK;
    u32x4 opn[4]; f32x4 xn[8];
    if (row < row_end) {
#pragma unroll
        for (int k = 0; k < 4; ++k) { opn[k] = *(const u32x4*)(OP + (size_t)row * DM + k * 512 + lane * 8);
            xn[2 * k] = *(const f32x4*)(xin + (size_t)row * DM + k * 512 + lane * 8); xn[2 * k + 1] = *(const f32x4*)(xin + (size_t)row * DM + k * 512 + lane * 8 + 4); }
    }
    for (; row < row_end; row += stride) {
        const float* mod = (const float*)(P.ws + WS_MOD) + ((size_t)l * 4 + (row >> 12)) * 6144;
        float ov[32]; f32x4 xc[8]; float ss = 0.f;
#pragma unroll
        for (int k = 0; k < 4; ++k) { const u32x4 w = opn[k]; xc[2 * k] = xn[2 * k]; xc[2 * k + 1] = xn[2 * k + 1];
            ov[8 * k + 0] = lo_bf(w.x); ov[8 * k + 1] = hi_bf(w.x); ov[8 * k + 2] = lo_bf(w.y); ov[8 * k + 3] = hi_bf(w.y);
            ov[8 * k + 4] = lo_bf(w.z); ov[8 * k + 5] = hi_bf(w.z); ov[8 * k + 6] = lo_bf(w.w); ov[8 * k + 7] = hi_bf(w.w); }
        const int rown = row + stride;
        if (rown < row_end) {
#pragma unroll
            for (int k = 0; k < 4; ++k) { opn[k] = *(const u32x4*)(OP + (size_t)rown * DM + k * 512 + lane * 8);
                xn[2 * k] = *(const f32x4*)(xin + (size_t)rown * DM + k * 512 + lane * 8); xn[2 * k + 1] = *(const f32x4*)(xin + (size_t)rown * DM + k * 512 + lane * 8 + 4); }
        }
#pragma unroll
        for (int j = 0; j < 32; ++j) ss += ov[j] * ov[j];
        ss = wave_sum(ss);
        const float rs = 1.0f / sqrtf(ss * (1.0f / DM) + 1e-6f);
        float* orow = outp + (size_t)row * DM; float ss2 = 0.f;
#pragma unroll
        for (int k = 0; k < 4; ++k) {
            const int col = k * 512 + lane * 8;
#pragma unroll
            for (int j = 0; j < 8; ++j) { const float xv = xc[2 * k + (j >> 2)][j & 3];
                const float nv = xv + mod[4096 + col + j] * (ov[8 * k + j] * rs * gpost[col + j]); ov[8 * k + j] = nv; ss2 += nv * nv; }
            *(f32x4*)(orow + col) = (f32x4){ov[8 * k], ov[8 * k + 1], ov[8 * k + 2], ov[8 * k + 3]};
            *(f32x4*)(orow + col + 4) = (f32x4){ov[8 * k + 4], ov[8 * k + 5], ov[8 * k + 6], ov[8 * k + 7]};
        }
        if (l + 1 < DEPTH) {
            ss2 = wave_sum(ss2);
            const float rs2 = 1.0f / sqrtf(ss2 * (1.0f / DM) + 1e-6f);
            const float* mod2 = mod + 4 * 6144; const float* gpre = P.norm_pre_g + (size_t)(l + 1) * DM;
#pragma unroll
            for (int k = 0; k < 4; ++k) {
                const int col = k * 512 + lane * 8; float o[8];
#pragma unroll
                for (int j = 0; j < 8; ++j) o[j] = ov[8 * k + j] * rs2 * gpre[col + j] * (1.0f + mod2[2048 + col + j]) + mod2[col + j];
                u32x4 w; w.x = pk2(o[0], o[1]); w.y = pk2(o[2], o[3]); w.z = pk2(o[4], o[5]); w.w = pk2(o[6], o[7]);
                *(u32x4*)(H + (size_t)row * DM + col) = w;
                u32x2 w8; w8.x = pk4_fp8(o[0] * F8_SCALE_H, o[1] * F8_SCALE_H, o[2] * F8_SCALE_H, o[3] * F8_SCALE_H); w8.y = pk4_fp8(o[4] * F8_SCALE_H, o[5] * F8_SCALE_H, o[6] * F8_SCALE_H, o[7] * F8_SCALE_H);
                *(u32x2*)(H8 + (size_t)row * DM + col) = w8;
            }
        }
    }
}
__device__ __forceinline__ void diffpost_phase(const Params& P, int l) {
    const int tid = opaque_tid(), hw = tid >> 5, l32 = tid & 31;
    const bf16* O0 = (const bf16*)(P.ws + WS_DIFFO); const bf16* O1 = O0 + (size_t)MTOK * 1024;
    const bf16* proj = (const bf16*)(P.ws + WS_PROJ); bf16* ys = (bf16*)(P.ws + WS_YS);
    const float lam = ((const float*)(P.ws + WS_LAM))[l];
    const float lam_init = 0.8f - 0.6f * expf(-0.3f * (float)l);
    const float* g = P.diff_norm_g + (size_t)l * 256 + l32 * 8;
    float gv[8];
#pragma unroll
    for (int j = 0; j < 8; ++j) gv[j] = g[j] * (1.0f - lam_init);
    for (int v = blockIdx.x * 16 + hw; v < MTOK * 4; v += gridDim.x * 16) {
        const size_t row = (size_t)(v >> 2); const int col = (v & 3) * 256 + l32 * 8;
        const u32x4 a = *(const u32x4*)(O0 + row * 1024 + col), b = *(const u32x4*)(O1 + row * 1024 + col), z = *(const u32x4*)(proj + row * LDP + C_AZ + col);
        float d[8];
        d[0] = lo_bf(a.x) - lam * lo_bf(b.x); d[1] = hi_bf(a.x) - lam * hi_bf(b.x); d[2] = lo_bf(a.y) - lam * lo_bf(b.y); d[3] = hi_bf(a.y) - lam * hi_bf(b.y);
        d[4] = lo_bf(a.z) - lam * lo_bf(b.z); d[5] = hi_bf(a.z) - lam * hi_bf(b.z); d[6] = lo_bf(a.w) - lam * lo_bf(b.w); d[7] = hi_bf(a.w) - lam * hi_bf(b.w);
        float ss = 0.f;
#pragma unroll
        for (int j = 0; j < 8; ++j) ss += d[j] * d[j];
#pragma unroll
        for (int o = 16; o >= 1; o >>= 1) ss += __shfl_xor(ss, o);
        const float rs = 1.0f / sqrtf(ss * (1.0f / 256.0f) + 1e-5f);
        const float zz[8] = {lo_bf(z.x), hi_bf(z.x), lo_bf(z.y), hi_bf(z.y), lo_bf(z.z), hi_bf(z.z), lo_bf(z.w), hi_bf(z.w)};
        float o[8];
#pragma unroll
        for (int j = 0; j < 8; ++j) o[j] = d[j] * rs * gv[j] * siluf_(zz[j]);
        u32x4 w; w.x = pk2(o[0], o[1]); w.y = pk2(o[2], o[3]); w.z = pk2(o[4], o[5]); w.w = pk2(o[6], o[7]);
        *(u32x4*)(ys + row * 1024 + col) = w;
    }
}

__device__ __forceinline__ void conv_tile_load(f32x4 (&r)[8], const float* src, size_t lds_, int nvalid) {
    const int tid = opaque_tid(), c4 = (tid & 31) * 4, rb = tid >> 5;
#pragma unroll
    for (int i = 0; i < 8; ++i) r[i] = (c4 < nvalid) ? __builtin_nontemporal_load((const f32x4*)(src + (size_t)(rb + 16 * i) * lds_ + c4)) : (f32x4){0.f, 0.f, 0.f, 0.f};
}
__device__ __forceinline__ void conv_tile_store(const f32x4 (&r)[8], bf16* dst, size_t ldd, char* lds, unsigned char* dst8) {
    const int tid = opaque_tid(), c4 = (tid & 31) * 4, rb = tid >> 5;
    float* T = (float*)lds;
#pragma unroll
    for (int i = 0; i < 8; ++i) { const int k = rb + 16 * i; *(f32x4*)(T + k * 128 + (c4 ^ (((k >> 3) & 7) << 2))) = r[i]; }
    __syncthreads();
    const int kc = tid & 15;
#pragma unroll
    for (int i = 0; i < 4; ++i) { const int n = (tid >> 4) + 32 * i; float v[8];
#pragma unroll
        for (int j = 0; j < 8; ++j) v[j] = T[(8 * kc + j) * 128 + (n ^ ((kc & 7) << 2))];
        if (dst8) { u32x2 w8; w8.x = pk4_fp8(v[0] * F8_SCALE_W, v[1] * F8_SCALE_W, v[2] * F8_SCALE_W, v[3] * F8_SCALE_W); w8.y = pk4_fp8(v[4] * F8_SCALE_W, v[5] * F8_SCALE_W, v[6] * F8_SCALE_W, v[7] * F8_SCALE_W);
                    *(u32x2*)(dst8 + (size_t)n * ldd + 8 * kc) = w8; }
        else { u32x4 w; w.x = pk2(v[0], v[1]); w.y = pk2(v[2], v[3]); w.z = pk2(v[4], v[5]); w.w = pk2(v[6], v[7]);
               *(u32x4*)(dst + (size_t)n * ldd + 8 * kc) = w; } }
    __syncthreads();
}
struct ConvTile { const float* src; bf16* dst; unsigned char* dst8; size_t lds_, ldd; int nvalid; };
constexpr int CT_WIN1 = 16 * 142, CT_WBR1 = 8 * 16, CT_WOUT1 = 16 * 16, CT_W1 = 8 * 32, CT_W2 = 8;
__device__ __forceinline__ ConvTile conv_win(const Params& P, int l, int r) { ConvTile c; c.dst8 = nullptr;
    const int nt = r / 16, kt = r % 16; const int n0 = nt * 128;
    int s0, nv = 128; if (n0 < C_NZ) s0 = n0; else if (n0 < C_SQ) s0 = 6680 + (n0 - C_NZ); else if (n0 < C_NG) s0 = 7704 + (n0 - C_SQ);
    else if (n0 < C_MG) { s0 = 6656 + (n0 - C_NG); nv = (n0 == C_NG) ? 24 : 0; if (nv == 0) s0 = 0; } else s0 = 11800 + (n0 - C_MG);
    c.src = P.w_in + ((size_t)l * DM + kt * 128) * N_IN + s0; c.lds_ = N_IN; c.nvalid = nv; c.ldd = DM;
    c.dst = (bf16*)(P.ws + WS_WIN) + ((size_t)l * LDP + n0) * DM + kt * 128;
    if (n0 >= C_MG) c.dst8 = P.ws + WS_WG8 + ((size_t)l * N_F8 + (n0 - C_MG)) * DM + kt * 128;
    return c; }
__device__ __forceinline__ ConvTile conv_wbr(const Params& P, int m, int r) { ConvTile c; c.dst8 = nullptr; const int nt = r / 8, kt = r % 8;
    c.src = P.w_branch + ((size_t)m * 1024 + kt * 128) * DM + nt * 128; c.lds_ = DM; c.nvalid = 128;
    c.dst = (bf16*)(P.ws + WS_WBR) + ((size_t)m * DM + nt * 128) * 1024 + kt * 128; c.ldd = 1024; return c; }
__device__ __forceinline__ ConvTile conv_wout(const Params& P, int l, int r) { ConvTile c; c.dst8 = nullptr; const int nt = r / 16, kt = r % 16;
    c.src = P.w_out + ((size_t)l * DM + kt * 128) * DM + nt * 128; c.lds_ = DM; c.nvalid = 128;
    c.dst = (bf16*)(P.ws + WS_WOUT) + ((size_t)l * DM + nt * 128) * DM + kt * 128; c.ldd = DM; return c; }
__device__ __forceinline__ ConvTile conv_cmpw(const Params& P, int t) { ConvTile c; c.dst8 = nullptr;
    if (t < CT_W1) { const int kv = t / 128, r = t % 128, l = r / 32, kt = r % 32;
        c.src = (kv ? P.w1_v : P.w1_k) + ((size_t)l * 4096 + kt * 128) * 128; c.lds_ = 128; c.nvalid = 128;
        c.dst = (bf16*)(P.ws + (kv ? WS_W1V : WS_W1K)) + (size_t)l * 128 * 4096 + kt * 128; c.ldd = 4096; return c; }
    t -= CT_W1;
    { const int kv = t / 4, l = t % 4;
        c.src = (kv ? P.w2_v : P.w2_k) + (size_t)l * 128 * 128; c.lds_ = 128; c.nvalid = 128;
        c.dst = (bf16*)(P.ws + (kv ? WS_W2V : WS_W2K)) + (size_t)l * 128 * 128; c.ldd = 128; return c; }
}
constexpr int CT_PRO = CT_WIN1 + CT_W1 + CT_W2;
__device__ __forceinline__ ConvTile conv_decode_pro(const Params& P, int t) { if (t < CT_WIN1) return conv_win(P, 0, t); return conv_cmpw(P, t - CT_WIN1); }
constexpr int CT_DEF_A = 3 * CT_WBR1 + CT_WOUT1, CT_DEF = CT_DEF_A + CT_WIN1, CONV_TPI = 4;
__device__ __forceinline__ constexpr int conv_def_items(int l) { return ((l + 1 < DEPTH ? CT_DEF : CT_DEF_A) + CONV_TPI - 1) / CONV_TPI; }
__device__ __forceinline__ ConvTile conv_decode_def(const Params& P, int l, int t) {
    if (t < 3 * CT_WBR1) return conv_wbr(P, l * 3 + t / CT_WBR1, t % CT_WBR1);
    t -= 3 * CT_WBR1; if (t < CT_WOUT1) return conv_wout(P, l, t);
    return conv_win(P, l + 1, t - CT_WOUT1); }
__device__ __forceinline__ void conv_item(const Params& P, int l, int item, char* lds) {
    const int nt_ = (l + 1 < DEPTH) ? CT_DEF : CT_DEF_A, t0 = item * CONV_TPI, t1 = (t0 + CONV_TPI < nt_) ? t0 + CONV_TPI : nt_;
    f32x4 r[8]; ConvTile c = conv_decode_def(P, l, t0); conv_tile_load(r, c.src, c.lds_, c.nvalid);
    for (int t = t0; t < t1; ++t) {
        ConvTile cn = c; f32x4 rn[8];
        if (t + 1 < t1) { cn = conv_decode_def(P, l, t + 1); conv_tile_load(rn, cn.src, cn.lds_, cn.nvalid); }
        conv_tile_store(r, c.dst, c.ldd, lds, c.dst8);
        if (t + 1 < t1) {
#pragma unroll
            for (int i = 0; i < 8; ++i) r[i] = rn[i]; }
        c = cn;
    }
}
__device__ __forceinline__ void prologue_phase(const Params& P, char* lds) {
    const int tid = opaque_tid();
    {
        f32x4 r[8]; int t = blockIdx.x;
        ConvTile c = {}; if (t < CT_PRO) { c = conv_decode_pro(P, t); conv_tile_load(r, c.src, c.lds_, c.nvalid); }
        while (t < CT_PRO) {
            const int tn = t + gridDim.x; ConvTile cn = c; f32x4 rn[8];
            if (tn < CT_PRO) { cn = conv_decode_pro(P, tn); conv_tile_load(rn, cn.src, cn.lds_, cn.nvalid); }
            conv_tile_store(r, c.dst, c.ldd, lds, c.dst8);
            if (tn < CT_PRO) {
#pragma unroll
                for (int i = 0; i < 8; ++i) r[i] = rn[i]; }
            c = cn; t = tn;
        }
    }
    {
        float* sl = (float*)lds;
        float* modp = (float*)(P.ws + WS_MODP);
        for (int it = blockIdx.x; it < 4 * 32 * 12; it += gridDim.x) {
            const int l = it / 384, r = it % 384, kc = r / 12, jb = r % 12, j = jb * 512 + tid;
            __syncthreads();
            if (tid < 256) { const int b = tid >> 6, k = tid & 63; sl[tid] = siluf_(P.c[(size_t)b * DM + kc * 64 + k]); }
            __syncthreads();
            const float* w = P.w_ada + ((size_t)l * DM + kc * 64) * 6144 + j;
            float a0 = 0.f, a1 = 0.f, a2 = 0.f, a3 = 0.f;
#pragma unroll 16
            for (int k = 0; k < 64; ++k) { const float wv = w[(size_t)k * 6144]; a0 += sl[k] * wv; a1 += sl[64 + k] * wv; a2 += sl[128 + k] * wv; a3 += sl[192 + k] * wv; }
            float* mp = modp + (((size_t)l * 32 + kc) * 4) * 6144 + j;
            mp[0] = a0; mp[6144] = a1; mp[2 * 6144] = a2; mp[3 * 6144] = a3;
        }
        __syncthreads();
    }
    {
        float* rope = (float*)(P.ws + WS_ROPE);
        for (int i = blockIdx.x * 512 + tid; i < SEQ * 16; i += gridDim.x * 512) {
            const int pos = i >> 4, fi = i & 15;
            const float inv = powf(500000.0f, -(float)(2 * fi) / 32.0f);
            const float ang = (float)pos * inv;
            rope[pos * 32 + fi] = cosf(ang); rope[pos * 32 + 16 + fi] = sinf(ang);
        }
    }
}
__device__ __forceinline__ void modreduce_phase(const Params& P) {
    const int tid = opaque_tid();
    const float* modp = (const float*)(P.ws + WS_MODP); float* mod = (float*)(P.ws + WS_MOD);
    for (int i = blockIdx.x * 512 + tid; i < 4 * 4 * 6144; i += gridDim.x * 512) {
        const int l = i / (4 * 6144), r = i % (4 * 6144), b = r / 6144, j = r % 6144;
        float s = P.b_ada[(size_t)l * 6144 + j];
        for (int kc = 0; kc < 32; ++kc) s += modp[(((size_t)l * 32 + kc) * 4 + b) * 6144 + j];
        mod[i] = s;
    }
    if (blockIdx.x == 0 && tid < 256) {
        const int l = tid >> 6, lane = tid & 63;
        float s1 = P.lq1[l * 128 + lane] * P.lk1[l * 128 + lane] + P.lq1[l * 128 + 64 + lane] * P.lk1[l * 128 + 64 + lane];
        float s2 = P.lq2[l * 128 + lane] * P.lk2[l * 128 + lane] + P.lq2[l * 128 + 64 + lane] * P.lk2[l * 128 + 64 + lane];
        s1 = wave_sum(s1); s2 = wave_sum(s2);
        if (lane == 0) ((float*)(P.ws + WS_LAM))[l] = expf(s1) - expf(s2) + (0.8f - 0.6f * expf(-0.3f * (float)l));
    }
}

__device__ __forceinline__ BlockRef diff_ref(const bf16* proj, int item, int pass) {
    const int bh = item >> 3, x = item & 7, b = bh >> 4, hh = bh & 15, h = hh >> 2, c = (hh >> 1) & 1, vh = hh & 1;
    const int qb = pass ? 15 - x : x;
    BlockRef r; const bf16* base = proj + (size_t)b * SEQ * LDP;
    r.Q = base + (size_t)qb * QB * LDP + C_AQ + (h * 2 + c) * 128; r.K = base + C_AK + (h * 2 + c) * 128; r.V = base + C_AV + h * 256 + vh * 128;
    r.M = nullptr; r.P0 = qb * QB; r.row0 = b * SEQ + qb * QB + c * MTOK; r.aux = h * 256 + vh * 128; r.aux2 = 0; return r;
}
__device__ __forceinline__ BlockRef win_ref(const bf16* proj, int item, int pass) {
    const int blk = item * 2 + pass, bg = blk >> 6, qb = blk & 63, b = bg >> 1, g = bg & 1, head = g * 4;
    BlockRef r; const bf16* base = proj + (size_t)b * SEQ * LDP;
    r.Q = base + (size_t)qb * 64 * LDP + C_NQ + head * 128; r.K = base + C_NKW + g * 128; r.V = base + C_NVW + g * 128;
    r.M = nullptr; r.P0 = qb * 64; r.row0 = b * SEQ + qb * 64; r.aux = head * 128; r.aux2 = head; return r;
}
__device__ __forceinline__ BlockRef slc_ref(const bf16* proj, const u64* selm, int item, int pass) {
    const int bg = item >> 5, x = item & 31, b = bg >> 1, g = bg & 1, head = g * 4;
    const int qb = pass ? 63 - x : x;
    BlockRef r; const bf16* base = proj + (size_t)b * SEQ * LDP;
    r.Q = base + (size_t)qb * 64 * LDP + C_NQ + head * 128; r.K = base + C_NKS + g * 128; r.V = base + C_NVS + g * 128;
    r.M = selm + (size_t)(b * 2 + g) * SEQ; r.P0 = qb * 64; r.row0 = b * SEQ + qb * 64; r.aux = head * 128; r.aux2 = head; return r;
}
__device__ __forceinline__ BlockRef sb_ref(const bf16* proj, int blk) {
    const int bh = blk >> 4, qb = blk & 15, b = bh >> 3, head = bh & 7;
    BlockRef r; const bf16* base = proj + (size_t)b * SEQ * LDP;
    r.Q = base + (size_t)qb * QB * LDP + C_SQ + head * 128; r.K = base + C_SK + head * 128; r.V = base + C_SV + head * 128;
    r.M = nullptr; r.P0 = qb * QB; r.row0 = b * SEQ + qb * QB; r.aux = head * 128; r.aux2 = head; return r;
}

constexpr int N_PHASES = 3 + 7 * DEPTH;
typedef const __attribute__((address_space(4))) Params* kparams_t;
__device__ __forceinline__ kparams_t kparams() { kparams_t p = (kparams_t)__builtin_amdgcn_kernarg_segment_ptr(); asm volatile("" : "+s"(p)); return p; }
__device__ __forceinline__ Params load_params(kparams_t k) { Params p;
    p.x = k->x; p.c = k->c; p.norm_pre_g = k->norm_pre_g; p.norm_post_g = k->norm_post_g; p.w_ada = k->w_ada; p.b_ada = k->b_ada; p.w_in = k->w_in;
    p.lq1 = k->lq1; p.lk1 = k->lk1; p.lq2 = k->lq2; p.lk2 = k->lk2; p.diff_norm_g = k->diff_norm_g;
    p.pe_k = k->pe_k; p.w1_k = k->w1_k; p.w2_k = k->w2_k; p.pe_v = k->pe_v; p.w1_v = k->w1_v; p.w2_v = k->w2_v; p.w_branch = k->w_branch; p.w_out = k->w_out;
    p.out = k->out; p.ws = k->ws; return p; }
template <int MODE> __global__ void __launch_bounds__(512, 2) hybrid_fwd(Params Parg, int ph_lo, int ph_hi) {
    extern __shared__ __attribute__((aligned(16))) unsigned char lds_raw[];
    char* lds = (char*)lds_raw;
    (void)Parg;
    { const int tid = threadIdx.x;
      if (tid < 64) ((volatile unsigned*)(lds + LDS_CTL))[tid] = 0u; }
    __syncthreads();
    const bool one = (ph_hi - ph_lo) > 1;
    if (one) (void)xcd_barrier_post((unsigned*)(kparams()->ws + WS_CTL) + CW_BAR, (volatile LAS unsigned*)(lds + LDS_CTL));
    if (one && threadIdx.x == 0) (void)__hip_atomic_fetch_or((unsigned*)(kparams()->ws + WS_CTL) + CW_GXM + 64 * (blockIdx.x & 7), 1u << xb_xcc_id(), __ATOMIC_RELAXED, __HIP_MEMORY_SCOPE_AGENT);
#define IN(k) (ph_lo <= (k) && (k) < ph_hi)
#define TY(t) (MODE < 0 || MODE == (t) || ((t) == 4 && MODE >= 10 && MODE < 14))
#define SUB(s_) (MODE < 10 || MODE == 10 + (s_))
#define SEAM(k) do { if ((k) + 1 < ph_hi) { XcdBarrier b_; b_.bar = (unsigned*)(kparams()->ws + WS_CTL) + CW_BAR; b_.x = xb_xcc_id(); b_.st = (volatile LAS unsigned*)(lds + LDS_CTL); xcd_barrier(b_); } } while (0)
#define LOCAL_SEAM(k) do { if ((k) + 1 < ph_hi) { asm volatile("s_waitcnt vmcnt(0)" ::: "memory"); __syncthreads(); \
        if (threadIdx.x == 0) { __builtin_amdgcn_fence(__ATOMIC_ACQUIRE, "agent"); asm volatile("s_waitcnt vmcnt(0)" ::: "memory"); } __syncthreads(); } } while (0)
#define GROUP_SEAM(k, use_) do { if ((k) + 1 < ph_hi) { if (grp_ok) { unsigned* ctl_ = (unsigned*)(kparams()->ws + WS_CTL); group_barrier(ctl_ + CW_BAR, ctl_ + CW_GRP + 64 * (blockIdx.x & 7), 32u * (unsigned)(use_), ctl_ + CW_GXM + 64 * (blockIdx.x & 7), (volatile LAS unsigned*)(lds + LDS_CTL)); } else SEAM(k); } } while (0)
#define REP(id) for (int rep_ = 0; rep_ < ((((PROBE_DUP_MASK) >> (id)) & 1) ? 2 : 1); ++rep_)
#define KP() const Params P = load_params(kparams()); bf16* proj = (bf16*)(P.ws + WS_PROJ); const int G = gridDim.x, c = blockIdx.x; (void)proj; (void)G; (void)c
    if constexpr (TY(0)) if (IN(0)) { { KP(); REP(0) prologue_phase(P, lds); } SEAM(0); }
    if constexpr (TY(1)) if (IN(1)) { { KP(); REP(1) modreduce_phase(P); } SEAM(1); }
    if constexpr (TY(2)) if (IN(2)) { { KP(); REP(2) norm_phase(P, 0, P.x); } SEAM(2); }

    const bool grp_ok = gridDim.x == 256;
    for (int l = 0; l < DEPTH; ++l) {
        const int pb = 3 + 7 * l;
        if constexpr (TY(3)) if (IN(pb + 0)) {
            { KP();
            pg8::Gemm g{(const pg8::bf16_t*)(P.ws + WS_H), (const pg8::bf16_t*)(P.ws + WS_WIN) + (size_t)l * LDP * DM, MTOK, N_BF, DM};
            pg8::StaticOrder S; S.init(MTOK, N_BF, G, c);
            pg8::EpiProj E{(pg8::bf16_t*)proj, (const float*)(P.ws + WS_ROPE)};
            REP(3) pg8::gemm_phase<pg8::EpiProj, pg8::StaticOrder, true, true>((PG8_LAS unsigned char*)lds_raw, g, S, E);
            pg8::Gemm g8{(const pg8::bf16_t*)(P.ws + WS_H8), (const pg8::bf16_t*)(P.ws + WS_WG8 + (size_t)l * N_F8 * DM), MTOK, N_F8, DM / 2};
            pg8::StaticOrder S8; S8.init(MTOK, N_F8, G, c);
            pg8::EpiGate8 E8{(pg8::bf16_t*)proj};
            REP(3) pg8::gemm_phase<pg8::EpiGate8, pg8::StaticOrder, false, true, true>((PG8_LAS unsigned char*)lds_raw, g8, S8, E8); }
            SEAM(pb + 0);
        }
        if constexpr (TY(4)) if (IN(pb + 1)) {
            if constexpr (SUB(0)) REP(10) {
                KP();
                for (int L = c; L < 256; L += G) {
                    const int bhc = L >> 3, x = L & 7, b = bhc >> 3, h = (bhc >> 1) & 3, cm = bhc & 1;
                    const bf16* base = proj + (size_t)b * SEQ * LDP;
                    for (int pass = 0; pass < 2; ++pass) {
                        const int qb = pass ? 15 - x : x;
                        BlockRef r; r.Q = base + (size_t)qb * QB * LDP + C_AQ + (h * 2 + cm) * 128; r.K = base + C_AK + (h * 2 + cm) * 128; r.V = base + C_AV + h * 256;
                        r.M = nullptr; r.P0 = qb * QB; r.row0 = b * SEQ + qb * QB + cm * MTOK; r.aux = h * 256; r.aux2 = 0;
                        diff_block(r, (bf16*)(P.ws + WS_DIFFO), lds);
                    }
                }
            }
            if constexpr (SUB(1)) REP(11) {
                KP();
                EpiAttnStore E{(bf16*)(P.ws + WS_OWIN), 1024, lds};
                for (int L0 = c; L0 < 256; L0 += G) { const int L = L0;
                    for (int pass = 0; pass < 2; ++pass) { const BlockRef cur = win_ref(proj, L, pass); attn_simple<false, 512, 4, EpiAttnStore>(cur, lds, E); } }
            }
            if constexpr (SUB(2)) {
                KP();
                EpiSb E{proj, (bf16*)(P.ws + WS_YS) + (size_t)2 * MTOK * 1024, lds};
                unsigned* qctr = (unsigned*)(P.ws + WS_CTL) + CW_QUEUE + 64 * l;
                volatile unsigned* qslot = (volatile unsigned*)(lds + LDS_CTL + 64);
                const bool t0 = threadIdx.x == 0;
                if (t0) *qslot = __hip_atomic_fetch_add(qctr, 1u, __ATOMIC_RELAXED, __HIP_MEMORY_SCOPE_AGENT);
                __syncthreads(); unsigned it = *qslot; __syncthreads();
                const unsigned nq = 640u + (unsigned)conv_def_items(l);
                while (it < nq) {
                    unsigned nx = 0u; if (t0) nx = __hip_atomic_fetch_add(qctr, 1u, __ATOMIC_RELAXED, __HIP_MEMORY_SCOPE_AGENT);
                    if (it < 128u) { const int kv = (int)it >> 6, bg = ((int)it >> 3) & 7, nt = (int)it & 7;
                        compress_item(proj, (kv ? P.pe_v : P.pe_k) + (size_t)l * 32 * 128, (const bf16*)(P.ws + (kv ? WS_W1V : WS_W1K)) + (size_t)l * 128 * 4096,
                                      (const bf16*)(P.ws + (kv ? WS_W2V : WS_W2K)) + (size_t)l * 128 * 128, (bf16*)(P.ws + (kv ? WS_VCMP : WS_KCMP)), kv, bg, nt, lds); }
                    else if (it >= 640u) conv_item(P, l, (int)it - 640, lds);
                    else { const int idx = (int)it - 128, b = idx >> 7, hp = (idx >> 5) & 3, qh = 31 - (idx & 31);
                        const bf16* base = proj + (size_t)b * SEQ * LDP + hp * 256;
                        SbPairRef pr; pr.Q = base + (size_t)qh * 128 * LDP + C_SQ; pr.K = base + C_SK; pr.V = base + C_SV; pr.P0 = qh * 128; pr.row0 = b * SEQ + qh * 128; pr.aux = hp * 256;
                        sb_pair(pr, lds, E); }
                    if (t0) *qslot = nx;
                    __syncthreads(); it = *qslot; __syncthreads();
                }
            }
            SEAM(pb + 1);
        }
        if constexpr (TY(5)) if (IN(pb + 2)) {
            { KP(); REP(5) for (int it = c; it < 256; it += G)
                cmp_pair(proj, (const bf16*)(P.ws + WS_KCMP), (const bf16*)(P.ws + WS_VCMP), (bf16*)(P.ws + WS_OCMP), (u64*)(P.ws + WS_SELM), it, lds);
            REP(14) diffpost_phase(P, l); }
            LOCAL_SEAM(pb + 2);
        }
        if constexpr (TY(6)) if (IN(pb + 3)) {
            { KP();
            EpiNsaCombine E{proj, (const bf16*)(P.ws + WS_OCMP), (const bf16*)(P.ws + WS_OWIN), (bf16*)(P.ws + WS_YS) + (size_t)MTOK * 1024, lds};
            const u64* selm = (const u64*)(P.ws + WS_SELM);
            REP(6) { for (int L = c; L < 256; L += G) {
                for (int pass = 0; pass < 2; ++pass) { const BlockRef cur = slc_ref(proj, selm, L, pass); attn_simple<true, 1 << 30, 4, EpiNsaCombine>(cur, lds, E); }
            } } }
            SEAM(pb + 3);
        }
        if constexpr (TY(7)) if (IN(pb + 4)) {
            { KP();
            pg8::Gemm g{(const pg8::bf16_t*)(P.ws + WS_YS), (const pg8::bf16_t*)(P.ws + WS_WBR) + (size_t)l * 3 * DM * 1024, 3 * MTOK, 3 * DM, 1024};
            pg8::BranchOrder S{G, c};
            pg8::EpiBranch E{(const pg8::bf16_t*)proj, (pg8::bf16_t*)(P.ws + WS_MERGED)};
            REP(7) pg8::gemm_phase<pg8::EpiBranch, pg8::BranchOrder, false, true>((PG8_LAS unsigned char*)lds_raw, g, S, E); }
            GROUP_SEAM(pb + 4, 3 * l + 1);
        }
        if constexpr (TY(8)) if (IN(pb + 5)) {
            { KP();
            pg8::Gemm g{(const pg8::bf16_t*)(P.ws + WS_MERGED), (const pg8::bf16_t*)(P.ws + WS_WOUT) + (size_t)l * DM * DM, MTOK, DM, DM};
            pg8::StaticOrder S; S.init(MTOK, DM, G, c);
            pg8::EpiPlain E{(pg8::bf16_t*)(P.ws + WS_OUTPRE), DM};
            REP(8) pg8::gemm_phase<pg8::EpiPlain, pg8::StaticOrder, false, true>((PG8_LAS unsigned char*)lds_raw, g, S, E); }
            GROUP_SEAM(pb + 5, 3 * l + 2);
        }
        if constexpr (TY(9)) if (IN(pb + 6)) {
            { KP(); post_phase(P, l, l == 0 ? P.x : P.out, grp_ok); }
            GROUP_SEAM(pb + 6, 3 * l + 3);
        }
    }
#undef IN
#undef TY
#undef SUB
#undef SEAM
#undef REP
#undef KP
}

#if MK_ONE_LAUNCH
static hipError_t set_attrs() { return hipFuncSetAttribute((const void*)hybrid_fwd<-1>, hipFuncAttributeMaxDynamicSharedMemorySize, LDS_BYTES); }
#else
template <int T> static hipError_t set_attr1() { return hipFuncSetAttribute((const void*)hybrid_fwd<T>, hipFuncAttributeMaxDynamicSharedMemorySize, LDS_BYTES); }
static hipError_t set_attrs() { hipError_t e = hipSuccess, r;
    r = set_attr1<0>(); if (r != hipSuccess) e = r; r = set_attr1<1>(); if (r != hipSuccess) e = r; r = set_attr1<2>(); if (r != hipSuccess) e = r; r = set_attr1<3>(); if (r != hipSuccess) e = r;
    r = set_attr1<5>(); if (r != hipSuccess) e = r; r = set_attr1<6>(); if (r != hipSuccess) e = r; r = set_attr1<7>(); if (r != hipSuccess) e = r;
    r = set_attr1<8>(); if (r != hipSuccess) e = r; r = set_attr1<9>(); if (r != hipSuccess) e = r;
    r = set_attr1<10>(); if (r != hipSuccess) e = r; r = set_attr1<11>(); if (r != hipSuccess) e = r; r = set_attr1<12>(); if (r != hipSuccess) e = r; r = set_attr1<13>(); if (r != hipSuccess) e = r; return e; }
static void launch_phase(int ty, int grid, hipStream_t stream, const Params& p, int k) {
    switch (ty) {
    case 0: hipLaunchKernelGGL(hybrid_fwd<0>, dim3(grid), dim3(512), LDS_BYTES, stream, p, k, k + 1); break;
    case 1: hipLaunchKernelGGL(hybrid_fwd<1>, dim3(grid), dim3(512), LDS_BYTES, stream, p, k, k + 1); break;
    case 2: hipLaunchKernelGGL(hybrid_fwd<2>, dim3(grid), dim3(512), LDS_BYTES, stream, p, k, k + 1); break;
    case 3: hipLaunchKernelGGL(hybrid_fwd<3>, dim3(grid), dim3(512), LDS_BYTES, stream, p, k, k + 1); break;
    case 4: hipLaunchKernelGGL(hybrid_fwd<10>, dim3(grid), dim3(512), LDS_BYTES, stream, p, k, k + 1);
            hipLaunchKernelGGL(hybrid_fwd<11>, dim3(grid), dim3(512), LDS_BYTES, stream, p, k, k + 1);
            hipLaunchKernelGGL(hybrid_fwd<12>, dim3(grid), dim3(512), LDS_BYTES, stream, p, k, k + 1);
            hipLaunchKernelGGL(hybrid_fwd<13>, dim3(grid), dim3(512), LDS_BYTES, stream, p, k, k + 1); break;
    case 5: hipLaunchKernelGGL(hybrid_fwd<5>, dim3(grid), dim3(512), LDS_BYTES, stream, p, k, k + 1); break;
    case 6: hipLaunchKernelGGL(hybrid_fwd<6>, dim3(grid), dim3(512), LDS_BYTES, stream, p, k, k + 1); break;
    case 7: hipLaunchKernelGGL(hybrid_fwd<7>, dim3(grid), dim3(512), LDS_BYTES, stream, p, k, k + 1); break;
    case 8: hipLaunchKernelGGL(hybrid_fwd<8>, dim3(grid), dim3(512), LDS_BYTES, stream, p, k, k + 1); break;
    default: hipLaunchKernelGGL(hybrid_fwd<9>, dim3(grid), dim3(512), LDS_BYTES, stream, p, k, k + 1); break;
    }
}
#endif
extern "C" void kernel_launch(void* const* d_in, const int* in_sizes, int n_in, void* d_out, int out_size, void* d_ws, size_t ws_size, hipStream_t stream) {
    static int grid = 0;
    if (grid == 0) {
        if (n_in != 20 || out_size != MTOK * DM || ws_size < WS_END) { fprintf(stderr, "kernel_launch: unexpected shapes (n_in %d, out %d, ws %zu < %zu)\n", n_in, out_size, ws_size, (size_t)WS_END); grid = -1; return; }
        int dev = 0, cus = 0, per_cu = 0;
        if (hipGetDevice(&dev) != hipSuccess || hipDeviceGetAttribute(&cus, hipDeviceAttributeMultiprocessorCount, dev) != hipSuccess) { grid = -1; return; }
        if (set_attrs() != hipSuccess) { fprintf(stderr, "kernel_launch: hipFuncSetAttribute failed\n"); grid = -1; return; }
        (void)per_cu;
        (void)hipGetLastError();
        grid = cus;
    }
    if (grid < 0) return;
    (void)hipMemsetAsync((char*)d_ws + WS_CTL, 0, CTL_BYTES, stream);
    Params p{};
    p.x = (const float*)d_in[0]; p.c = (const float*)d_in[1]; p.norm_pre_g = (const float*)d_in[2]; p.norm_post_g = (const float*)d_in[3];
    p.w_ada = (const float*)d_in[4]; p.b_ada = (const float*)d_in[5]; p.w_in = (const float*)d_in[6];
    p.lq1 = (const float*)d_in[7]; p.lk1 = (const float*)d_in[8]; p.lq2 = (const float*)d_in[9]; p.lk2 = (const float*)d_in[10]; p.diff_norm_g = (const float*)d_in[11];
    p.pe_k = (const float*)d_in[12]; p.w1_k = (const float*)d_in[13]; p.w2_k = (const float*)d_in[14]; p.pe_v = (const float*)d_in[15]; p.w1_v = (const float*)d_in[16]; p.w2_v = (const float*)d_in[17];
    p.w_branch = (const float*)d_in[18]; p.w_out = (const float*)d_in[19];
    p.out = (float*)d_out; p.ws = (unsigned char*)d_ws;
#if MK_ONE_LAUNCH
    hipLaunchKernelGGL(hybrid_fwd<-1>, dim3(grid), dim3(512), LDS_BYTES, stream, p, 0, N_PHASES);
#else
    for (int k = 0; k < N_PHASES; ++k) launch_phase(k < 3 ? k : 3 + (k - 3) % 7, grid, stream, p, k);
#endif
}
```

```cpp
#include <hip/hip_runtime.h>
#include <cstdio>
#include <cstdint>

#ifndef MK_ONE_LAUNCH
#define MK_ONE_LAUNCH 1
#endif
#ifndef PROBE_DUP_MASK
#define PROBE_DUP_MASK 0
#endif

namespace pg8 {
#define PG8_LAS __attribute__((address_space(3)))
typedef unsigned short bf16_t;
typedef short bf16x8 __attribute__((ext_vector_type(8)));
typedef float f32x4 __attribute__((ext_vector_type(4)));
typedef unsigned u32x4 __attribute__((ext_vector_type(4)));
constexpr int BM = 256, BK = 64, HALF = 128, HTB = HALF * BK * 2  , STAGE_BYTES = 8 * HTB, NXCD = 8, WGM = 8;

__host__ __device__ __forceinline__ int lds_byte(int r, int c) { const int st = (r >> 4) * 2 + (c >> 5), rr = r & 15, cc = c & 31, ob = rr * 64 + cc * 2; return st * 1024 + (ob ^ (((ob >> 9) & 1) << 5)); }
__host__ __device__ __forceinline__ void stage_rc(int b, int& R, int& C) { const int st = b / 1024, sb = b % 1024, swz = sb ^ (((sb >> 9) & 1) << 5); R = (st >> 1) * 16 + swz / 64; C = (st & 1) * 32 + (swz % 64) / 2; }
__host__ __device__ __forceinline__ int perm32(int rho) { const int n = rho >> 4, i = rho & 15; return 8 * (i >> 2) + 4 * n + (i & 3); }

struct Unit { int pm, pn; };
struct Gemm { const bf16_t* A; const bf16_t* Bt; int M, N, K; };

struct StaticOrder {
    int nM, nN, nwg, G, c;
    __host__ __device__ void init(int M, int N, int G_, int c_) { nM = M / BM; nN = N / BM; nwg = nM * nN; G = G_; c = c_; }
    __host__ __device__ bool next(int i, Unit& u) const {
        const long L = (long)i * G + c; if (L >= nwg) return false;
        int wgid = (int)L; { const int q = nwg / NXCD, r = nwg % NXCD, xcd = wgid % NXCD, off = wgid / NXCD; wgid = (xcd < r ? xcd * (q + 1) : r * (q + 1) + (xcd - r) * q) + off; }
        const int nig = WGM * nN, gid = wgid / nig, fm = gid * WGM, gsz = (nM - fm) < WGM ? (nM - fm) : WGM;
        u.pm = fm + ((wgid % nig) % gsz); u.pn = (wgid % nig) / gsz; return true;
    }
    __device__ __forceinline__ void a_ready(const Unit&) const {}
    __device__ __forceinline__ void done(const Unit&) const {}
};

__device__ __forceinline__ unsigned cvt_pk_bf16(float lo, float hi) { unsigned r; asm volatile("v_cvt_pk_bf16_f32 %0, %1, %2" : "=v"(r) : "v"(lo), "v"(hi)); return r; }
typedef int pg8_v8i32 __attribute__((ext_vector_type(8))); typedef int pg8_v4i32 __attribute__((ext_vector_type(4)));
__device__ __forceinline__ pg8_v8i32 pg8_cat8(bf16x8 lo, bf16x8 hi) { const pg8_v4i32 a = __builtin_bit_cast(pg8_v4i32, lo), b = __builtin_bit_cast(pg8_v4i32, hi); return __builtin_shufflevector(a, b, 0, 1, 2, 3, 4, 5, 6, 7); }
template <class Epi, class Sched, bool ALIGN_EPI = false, bool SP2 = false, bool F8 = false>
__device__ __forceinline__ void gemm_phase(PG8_LAS unsigned char* lds, const Gemm g, const Sched& S, const Epi& E) {
    int tid_ = threadIdx.x; asm volatile("" : "+v"(tid_)); const int tid = tid_, wid = __builtin_amdgcn_readfirstlane(tid >> 6), lane = tid & 63, wr = wid >> 2, wc = wid & 3, fr = lane & 15, fq = lane >> 4;
    const int K = g.K, nt = K / BK;
    unsigned voffA[2], voffB[2];
#pragma unroll
    for (int i = 0; i < 2; ++i) { int R, C; stage_rc(tid * 16 + i * 8192, R, C); const int Rb = Epi::PERM ? ((R & ~31) + perm32(R & 31)) : R;
        voffA[i] = (unsigned)(R * K + C) * 2u; voffB[i] = (unsigned)(Rb * K + C) * 2u; }
    const __amdgpu_buffer_rsrc_t rsrc_voffA = __builtin_amdgcn_make_buffer_rsrc((void*)g.A, 0, 0x7fffffff, 0x00020000), rsrc_voffB = __builtin_amdgcn_make_buffer_rsrc((void*)g.Bt, 0, 0x7fffffff, 0x00020000);
    const unsigned kstep = (unsigned)(BK * 2);
    const unsigned hstep = (unsigned)(HALF * K * 2);
    const unsigned tstep = 2u * hstep;
    const unsigned ldsw = (unsigned)wid * 1024u;
    const int aoff = lds_byte(wr * 64 + fr, fq * 8), boff = lds_byte(wc * 32 + fr, fq * 8);
#define PG8_SA(b, h) (((b) * 2 + (h)) * HTB)
#define PG8_SB(b, h) ((4 + (b) * 2 + (h)) * HTB)
#define PG8_STAGE(bufoff, gbase, voff) do { _Pragma("unroll") for (int _i = 0; _i < 2; ++_i) \
        __builtin_amdgcn_raw_ptr_buffer_load_lds(rsrc_##voff, (PG8_LAS void*)(lds + (bufoff) + ldsw + _i * 8192), 16, (int)(voff)[_i], (int)(unsigned)(gbase), 0, 0); } while (0)
#define PG8_LD8(addr_) __builtin_shufflevector(*(const PG8_LAS pg8_v4i32*)(addr_), *(const PG8_LAS pg8_v4i32*)((addr_) + 1024), 0, 1, 2, 3, 4, 5, 6, 7)
#define PG8_LDA(dst, b, h) do { if constexpr (F8) { _Pragma("unroll") for (int m = 0; m < 4; ++m) dst##8[m] = PG8_LD8(lds + PG8_SA(b, h) + aoff + m * 2048); } \
        else { _Pragma("unroll") for (int m = 0; m < 4; ++m) _Pragma("unroll") for (int k = 0; k < 2; ++k) dst[m][k] = *(const PG8_LAS bf16x8*)(lds + PG8_SA(b, h) + aoff + m * 2048 + k * 1024); } } while (0)
#define PG8_LDB(dst, b, h) do { if constexpr (F8) { _Pragma("unroll") for (int n = 0; n < 2; ++n) dst##8[n] = PG8_LD8(lds + PG8_SB(b, h) + boff + n * 2048); } \
        else { _Pragma("unroll") for (int n = 0; n < 2; ++n) _Pragma("unroll") for (int k = 0; k < 2; ++k) dst[n][k] = *(const PG8_LAS bf16x8*)(lds + PG8_SB(b, h) + boff + n * 2048 + k * 1024); } } while (0)
#define PG8_MMA(ai, bj, At, Bt) do { __builtin_amdgcn_s_setprio(1); \
        if constexpr (F8) { _Pragma("unroll") for (int m = 0; m < 4; ++m) _Pragma("unroll") for (int n = 0; n < 2; ++n) \
            asm volatile("v_mfma_scale_f32_16x16x128_f8f6f4 %0, %1, %2, %0, %3, %3 op_sel_hi:[0,0,0]" : "+v"(acc[ai][bj][m][n]) : "v"(Bt##8[n]), "v"(At##8[m]), "v"(sc8_)); } \
        else { _Pragma("unroll") for (int m = 0; m < 4; ++m) _Pragma("unroll") for (int n = 0; n < 2; ++n) _Pragma("unroll") for (int k = 0; k < 2; ++k) \
            acc[ai][bj][m][n] = __builtin_amdgcn_mfma_f32_16x16x32_bf16(Bt[n][k], At[m][k], acc[ai][bj][m][n], 0, 0, 0); } \
        __builtin_amdgcn_s_setprio(0); } while (0)
#define PG8_WAIT_V(n) asm volatile("s_waitcnt vmcnt(" #n ")" ::: "memory")
#define PG8_WAIT_L(n) asm volatile("s_waitcnt lgkmcnt(" #n ")" ::: "memory")
#define PG8_BAR __builtin_amdgcn_s_barrier()
#define PG8_SCHED __builtin_amdgcn_sched_barrier(0)
    Unit cur, nxt; int ui = 0;
    if (!S.next(0, cur)) return;
    f32x4 acc[2][2][4][2];
#pragma unroll
    for (int a = 0; a < 2; ++a)
#pragma unroll
        for (int b = 0; b < 2; ++b)
#pragma unroll
            for (int m = 0; m < 4; ++m)
#pragma unroll
                for (int n = 0; n < 2; ++n) acc[a][b][m][n] = (f32x4){0.f, 0.f, 0.f, 0.f};
    const int sc8_ = 0x7F7F7F7F;
    bf16x8 At[4][2], B0[2][2], B1[2][2]; pg8_v8i32 At8[4], B08[2], B18[2];
    unsigned cA = (unsigned)cur.pm * tstep, cB = (unsigned)cur.pn * tstep;
    S.a_ready(cur);
    if constexpr (SP2) {
        PG8_STAGE(PG8_SB(0, 0), cB, voffB); PG8_STAGE(PG8_SB(0, 1), cB + hstep, voffB); PG8_STAGE(PG8_SA(0, 0), cA, voffA); PG8_STAGE(PG8_SA(0, 1), cA + hstep, voffA);
        if (wr == 1) PG8_BAR;
        PG8_WAIT_V(2); PG8_BAR;
        PG8_STAGE(PG8_SB(1, 0), cB + kstep, voffB); PG8_STAGE(PG8_SA(1, 0), cA + kstep, voffA); PG8_STAGE(PG8_SB(1, 1), cB + hstep + kstep, voffB);
        PG8_WAIT_V(6); PG8_BAR;
    } else {
        PG8_STAGE(PG8_SB(0, 0), cB, voffB); PG8_STAGE(PG8_SA(0, 0), cA, voffA); PG8_STAGE(PG8_SB(0, 1), cB + hstep, voffB); PG8_STAGE(PG8_SA(0, 1), cA + hstep, voffA);
        if (wr == 1) PG8_BAR;
        PG8_WAIT_V(4); PG8_BAR;
        PG8_STAGE(PG8_SB(1, 0), cB + kstep, voffB); PG8_STAGE(PG8_SA(1, 0), cA + kstep, voffA); PG8_STAGE(PG8_SB(1, 1), cB + hstep + kstep, voffB);
        PG8_WAIT_V(6); PG8_BAR;
    }
    for (;;) {
        const bool has_next = S.next(ui + 1, nxt);
        const unsigned nA = has_next ? (unsigned)nxt.pm * tstep : cA, nB = has_next ? (unsigned)nxt.pn * tstep : cB;
        for (int t = 0; t < nt; t += 2) {
            const bool last = (t == nt - 2);
            const unsigned a1 = cA + (unsigned)(t + 1) * kstep;
            const unsigned a2 = last ? nA : cA + (unsigned)(t + 2) * kstep, b2 = last ? nB : cB + (unsigned)(t + 2) * kstep;
            const unsigned a3 = a2 + kstep, b3 = b2 + kstep;
            if (last && has_next) S.a_ready(nxt);
            if constexpr (SP2) {
            PG8_LDB(B0, 0, 0); PG8_LDB(B1, 0, 1); PG8_SCHED; PG8_LDA(At, 0, 0); PG8_STAGE(PG8_SA(1, 1), a1 + hstep, voffA);
            PG8_WAIT_V(8); PG8_WAIT_L(0); PG8_BAR; PG8_MMA(0, 0, At, B0); PG8_MMA(0, 1, At, B1); PG8_BAR; PG8_SCHED;
            PG8_LDA(At, 0, 1); PG8_STAGE(PG8_SB(0, 0), b2, voffB); PG8_STAGE(PG8_SB(0, 1), b2 + hstep, voffB); PG8_STAGE(PG8_SA(0, 0), a2, voffA);
            PG8_WAIT_V(8); PG8_WAIT_L(0); PG8_BAR; PG8_MMA(1, 0, At, B0); PG8_MMA(1, 1, At, B1); PG8_BAR; PG8_SCHED;
            PG8_LDB(B0, 1, 0); PG8_LDB(B1, 1, 1); PG8_SCHED; PG8_LDA(At, 1, 0); PG8_STAGE(PG8_SA(0, 1), a2 + hstep, voffA);
            PG8_WAIT_V(8); PG8_WAIT_L(0); PG8_BAR; PG8_MMA(0, 0, At, B0); PG8_MMA(0, 1, At, B1); PG8_BAR; PG8_SCHED;
            PG8_LDA(At, 1, 1); PG8_STAGE(PG8_SB(1, 0), b3, voffB); PG8_STAGE(PG8_SB(1, 1), b3 + hstep, voffB); PG8_STAGE(PG8_SA(1, 0), a3, voffA);
            PG8_WAIT_V(8); PG8_WAIT_L(0); PG8_BAR; PG8_MMA(1, 0, At, B0); PG8_MMA(1, 1, At, B1); PG8_BAR; PG8_SCHED;
            } else {
            PG8_LDB(B0, 0, 0); PG8_SCHED; PG8_LDA(At, 0, 0); PG8_STAGE(PG8_SA(1, 1), a1 + hstep, voffA);
            PG8_WAIT_L(8); PG8_BAR; PG8_WAIT_L(0); PG8_MMA(0, 0, At, B0); PG8_BAR; PG8_SCHED;
            PG8_LDB(B1, 0, 1); PG8_STAGE(PG8_SB(0, 0), b2, voffB);
            PG8_BAR; PG8_WAIT_L(0); PG8_MMA(0, 1, At, B1); PG8_BAR;
            PG8_LDA(At, 0, 1); PG8_STAGE(PG8_SA(0, 0), a2, voffA);
            PG8_BAR; PG8_WAIT_L(0); PG8_MMA(1, 0, At, B0); PG8_BAR; PG8_SCHED;
            PG8_STAGE(PG8_SB(0, 1), b2 + hstep, voffB);
            PG8_WAIT_V(6); PG8_BAR; PG8_MMA(1, 1, At, B1); PG8_BAR;
            PG8_LDB(B0, 1, 0); PG8_SCHED; PG8_LDA(At, 1, 0); PG8_STAGE(PG8_SA(0, 1), a2 + hstep, voffA);
            PG8_WAIT_L(8); PG8_BAR; PG8_WAIT_L(0); PG8_MMA(0, 0, At, B0); PG8_BAR; PG8_SCHED;
            PG8_LDB(B1, 1, 1); PG8_STAGE(PG8_SB(1, 0), b3, voffB);
            PG8_BAR; PG8_WAIT_L(0); PG8_MMA(0, 1, At, B1); PG8_BAR;
            PG8_LDA(At, 1, 1); PG8_STAGE(PG8_SA(1, 0), a3, voffA);
            PG8_BAR; PG8_WAIT_L(0); PG8_MMA(1, 0, At, B0); PG8_BAR; PG8_SCHED;
            PG8_STAGE(PG8_SB(1, 1), b3 + hstep, voffB);
            PG8_WAIT_V(6); PG8_BAR; PG8_MMA(1, 1, At, B1); PG8_BAR;
            }
        }
        if constexpr (ALIGN_EPI) { if (wr == 0) PG8_BAR; }
        if constexpr (F8) asm volatile("s_nop 15\n\ts_nop 15" ::: "memory");
        if constexpr (!Epi::AFTER_DRAIN) { E(acc, cur, wr, wc, fr, fq); S.done(cur); }
        if (!has_next) break;
#pragma unroll
        for (int a = 0; a < 2; ++a)
#pragma unroll
            for (int b = 0; b < 2; ++b)
#pragma unroll
                for (int m = 0; m < 4; ++m)
#pragma unroll
                    for (int n = 0; n < 2; ++n) acc[a][b][m][n] = (f32x4){0.f, 0.f, 0.f, 0.f};
        cur = nxt; cA = nA; cB = nB; ++ui;
        if constexpr (ALIGN_EPI) { if (wr == 1) PG8_BAR; }
    }
    PG8_WAIT_V(0);
    if constexpr (!ALIGN_EPI) { if (wr == 0) PG8_BAR; }
    PG8_BAR;
    if constexpr (Epi::AFTER_DRAIN) { E.fused(acc, cur, wr, wc, fr, fq, lds, wid, lane); S.done(cur); }
#undef PG8_SA
#undef PG8_SB
#undef PG8_STAGE
#undef PG8_LDA
#undef PG8_LD8
#undef PG8_LDB
#undef PG8_MMA
#undef PG8_WAIT_V
#undef PG8_WAIT_L
#undef PG8_BAR
#undef PG8_SCHED
}
}
#define XB_TMO      128
#define XB_XCNT(j)  (256  + 64 * (j))
#define XB_XSUB(j)  (1280 + 64 * (j))
#define XB_XGEN(j)  (2304 + 64 * (j))
#define XB_TOP      3328
#define XB_TOPGEN   3392
#define XCD_BAR_WORDS 3456
#define XB_SPIN_CAP (1u << 18)
#define LAS __attribute__((address_space(3)))

__device__ __forceinline__ unsigned xb_ld(unsigned* p)              { return __hip_atomic_load(p, __ATOMIC_RELAXED, __HIP_MEMORY_SCOPE_AGENT); }
__device__ __forceinline__ unsigned xb_add(unsigned* p, unsigned v) { return __hip_atomic_fetch_add(p, v, __ATOMIC_RELAXED, __HIP_MEMORY_SCOPE_AGENT); }
__device__ __forceinline__ unsigned xb_xcc_id() { return (unsigned)__builtin_amdgcn_s_getreg((3 << 11) | 20) & 0xFu; }
#define XB_SPIN(cond, bar) do { unsigned _sp = 0; while (cond) { __builtin_amdgcn_s_sleep(1); \
    if ((++_sp & 255u) == 0u) { if (xb_ld(&(bar)[XB_TMO])) break; if (_sp > XB_SPIN_CAP) { atomicAdd(&(bar)[XB_TMO], 1u); break; } } } } while (0)

struct XcdBarrier {
    unsigned* bar; unsigned x;
    volatile LAS unsigned* st;
};

__device__ __forceinline__ XcdBarrier xcd_barrier_post(unsigned* bar, volatile LAS unsigned* st) {
    XcdBarrier b; b.bar = bar; b.x = xb_xcc_id(); b.st = st;
    if (threadIdx.x == 0) (void)xb_add(&bar[XB_XCNT(b.x)], 1u);
    return b;
}
__device__ __forceinline__ void xcd_barrier_complete(unsigned* bar, unsigned x, unsigned& nloc, unsigned& nx) {
    const unsigned G = gridDim.x * gridDim.y * gridDim.z;
    unsigned sum, cnt, mine, sp = 0u;
    for (;;) {
        sum = 0u; cnt = 0u; mine = 0u;
#pragma unroll
        for (unsigned j = 0; j < 16; ++j) { const unsigned c = xb_ld(&bar[XB_XCNT(j)]); sum += c; cnt += (c > 0u) ? 1u : 0u; mine = (j == x) ? c : mine; }
        if (sum == G) break;
        __builtin_amdgcn_s_sleep(1);
        if ((++sp & 255u) == 0u) { if (xb_ld(&bar[XB_TMO])) break; if (sp > XB_SPIN_CAP) { atomicAdd(&bar[XB_TMO], 1u); break; } }
    }
    nloc = mine > 0u ? mine : 1u; nx = cnt > 0u ? cnt : 1u;
}

__device__ __forceinline__ void xcd_barrier(const XcdBarrier& b) {
    asm volatile("s_waitcnt vmcnt(0)" ::: "memory");
    __syncthreads();
    if (threadIdx.x == 0) {
        unsigned* bar = b.bar;
        __builtin_amdgcn_s_waitcnt(0);
        unsigned nloc = b.st[0], nx = b.st[1];
        if (nloc == 0u) { xcd_barrier_complete(bar, b.x, nloc, nx); b.st[0] = nloc; b.st[1] = nx; }
        const unsigned old = xb_add(&bar[XB_XSUB(b.x)], 1u);
        const unsigned gen = old / nloc;
        if (old + 1u == (gen + 1u) * nloc) {
            __builtin_amdgcn_fence(__ATOMIC_RELEASE, "agent");
            asm volatile("s_waitcnt vmcnt(0)" ::: "memory");
            const unsigned og = xb_add(&bar[XB_TOP], 1u);
            const unsigned tg = og / nx;
            if (og + 1u == (tg + 1u) * nx) xb_add(&bar[XB_TOPGEN], 1u);
            else XB_SPIN(xb_ld(&bar[XB_TOPGEN]) == tg, bar);
            __builtin_amdgcn_fence(__ATOMIC_ACQUIRE, "agent");
            xb_add(&bar[XB_XGEN(b.x)], 1u);
            asm volatile("s_waitcnt vmcnt(0)" ::: "memory");
        } else {
            XB_SPIN(xb_ld(&bar[XB_XGEN(b.x)]) == gen, bar);
            __builtin_amdgcn_fence(__ATOMIC_ACQUIRE, "agent");
            asm volatile("s_waitcnt vmcnt(0)" ::: "memory");
        }
    }
    __syncthreads();
}

__device__ __forceinline__ void group_barrier(unsigned* bar, unsigned* ctr, unsigned target, unsigned* xmask, volatile LAS unsigned* st) {
    asm volatile("s_waitcnt vmcnt(0)" ::: "memory");
    __syncthreads();
    if (threadIdx.x == 0) {
        __builtin_amdgcn_s_waitcnt(0);
        unsigned mode = st[5];
        if (mode == 0u) { mode = (__popc(xb_ld(xmask)) == 1) ? 1u : 2u; st[5] = mode; }
        if (mode != 1u) { __builtin_amdgcn_fence(__ATOMIC_RELEASE, "agent"); asm volatile("s_waitcnt vmcnt(0)" ::: "memory"); }
        (void)xb_add(ctr, 1u);
        XB_SPIN(xb_ld(ctr) < target, bar);
        __builtin_amdgcn_fence(__ATOMIC_ACQUIRE, "agent");
        asm volatile("s_waitcnt vmcnt(0)" ::: "memory");
    }
    __syncthreads();
}

typedef unsigned short bf16;
typedef unsigned long long u64;
constexpr int NBATCH = 4, SEQ = 4096, DM = 2048, MTOK = NBATCH * SEQ, DEPTH = 4;
constexpr int N_IN = 17944, LDP = 18176;
constexpr int C_AQ = 0, C_AK = 1024, C_AV = 2048, C_AZ = 3072;
constexpr int C_NQ = 4096, C_NKC = 5120, C_NVC = 5376, C_NKS = 5632, C_NVS = 5888, C_NKW = 6144, C_NVW = 6400, C_NZ = 6656;
constexpr int C_SQ = 7680, C_SK = 8704, C_SV = 9728, C_SZ = 10752, C_NG = 11776, C_MG = 12032;
constexpr int N_BF = 12032, N_F8 = 6144;
constexpr float F8_SCALE_H = 32.f, F8_SCALE_W = 2048.f, F8_UNSCALE = 1.0f / (32.f * 2048.f);
constexpr u64 ROPE_BLOCKS = 0xFFFFull | (0x3FFull << 32) | (3ull << 44) | (3ull << 48);

constexpr size_t MiB = 1u << 20;
constexpr size_t WS_CTL = 0;
constexpr size_t CTL_BYTES = 1 * MiB;
constexpr size_t WS_ROPE = 1 * MiB;
constexpr size_t WS_MOD = 2 * MiB;
constexpr size_t WS_LAM = 3 * MiB;
constexpr size_t WS_MODP = 4 * MiB;
constexpr size_t WS_KCMP = 20 * MiB;
constexpr size_t WS_VCMP = 21 * MiB;
constexpr size_t WS_SELM = 22 * MiB;
constexpr size_t WS_W1K = 24 * MiB;
constexpr size_t WS_W1V = 28 * MiB;
constexpr size_t WS_W2K = 32 * MiB;
constexpr size_t WS_W2V = 33 * MiB;
constexpr size_t WS_WOUT = 34 * MiB;
constexpr size_t WS_WBR = 66 * MiB;
constexpr size_t WS_WIN = 114 * MiB;
constexpr size_t WS_H = 398 * MiB;
constexpr size_t WS_PROJ = 462 * MiB;
constexpr size_t WS_DIFFO = 1030 * MiB;
constexpr size_t WS_YS = 1094 * MiB;
constexpr size_t WS_OWIN = 1190 * MiB;
constexpr size_t WS_OCMP = 1222 * MiB;
constexpr size_t WS_WG8 = 1254 * MiB;
constexpr size_t WS_H8 = 1302 * MiB;
constexpr size_t WS_MERGED = 1382 * MiB;
constexpr size_t WS_OUTPRE = 1446 * MiB;
constexpr size_t WS_END = 1510 * MiB;

constexpr int CW_TMO = 0;
constexpr int CW_QUEUE = 8192;
constexpr int CW_GXM = 5632;
constexpr int CW_GRP = 5120;
constexpr int CW_BAR = 1024;

constexpr int LDS_MAIN = 131072;
constexpr int LDS_AUX = 131072;
constexpr int LDS_CTL = 147456;
constexpr int LDS_BYTES = 147712;

#define GAS __attribute__((address_space(1)))
typedef float f32x2 __attribute__((ext_vector_type(2)));
typedef unsigned u32x2 __attribute__((ext_vector_type(2)));
__device__ __forceinline__ float bf2f(unsigned short b) { return __uint_as_float(((unsigned)b) << 16); }
__device__ __forceinline__ unsigned f2bf(float f) { unsigned u = __float_as_uint(f); return (u + 0x7fffu + ((u >> 16) & 1u)) >> 16; }
__device__ __forceinline__ unsigned pk2(float lo, float hi) { unsigned r; asm volatile("v_cvt_pk_bf16_f32 %0, %1, %2" : "=v"(r) : "v"(lo), "v"(hi)); return r; }
__device__ __forceinline__ float clamp8(float x) { return fminf(fmaxf(x, -448.f), 448.f); }
__device__ __forceinline__ unsigned pk4_fp8(float a, float b, float c, float d) {
    int w = __builtin_amdgcn_cvt_pk_fp8_f32(clamp8(a), clamp8(b), 0, false); w = __builtin_amdgcn_cvt_pk_fp8_f32(clamp8(c), clamp8(d), w, true); return (unsigned)w; }
__device__ __forceinline__ float lo_bf(unsigned w) { return __uint_as_float(w << 16); }
__device__ __forceinline__ float hi_bf(unsigned w) { return __uint_as_float(w & 0xffff0000u); }
__device__ __forceinline__ float sigmoidf_(float x) { return __builtin_amdgcn_rcpf(1.0f + __builtin_amdgcn_exp2f(-1.4426950408889634f * x)); }
__device__ __forceinline__ float siluf_(float x) { return x * sigmoidf_(x); }
__device__ __forceinline__ float other_half(float x) {
    auto rr = __builtin_amdgcn_permlane32_swap(__float_as_uint(x), __float_as_uint(x), false, false);
    return __uint_as_float((__lane_id() & 32) ? rr[0] : rr[1]);
}

__device__ __forceinline__ int opaque_tid() { const int w = __builtin_amdgcn_readfirstlane((int)threadIdx.x >> 6);
    int t = w * 64 + (int)__builtin_amdgcn_mbcnt_hi(~0u, __builtin_amdgcn_mbcnt_lo(~0u, 0u)); asm volatile("" : "+v"(t)); return t; }
struct Params {
    const float* x; const float* c; const float* norm_pre_g; const float* norm_post_g; const float* w_ada; const float* b_ada; const float* w_in;
    const float* lq1; const float* lk1; const float* lq2; const float* lk2; const float* diff_norm_g;
    const float* pe_k; const float* w1_k; const float* w2_k; const float* pe_v; const float* w1_v; const float* w2_v; const float* w_branch; const float* w_out;
    float* out; unsigned char* ws;
};

namespace pg8 {
struct EpiProj {
    static constexpr bool PERM = true, AFTER_DRAIN = false;
    bf16_t* __restrict__ O; const float* __restrict__ rope;
    __device__ __forceinline__ void operator()(const f32x4 (&acc)[2][2][4][2], const Unit& u, int wr, int wc, int fr, int fq) const {
        run(acc, u, wr, wc, fr, fq); if constexpr (((PROBE_DUP_MASK) >> 15) & 1) { asm volatile("" ::: "memory"); run(acc, u, wr, wc, fr, fq); } }
    __device__ __forceinline__ void run(const f32x4 (&acc)[2][2][4][2], const Unit& u, int wr, int wc, int fr, int fq) const {
        const int row0 = u.pm * BM + wr * 64 + fr, col0 = u.pn * BM + wc * 32 + 8 * fq;
        const bool rot = wc == 0 && u.pn < 32 && ((ROPE_BLOCKS >> (2 * u.pn)) & 1ull);
        const float sg = (fq < 2) ? -1.f : 1.f;
#pragma unroll
        for (int ai = 0; ai < 2; ++ai) {
            f32x4 c0[4], c1[4], s0[4], s1[4];
            if (rot) {
#pragma unroll
                for (int m = 0; m < 4; ++m) { const float* cs = rope + (size_t)((row0 + ai * HALF + m * 16) & (SEQ - 1)) * 32 + 8 * (fq & 1);
                    c0[m] = *(const f32x4*)cs; c1[m] = *(const f32x4*)(cs + 4); s0[m] = *(const f32x4*)(cs + 16); s1[m] = *(const f32x4*)(cs + 20); }
                asm volatile("" ::: "memory");
            }
#pragma unroll
            for (int m = 0; m < 4; ++m) {
                const int row = row0 + ai * HALF + m * 16;
                bf16_t* rowp = O + (size_t)row * LDP + col0;
#pragma unroll
                for (int bj = 0; bj < 2; ++bj) {
                    f32x4 v0 = acc[ai][bj][m][0], v1 = acc[ai][bj][m][1];
                    if (rot) {
                        f32x4 o0, o1;
#pragma unroll
                        for (int j = 0; j < 4; ++j) { o0[j] = other_half(v0[j]); o1[j] = other_half(v1[j]); }
                        v0 = v0 * c0[m] + sg * (o0 * s0[m]); v1 = v1 * c1[m] + sg * (o1 * s1[m]);
                    }
                    u32x4 w; w.x = cvt_pk_bf16(v0[0], v0[1]); w.y = cvt_pk_bf16(v0[2], v0[3]); w.z = cvt_pk_bf16(v1[0], v1[1]); w.w = cvt_pk_bf16(v1[2], v1[3]);
                    *(u32x4*)(rowp + bj * HALF) = w;
                }
            }
        }
    }
};
struct EpiPlain {
    static constexpr bool PERM = true, AFTER_DRAIN = false;
    bf16_t* O; int ldc;
    __device__ __forceinline__ void operator()(const f32x4 (&acc)[2][2][4][2], const Unit& u, int wr, int wc, int fr, int fq) const {
        const int row0 = u.pm * BM + wr * 64 + fr, col0 = u.pn * BM + wc * 32 + 8 * fq;
#pragma unroll
        for (int ai = 0; ai < 2; ++ai)
#pragma unroll
            for (int m = 0; m < 4; ++m) {
                bf16_t* rowp = O + (size_t)(row0 + ai * HALF + m * 16) * ldc + col0;
#pragma unroll
                for (int bj = 0; bj < 2; ++bj) {
                    const f32x4 v0 = acc[ai][bj][m][0], v1 = acc[ai][bj][m][1];
                    u32x4 w; w.x = cvt_pk_bf16(v0[0], v0[1]); w.y = cvt_pk_bf16(v0[2], v0[3]); w.z = cvt_pk_bf16(v1[0], v1[1]); w.w = cvt_pk_bf16(v1[2], v1[3]);
                    *(u32x4*)(rowp + bj * HALF) = w;
                }
            }
    }
};
struct EpiGate8 {
    static constexpr bool PERM = true, AFTER_DRAIN = false;
    bf16_t* O;
    __device__ __forceinline__ void operator()(const f32x4 (&acc)[2][2][4][2], const Unit& u, int wr, int wc, int fr, int fq) const {
        const int row0 = u.pm * BM + wr * 64 + fr, col0 = C_MG + u.pn * BM + wc * 32 + 8 * fq;
#pragma unroll
        for (int ai = 0; ai < 2; ++ai)
#pragma unroll
            for (int m = 0; m < 4; ++m) {
                bf16_t* rowp = O + (size_t)(row0 + ai * HALF + m * 16) * LDP + col0;
#pragma unroll
                for (int bj = 0; bj < 2; ++bj) {
                    const f32x4 v0 = acc[ai][bj][m][0] * F8_UNSCALE, v1 = acc[ai][bj][m][1] * F8_UNSCALE;
                    u32x4 w; w.x = cvt_pk_bf16(v0[0], v0[1]); w.y = cvt_pk_bf16(v0[2], v0[3]); w.z = cvt_pk_bf16(v1[0], v1[1]); w.w = cvt_pk_bf16(v1[2], v1[3]);
                    *(u32x4*)(rowp + bj * HALF) = w;
                }
            }
    }
};
struct EpiBranch {
    static constexpr bool PERM = true, AFTER_DRAIN = false;
    const bf16_t* __restrict__ proj; bf16_t* merged;
    __device__ __forceinline__ void operator()(const f32x4 (&acc)[2][2][4][2], const Unit& u, int wr, int wc, int fr, int fq) const {
        const int n = u.pm >> 6, pm = u.pm & 63, pn = u.pn & 7;
        const int row0 = pm * BM + wr * 64 + fr, col0 = pn * BM + wc * 32 + 8 * fq;
        const unsigned goff = (unsigned)(row0 * LDP + C_MG + n * DM + col0) * 2u, toff = (unsigned)(row0 * DM + col0) * 2u;
#pragma unroll
        for (int ai = 0; ai < 2; ++ai) {
            u32x4 g[4][2], t[4][2];
#pragma unroll
            for (int m = 0; m < 4; ++m)
#pragma unroll
                for (int bj = 0; bj < 2; ++bj) { const int dr = ai * HALF + m * 16;
                    g[m][bj] = *(const u32x4*)((const char*)proj + goff + (unsigned)(dr * LDP + bj * HALF) * 2u);
                    if (n > 0) t[m][bj] = *(const u32x4*)((const char*)merged + toff + (unsigned)(dr * DM + bj * HALF) * 2u); }
            asm volatile("" ::: "memory");
#pragma unroll
            for (int m = 0; m < 4; ++m)
#pragma unroll
                for (int bj = 0; bj < 2; ++bj) { const int dr = ai * HALF + m * 16;
                    const u32x4 gg = g[m][bj];
                    f32x4 v0 = acc[ai][bj][m][0], v1 = acc[ai][bj][m][1];
                    v0[0] *= sigmoidf_(lo_bf(gg.x)); v0[1] *= sigmoidf_(hi_bf(gg.x)); v0[2] *= sigmoidf_(lo_bf(gg.y)); v0[3] *= sigmoidf_(hi_bf(gg.y));
                    v1[0] *= sigmoidf_(lo_bf(gg.z)); v1[1] *= sigmoidf_(hi_bf(gg.z)); v1[2] *= sigmoidf_(lo_bf(gg.w)); v1[3] *= sigmoidf_(hi_bf(gg.w));
                    if (n > 0) { const u32x4 tt = t[m][bj];
                        v0[0] += lo_bf(tt.x); v0[1] += hi_bf(tt.x); v0[2] += lo_bf(tt.y); v0[3] += hi_bf(tt.y); v1[0] += lo_bf(tt.z); v1[1] += hi_bf(tt.z); v1[2] += lo_bf(tt.w); v1[3] += hi_bf(tt.w); }
                    u32x4 w; w.x = cvt_pk_bf16(v0[0], v0[1]); w.y = cvt_pk_bf16(v0[2], v0[3]); w.z = cvt_pk_bf16(v1[0], v1[1]); w.w = cvt_pk_bf16(v1[2], v1[3]);
                    *(u32x4*)((char*)merged + toff + (unsigned)(dr * DM + bj * HALF) * 2u) = w;
                }
        }
    }
};
struct BranchOrder {
    int G, c;
    __device__ bool next(int i, Unit& u) const {
        const int ts = i / 3, n = i - ts * 3; const long L = (long)ts * G + c; constexpr int nM = 64, nN = 8, nwg = nM * nN;
        if (L >= nwg) return false;
        int wgid = (int)L; { const int q = nwg / NXCD, xcd = wgid % NXCD, off = wgid / NXCD; wgid = xcd * q + off; }
        const int nig = WGM * nN, gid = wgid / nig, fm = gid * WGM;
        u.pm = n * 64 + fm + ((wgid % nig) % WGM); u.pn = n * 8 + (wgid % nig) / WGM; return true;
    }
    __device__ __forceinline__ void a_ready(const Unit&) const {}
    __device__ __forceinline__ void done(const Unit&) const {}
};
}

typedef short bf16x8 __attribute__((ext_vector_type(8)));
typedef short s16x4 __attribute__((ext_vector_type(4)));
typedef float f32x16 __attribute__((ext_vector_type(16)));
typedef float f32x4 __attribute__((ext_vector_type(4)));
typedef unsigned u32x4 __attribute__((ext_vector_type(4)));
template <class A, class Bt> struct same_t { static constexpr bool v = false; };
template <class A> struct same_t<A, A> { static constexpr bool v = true; };
constexpr int D = 128;
constexpr float SCALE = 0.08838834764831845f;
constexpr float THR = 8.f;
constexpr int NW = 8, QBLK = 32, KVBLK = 64, QB = NW * QBLK;
constexpr int SHM_V = KVBLK * D * 2, SHM_K = KVBLK * D * 2;
#define KSWZ(row, colB) ((row) * 256 + ((colB) ^ (((row) & 7) << 4)))
#define SBAR() __builtin_amdgcn_sched_barrier(0)
__device__ __forceinline__ int v_st(int k, int c) { const int kk = (k & ~0xC) | ((k & 4) << 1) | ((k & 8) >> 1); return ((kk >> 3) * 4 + (c >> 5)) * 512 + ((kk & 7) * 32 + (c & 31)) * 2; }
__device__ __forceinline__ int v_rd_base(int lane) { return ((lane & 3) << 3) | (((lane >> 2) & 3) << 6) | (((lane >> 4) & 1) << 5) | (((lane >> 5) & 1) << 8); }
constexpr int v_rd_off(int d0, int ks, int half) { return d0 * 512 + ks * 4096 + half * 2048; }
__device__ __forceinline__ int crow(int r, int hi) { return (r & 3) + 8 * (r >> 2) + 4 * hi; }
__device__ __forceinline__ unsigned cvtpk(float lo, float hi) {
    unsigned r; asm volatile("v_cvt_pk_bf16_f32 %0, %1, %2" : "=v"(r) : "v"(lo), "v"(hi)); return r;
}
__device__ __forceinline__ bf16x8 pack8(f32x4 a, f32x4 b) {
    u32x4 w = {cvtpk(a[0], a[1]), cvtpk(a[2], a[3]), cvtpk(b[0], b[1]), cvtpk(b[2], b[3])};
    return *reinterpret_cast<bf16x8*>(&w);
}
template <class T> __device__ __forceinline__ bf16x8 load8(const T* p) {
    if constexpr (same_t<T, float>::v) { return pack8(*(const f32x4*)p, *(const f32x4*)(p + 4)); }
    else { return *reinterpret_cast<const bf16x8*>(p); }
}
__device__ __forceinline__ void mask_tile(f32x16& p0, f32x16& p1, int dq, unsigned W) {
    const float NEG = -__builtin_inff();
#pragma unroll
    for (int r = 0; r < 16; ++r) {
        const int c = (r & 3) + 8 * (r >> 2);
        if ((unsigned)(dq - c) >= W) p0[r] = NEG;
        if ((unsigned)(dq - c - 32) >= W) p1[r] = NEG;
    }
}
__device__ __forceinline__ void partialSM(f32x16& p0, f32x16& p1, float& m_reg, float& mn, float& alpha) {
    float pmax = p0[0]; for (int r = 1; r < 16; ++r) pmax = fmaxf(pmax, p0[r]); for (int r = 0; r < 16; ++r) pmax = fmaxf(pmax, p1[r]);
    { auto rr = __builtin_amdgcn_permlane32_swap(__float_as_uint(pmax), __float_as_uint(pmax), false, false);
      pmax = fmaxf(__uint_as_float(rr[0]), __uint_as_float(rr[1])); }
    constexpr float C2 = 1.4426950408889634f * SCALE;
    if (__builtin_expect(__all((pmax - m_reg) * SCALE <= THR), 1)) { mn = m_reg; alpha = 1.f; }
    else { mn = fmaxf(m_reg, pmax); alpha = __builtin_amdgcn_exp2f((m_reg - mn) * C2); m_reg = mn; }
    const float mnL = -mn * C2;
    for (int r = 0; r < 16; ++r) p0[r] = fmaf(p0[r], C2, mnL); for (int r = 0; r < 16; ++r) p1[r] = fmaf(p1[r], C2, mnL);
    for (int r = 0; r < 16; ++r) p0[r] = __builtin_amdgcn_exp2f(p0[r]);
}
__device__ __forceinline__ void finishSM(f32x16& p0, f32x16& p1, float alpha, float& l_reg, bf16x8& pa0, bf16x8& pa1, bf16x8& pa2, bf16x8& pa3) {
    for (int r = 0; r < 16; ++r) p1[r] = __builtin_amdgcn_exp2f(p1[r]);
    float ps = 0; for (int r = 0; r < 16; ++r) ps += p0[r]; for (int r = 0; r < 16; ++r) ps += p1[r];
    { auto rr = __builtin_amdgcn_permlane32_swap(__float_as_uint(ps), __float_as_uint(ps), false, false);
      ps = __uint_as_float(rr[0]) + __uint_as_float(rr[1]); }
    l_reg = l_reg * alpha + ps;
#define PK4(P, B_, OUT) do { unsigned a0 = cvtpk(P[B_+0], P[B_+1]), a1 = cvtpk(P[B_+2], P[B_+3]);                          \
        unsigned b0 = cvtpk(P[B_+4], P[B_+5]), b1 = cvtpk(P[B_+6], P[B_+7]);                                             \
        auto r0 = __builtin_amdgcn_permlane32_swap(a0, b0, false, false); auto r1 = __builtin_amdgcn_permlane32_swap(a1, b1, false, false); \
        u32x4 w = {r0[0], r1[0], r0[1], r1[1]}; OUT = *reinterpret_cast<bf16x8*>(&w); } while (0)
    PK4(p0, 0, pa0); PK4(p0, 8, pa1); PK4(p1, 0, pa2); PK4(p1, 8, pa3);
#undef PK4
}
template <int KB, bool SK>
__device__ __forceinline__ void qkt(f32x16& p0, f32x16& p1, const char* K_lds, int r32, int hi, const bf16x8* qr, bool act) {
    if (SK && !act) { const float NEG = -__builtin_inff();
#pragma unroll
        for (int r = 0; r < 16; ++r) { p0[r] = NEG; p1[r] = NEG; } return; }
    p0 = f32x16{}; p1 = f32x16{};
    const char* kb[4];
#pragma unroll
    for (int dd = 0; dd < 4; ++dd) kb[dd] = K_lds + KB * SHM_K + KSWZ(r32, (dd * 16 + hi * 8) * 2);
#pragma unroll
    for (int d0 = 0; d0 < 8; ++d0) { const char* a = kb[d0 & 3] + (d0 >> 2) * 128;
        bf16x8 b0 = *reinterpret_cast<const bf16x8*>(a);
        bf16x8 b1 = *reinterpret_cast<const bf16x8*>(a + 32 * 256);
        p0 = __builtin_amdgcn_mfma_f32_32x32x16_bf16(b0, qr[d0], p0, 0, 0, 0);
        p1 = __builtin_amdgcn_mfma_f32_32x32x16_bf16(b1, qr[d0], p1, 0, 0, 0); }
}
template <int VB, bool SK>
__device__ __forceinline__ void pv_tile(f32x16* o, int vb0, bf16x8 pa0, bf16x8 pa1, bf16x8 pa2, bf16x8 pa3, bool act) {
    if (SK && !act) return;
#define TRRD(dst, off) asm volatile("ds_read_b64_tr_b16 %0, %1 offset:%2" : "=&v"(dst) : "v"(vb0), "i"(off) : "memory")
#define PV_D0(d0) do { s16x4 l0, l1, l2, l3, h0, h1, h2, h3; constexpr int b_ = VB * SHM_V + v_rd_off(d0, 0, 0);     \
        TRRD(l0, b_); TRRD(h0, b_ + 2048); TRRD(l1, b_ + 4096); TRRD(h1, b_ + 6144); TRRD(l2, b_ + 8192); TRRD(h2, b_ + 10240); TRRD(l3, b_ + 12288); TRRD(h3, b_ + 14336); \
        asm volatile("s_waitcnt lgkmcnt(0)" ::: "memory"); SBAR();                 \
        o[d0] = __builtin_amdgcn_mfma_f32_32x32x16_bf16(pa0, (bf16x8){l0[0], l0[1], l0[2], l0[3], h0[0], h0[1], h0[2], h0[3]}, o[d0], 0, 0, 0);   \
        o[d0] = __builtin_amdgcn_mfma_f32_32x32x16_bf16(pa1, (bf16x8){l1[0], l1[1], l1[2], l1[3], h1[0], h1[1], h1[2], h1[3]}, o[d0], 0, 0, 0);   \
        o[d0] = __builtin_amdgcn_mfma_f32_32x32x16_bf16(pa2, (bf16x8){l2[0], l2[1], l2[2], l2[3], h2[0], h2[1], h2[2], h2[3]}, o[d0], 0, 0, 0);   \
        o[d0] = __builtin_amdgcn_mfma_f32_32x32x16_bf16(pa3, (bf16x8){l3[0], l3[1], l3[2], l3[3], h3[0], h3[1], h3[2], h3[3]}, o[d0], 0, 0, 0); } while (0)
    PV_D0(0); PV_D0(1); PV_D0(2); PV_D0(3);
#undef PV_D0
#undef TRRD
}

__device__ __forceinline__ bf16x8 ld8(const bf16* p) { return *reinterpret_cast<const bf16x8*>(p); }
__device__ __forceinline__ bf16x8 bload8(const void* base, unsigned voff, unsigned soff) {
    const __amdgpu_buffer_rsrc_t r = __builtin_amdgcn_make_buffer_rsrc((void*)base, 0, 0x7fffffff, 0x00020000);
    u32x4 v = __builtin_amdgcn_raw_buffer_load_b128(r, (int)voff, (int)soff, 0);
    return *reinterpret_cast<bf16x8*>(&v);
}

struct BlockRef { const bf16* Q; const bf16* K; const bf16* V; const u64* M; int P0; int row0; int aux; int aux2; };
struct Seam { bf16x8 qr[8]; bf16x8 st_v0, st_v1, st_k0, st_k1; };
__device__ __forceinline__ int swa_jlo(int P0, int W) { const int lowk = P0 - W + 1; return lowk > 0 ? lowk / KVBLK : 0; }
#define TILEP(p, k0) ((const char*)(p) + (size_t)(k0) * (LDP * 2))
#define VMW() asm volatile("s_waitcnt vmcnt(0)" ::: "memory")
#define VMWN(n) asm volatile("s_waitcnt vmcnt(%0)" :: "i"(n) : "memory")
#define SLOAD_H(Kp, Vp, k0) do { const unsigned so_ = (unsigned)(k0) * (LDP * 2u);                                   \
                         S.st_v0 = bload8(Vp, roff0, so_); S.st_v1 = bload8(Vp, roff0, so_ + 32u * LDP * 2u);              \
                         S.st_k0 = bload8(Kp, roff0, so_); S.st_k1 = bload8(Kp, roff0, so_ + 32u * LDP * 2u); } while (0)
#define SWRITE_HK(bf) do { *(bf16x8*)(K_lds + (bf) * SHM_K + kws) = S.st_k0; *(bf16x8*)(K_lds + (bf) * SHM_K + kws + 32 * 256) = S.st_k1; } while (0)
#define SWRITE_HV(bf) do { *(bf16x8*)(V_lds + (bf) * SHM_V + vst0) = S.st_v0; *(bf16x8*)(V_lds + (bf) * SHM_V + vst1) = S.st_v1; } while (0)
#define SWRITE_H(bf) do { SWRITE_HV(bf); SWRITE_HK(bf); } while (0)
__device__ __forceinline__ void attn_prime(const BlockRef& cur, int W, char* lds, Seam& S) {
    const int tid = opaque_tid(), wid = __builtin_amdgcn_readfirstlane(tid >> 6), lane = tid & 63, r32 = lane & 31, hi = lane >> 5;
    const int sr = tid >> 4, sc = (tid & 15) * 8, kws = KSWZ(sr, sc * 2); char* K_lds = lds + 2 * SHM_V;
    const unsigned roff0 = (unsigned)(sr * LDP + sc) * 2u, qoff = (unsigned)(r32 * LDP + hi * 8) * 2u;
    const int kb0 = swa_jlo(cur.P0, W) * KVBLK;
    { const unsigned qs_ = (unsigned)(wid * QBLK) * (LDP * 2u);
#pragma unroll
    for (int d0 = 0; d0 < 8; ++d0) S.qr[d0] = bload8(cur.Q, qoff + d0 * 32, qs_); }
    SLOAD_H(cur.K, cur.V, kb0); VMW(); SWRITE_HK(0);
    __syncthreads();
}

__device__ __forceinline__ void partialSM_sel(f32x16& p0, f32x16& p1, float& m_reg, float& mn, float& alpha, bool sel) {
    const float NEG = -__builtin_inff();
    float pmax = p0[0]; for (int r = 1; r < 16; ++r) pmax = fmaxf(pmax, p0[r]); for (int r = 0; r < 16; ++r) pmax = fmaxf(pmax, p1[r]);
    { auto rr = __builtin_amdgcn_permlane32_swap(__float_as_uint(pmax), __float_as_uint(pmax), false, false);
      pmax = fmaxf(__uint_as_float(rr[0]), __uint_as_float(rr[1])); }
    pmax = sel ? pmax : NEG;
    constexpr float C2 = 1.4426950408889634f * SCALE;
    if (__builtin_expect(__all((pmax - m_reg) * SCALE <= THR), 1)) { mn = m_reg; alpha = 1.f; }
    else { mn = fmaxf(m_reg, pmax); alpha = __builtin_amdgcn_exp2f((m_reg - mn) * C2); m_reg = mn; }
    const float mnL = sel ? -mn * C2 : NEG;
    for (int r = 0; r < 16; ++r) p0[r] = fmaf(p0[r], C2, mnL); for (int r = 0; r < 16; ++r) p1[r] = fmaf(p1[r], C2, mnL);
    for (int r = 0; r < 16; ++r) p0[r] = __builtin_amdgcn_exp2f(p0[r]);
}
template <bool SK, bool SLC, class Epi>
__device__ __forceinline__ void attn_block(const BlockRef& cur, const BlockRef& nxt, int skv, int W, char* lds, Seam& S, const Epi& E) {
    const int tid = opaque_tid(), wid = __builtin_amdgcn_readfirstlane(tid >> 6), lane = tid & 63, r32 = lane & 31, hi = lane >> 5;
    const int j_lo = swa_jlo(cur.P0, W);
    int j_hi = (cur.P0 + QB - 1) / KVBLK + 1; if (j_hi > skv / KVBLK) j_hi = skv / KVBLK;
    const int NT = j_hi - j_lo;
    const int kbn = swa_jlo(nxt.P0, W) * KVBLK;
    const int qlo = cur.P0 + wid * QBLK, qm = qlo + r32 - 4 * hi;
    char* V_lds = lds; char* K_lds = lds + 2 * SHM_V;
    float* ws = (float*)(lds + 2 * SHM_V + 2 * SHM_K) + wid * 64; float* li_l = ws, * al_l = ws + 32;
    float m_reg = -1e30f, l_reg = 0; f32x16 o[4] = {};
    const int sr = tid >> 4, sc = (tid & 15) * 8, vst0 = v_st(sr, sc), vst1 = vst0 + 8192, kws = KSWZ(sr, sc * 2);
    const unsigned roff0 = (unsigned)(sr * LDP + sc) * 2u, qoff = (unsigned)(r32 * LDP + hi * 8) * 2u;
    const int vb0 = (int)(uintptr_t)V_lds + v_rd_base(lane);
    const bf16* Kh = cur.K; const bf16* Vh = cur.V;
    u64 rowmask = ~0ull; if constexpr (SLC) rowmask = cur.M[cur.P0 + wid * QBLK + r32];
#define RESC(a) do { if (__any((a) < 1.f)) { if (hi == 0) al_l[r32] = (a); asm volatile("s_waitcnt lgkmcnt(0)" ::: "memory");              \
                     for (int d_ = 0; d_ < 4; ++d_) for (int r = 0; r < 16; ++r) o[d_][r] *= al_l[crow(r, hi)]; } } while (0)
#define KBASE(t) ((j_lo + (t)) * KVBLK)
#define ACT(t) (KBASE(t) <= qlo + QBLK - 1 && KBASE(t) + KVBLK - 1 >= qlo - W + 1)
#define MASKT(P0_, P1_, t) do { const int kb_ = KBASE(t); if ((!SK || ACT(t)) && (kb_ + KVBLK - 1 > qlo || kb_ <= qlo + QBLK - 1 - W)) mask_tile(P0_, P1_, qm - kb_, (unsigned)W); } while (0)
#define PSM(P0_, P1_, mn_, al_, t) do { if constexpr (SLC) partialSM_sel(P0_, P1_, m_reg, mn_, al_, ((rowmask >> (j_lo + (t))) & 1ull) != 0ull); else partialSM(P0_, P1_, m_reg, mn_, al_); } while (0)
    constexpr int NQL = 8;
#define SEAM_K0() do { VMWN(NQL); SWRITE_HK(0); SBAR(); } while (0)
    f32x16 pA0, pA1, pB0, pB1; float mnA, mnB, alA, alB; bf16x8 pa0, pa1, pa2, pa3;
    SWRITE_HV(0); SBAR();
    if (NT > 1) { SLOAD_H(Kh, Vh, KBASE(1)); }
    SBAR(); qkt<0, SK>(pA0, pA1, K_lds, r32, hi, S.qr, ACT(0));
    MASKT(pA0, pA1, 0); PSM(pA0, pA1, mnA, alA, 0);
    if (NT > 1) { VMW(); SWRITE_H(1); }
    __syncthreads();
#define HALF_STEP(PX0, PX1, mnX, alX, PY0, PY1, alY, t, KB, VB, SB) do {                                                      \
        SBAR(); qkt<KB, SK>(PX0, PX1, K_lds, r32, hi, S.qr, ACT(t));                                             \
        finishSM(PY0, PY1, alY, l_reg, pa0, pa1, pa2, pa3); SBAR();                                                           \
        if ((t) + 1 < NT) { SLOAD_H(Kh, Vh, KBASE((t) + 1)); SBAR(); }                                               \
        pv_tile<VB, SK>(o, vb0, pa0, pa1, pa2, pa3, ACT((t) - 1)); MASKT(PX0, PX1, (t)); PSM(PX0, PX1, mnX, alX, (t));                                        \
        __syncthreads();                                                                                                      \
        if ((t) + 1 < NT) { VMW(); SWRITE_H(SB); }                                                                          \
        RESC(alX); __syncthreads(); } while (0)
    for (int t = 1; t + 1 < NT; t += 2) {
        HALF_STEP(pB0, pB1, mnB, alB, pA0, pA1, alA, t, 1, 0, 0);
        HALF_STEP(pA0, pA1, mnA, alA, pB0, pB1, alB, t + 1, 0, 1, 1);
    }
    const bool even = (NT & 1) == 0;
    if (even) { SBAR(); qkt<1, SK>(pB0, pB1, K_lds, r32, hi, S.qr, ACT(NT - 1)); SBAR(); }
    SLOAD_H(nxt.K, nxt.V, kbn); SBAR();
    { const unsigned qs_ = (unsigned)(wid * QBLK) * (LDP * 2u);
#pragma unroll
    for (int d0 = 0; d0 < 8; ++d0) S.qr[d0] = bload8(nxt.Q, qoff + d0 * 32, qs_); }
    SBAR();
    finishSM(pA0, pA1, alA, l_reg, pa0, pa1, pa2, pa3); SBAR();
    pv_tile<0, SK>(o, vb0, pa0, pa1, pa2, pa3, ACT(even ? NT - 2 : NT - 1));
    if (even) { MASKT(pB0, pB1, NT - 1); PSM(pB0, pB1, mnB, alB, NT - 1); __syncthreads(); RESC(alB);
        finishSM(pB0, pB1, alB, l_reg, pa0, pa1, pa2, pa3); SBAR(); pv_tile<1, SK>(o, vb0, pa0, pa1, pa2, pa3, ACT(NT - 1)); }
    SBAR(); SEAM_K0();
    if (hi == 0) li_l[r32] = l_reg; asm volatile("s_waitcnt lgkmcnt(0)" ::: "memory");
    float rli[16];
#pragma unroll
    for (int r = 0; r < 16; ++r) rli[r] = __builtin_amdgcn_rcpf(li_l[crow(r, hi)]);
    E(o, rli, cur, wid, r32, hi);
    __syncthreads();
#undef RESC
#undef KBASE
#undef ACT
#undef MASKT
#undef PSM
#undef SEAM_K0
#undef HALF_STEP
}


constexpr int OST_PITCH = 272, OST_WAVE = 32 * OST_PITCH, OST_BASE = 73728;
__device__ __forceinline__ void ost_put(char* scr, const f32x16* o, const float (&sc)[16], int r32, int hi) {
#pragma unroll
    for (int r = 0; r < 16; r += 2) {
        char* rp = scr + crow(r, hi) * OST_PITCH + r32 * 2;
#pragma unroll
        for (int d0 = 0; d0 < 4; ++d0) { const unsigned w = cvtpk(o[d0][r] * sc[r], o[d0][r + 1] * sc[r + 1]);
            *(unsigned short*)(rp + d0 * 64) = (unsigned short)w; *(unsigned short*)(rp + OST_PITCH + d0 * 64) = (unsigned short)(w >> 16); }
    }
}
__device__ __forceinline__ u32x4 ost_get(const char* scr, int q, int lane) { return *(const u32x4*)(scr + (q * 4 + (lane >> 4)) * OST_PITCH + (lane & 15) * 16); }

struct EpiAttnStore {
    bf16* O; int ldo; char* lds;
    __device__ __forceinline__ void operator()(const f32x16 (&o)[4], const float (&rli)[16], const BlockRef& cur, int wid, int r32, int hi) const {
        int lane = hi * 32 + r32; asm volatile("" : "+v"(lane));
        char* scr = lds + OST_BASE + wid * OST_WAVE;
        ost_put(scr, o, rli, r32, hi);
        char* Ow = (char*)(O + (size_t)(cur.row0 + wid * QBLK) * ldo + cur.aux);
        const unsigned loff = (unsigned)((lane >> 4) * ldo + (lane & 15) * 8) * 2u;
#pragma unroll
        for (int q = 0; q < 8; ++q) *(u32x4*)(Ow + (size_t)(q * 4 * ldo) * 2 + loff) = ost_get(scr, q, lane);
    }
};
struct EpiNsaCombine {
    const bf16* __restrict__ proj; const bf16* __restrict__ ocmp; const bf16* __restrict__ owin; bf16* __restrict__ ys; char* lds;
    __device__ __forceinline__ void operator()(const f32x16 (&o)[4], const float (&rli)[16], const BlockRef& cur, int wid, int r32, int hi) const {
        int lane = hi * 32 + r32; asm volatile("" : "+v"(lane));
        char* scr = lds + OST_BASE + wid * OST_WAVE;
        ost_put(scr, o, rli, r32, hi);
        const int rowb = cur.row0 + wid * QBLK + (lane >> 4), colb = cur.aux + (lane & 15) * 8;
#pragma unroll
        for (int qh = 0; qh < 2; ++qh) {
            u32x4 oc[4], ow[4], zz[4]; unsigned short gq[4][3];
#pragma unroll
            for (int qi = 0; qi < 4; ++qi) { const size_t row = (size_t)(rowb + (qh * 4 + qi) * 4);
                oc[qi] = *(const u32x4*)(ocmp + row * 1024 + colb); ow[qi] = *(const u32x4*)(owin + row * 1024 + colb); zz[qi] = *(const u32x4*)(proj + row * LDP + C_NZ + colb);
                const bf16* gp = proj + row * LDP + C_NG + cur.aux2 * 3; gq[qi][0] = gp[0]; gq[qi][1] = gp[1]; gq[qi][2] = gp[2]; }
            asm volatile("" ::: "memory");
#pragma unroll
            for (int qi = 0; qi < 4; ++qi) { const size_t row = (size_t)(rowb + (qh * 4 + qi) * 4);
                const u32x4 os = ost_get(scr, qh * 4 + qi, lane);
                const float g0 = sigmoidf_(bf2f(gq[qi][0])), g1 = sigmoidf_(bf2f(gq[qi][1])), g2 = sigmoidf_(bf2f(gq[qi][2]));
                const unsigned ocw[4] = {oc[qi].x, oc[qi].y, oc[qi].z, oc[qi].w}, oww[4] = {ow[qi].x, ow[qi].y, ow[qi].z, ow[qi].w}, zw[4] = {zz[qi].x, zz[qi].y, zz[qi].z, zz[qi].w}, osw[4] = {os.x, os.y, os.z, os.w};
                unsigned res[4];
#pragma unroll
                for (int j = 0; j < 4; ++j) {
                    const float a = (g0 * lo_bf(ocw[j]) + g1 * lo_bf(osw[j]) + g2 * lo_bf(oww[j])) * siluf_(lo_bf(zw[j]));
                    const float b2 = (g0 * hi_bf(ocw[j]) + g1 * hi_bf(osw[j]) + g2 * hi_bf(oww[j])) * siluf_(hi_bf(zw[j]));
                    res[j] = cvtpk(a, b2); }
                *(u32x4*)(ys + row * 1024 + colb) = (u32x4){res[0], res[1], res[2], res[3]}; }
        }
    }
};

struct EpiNsaCombineT {
    const bf16* __restrict__ proj; const bf16* __restrict__ ocmp; const bf16* __restrict__ owin; bf16* __restrict__ ys; char* lds;
    __device__ __forceinline__ void operator()(const f32x16 (&o)[4], const float (&rli)[16], const BlockRef& cur, int wid, int r32, int hi) const {
        int lane = hi * 32 + r32; asm volatile("" : "+v"(lane));
        char* scr = lds + OST_BASE + wid * OST_WAVE;
        ost_put(scr, o, rli, r32, hi);
        const int head = cur.aux2 + (lane >> 4), rowb = cur.row0 + wid * 8, colb = head * 128 + (lane & 15) * 8;
#pragma unroll
        for (int qh = 0; qh < 2; ++qh) {
            u32x4 oc[4], ow[4], zz[4]; unsigned short gq[4][3];
#pragma unroll
            for (int qi = 0; qi < 4; ++qi) { const size_t row = (size_t)(rowb + qh * 4 + qi);
                oc[qi] = *(const u32x4*)(ocmp + row * 1024 + colb); ow[qi] = *(const u32x4*)(owin + row * 1024 + colb); zz[qi] = *(const u32x4*)(proj + row * LDP + C_NZ + colb);
                const bf16* gp = proj + row * LDP + C_NG + head * 3; gq[qi][0] = gp[0]; gq[qi][1] = gp[1]; gq[qi][2] = gp[2]; }
            asm volatile("" ::: "memory");
#pragma unroll
            for (int qi = 0; qi < 4; ++qi) { const size_t row = (size_t)(rowb + qh * 4 + qi);
                const u32x4 os = ost_get(scr, qh * 4 + qi, lane);
                const float g0 = sigmoidf_(bf2f(gq[qi][0])), g1 = sigmoidf_(bf2f(gq[qi][1])), g2 = sigmoidf_(bf2f(gq[qi][2]));
                const unsigned ocw[4] = {oc[qi].x, oc[qi].y, oc[qi].z, oc[qi].w}, oww[4] = {ow[qi].x, ow[qi].y, ow[qi].z, ow[qi].w}, zw[4] = {zz[qi].x, zz[qi].y, zz[qi].z, zz[qi].w}, osw[4] = {os.x, os.y, os.z, os.w};
                unsigned res[4];
#pragma unroll
                for (int j = 0; j < 4; ++j) {
                    const float a = (g0 * lo_bf(ocw[j]) + g1 * lo_bf(osw[j]) + g2 * lo_bf(oww[j])) * siluf_(lo_bf(zw[j]));
                    const float b2 = (g0 * hi_bf(ocw[j]) + g1 * hi_bf(osw[j]) + g2 * hi_bf(oww[j])) * siluf_(hi_bf(zw[j]));
                    res[j] = cvtpk(a, b2); }
                *(u32x4*)(ys + row * 1024 + colb) = (u32x4){res[0], res[1], res[2], res[3]}; }
        }
    }
};

template <class Epi>
__device__ __forceinline__ void sb_block(const BlockRef& cur, char* lds, const Epi& E) {
    const int tid = opaque_tid(), wid = __builtin_amdgcn_readfirstlane(tid >> 6), lane = tid & 63, r32 = lane & 31, hi = lane >> 5;
    char* V_lds = lds; char* K_lds = lds + 2 * SHM_V;
    volatile unsigned* flags = (volatile unsigned*)(lds + 2 * SHM_V + 2 * SHM_K + 4096);
    const int sr = tid >> 4, sc = (tid & 15) * 8, vst0 = v_st(sr, sc), vst1 = vst0 + 8192, kws = KSWZ(sr, sc * 2);
    const unsigned roff0 = (unsigned)(sr * LDP + sc) * 2u, qoff = (unsigned)(r32 * LDP + hi * 8) * 2u;
    const int vb0 = (int)(uintptr_t)V_lds + v_rd_base(lane);
    const int qlo = cur.P0 + wid * QBLK, qpos = qlo + r32;
    const int j_hi = cur.P0 / KVBLK + 4;
    Seam S;
    { const unsigned qs_ = (unsigned)(wid * QBLK) * (LDP * 2u);
#pragma unroll
    for (int d0 = 0; d0 < 8; ++d0) S.qr[d0] = bload8(cur.Q, qoff + d0 * 32, qs_); }
    SLOAD_H(cur.K, cur.V, (j_hi - 1) * KVBLK); VMW(); SWRITE_H(0);
    if (tid < 16) flags[tid] = 0u;
    __syncthreads();
    float carry = 1.f; f32x16 o[4] = {}; bool wdone = false; int buf = 0, par = 0;
    for (int j = j_hi - 1; j >= 0; --j) {
        const int kb = j * KVBLK;
        if (j > 0) { SLOAD_H(cur.K, cur.V, kb - KVBLK); }
        const bool act = (kb < qlo + QBLK - 1) && !wdone;
        if (act) {
            f32x16 p0, p1;
            qkt<0, false>(p0, p1, K_lds + buf * SHM_K, r32, hi, S.qr, true);
            const int dq = qpos - kb - 4 * hi;
            f32x16 f0, f1;
#pragma unroll
            for (int r = 0; r < 16; ++r) {
                const int c = (r & 3) + 8 * (r >> 2);
                const float u0 = __builtin_amdgcn_exp2f(fminf(p0[r] * SCALE, 80.f) * 1.4426950408889634f), u1 = __builtin_amdgcn_exp2f(fminf(p1[r] * SCALE, 80.f) * 1.4426950408889634f);
                const float r0 = __builtin_amdgcn_rcpf(1.0f + u0), r1 = __builtin_amdgcn_rcpf(1.0f + u1);
                const bool s0 = c < dq, s1 = c + 32 < dq;
                f0[r] = s0 ? r0 : 1.f; f1[r] = s1 ? r1 : 1.f;
                p0[r] = s0 ? u0 * r0 : 0.f; p1[r] = s1 ? u1 * r1 : 0.f;
            }
            float T[8];
#pragma unroll
            for (int k = 0; k < 4; ++k) {
                { const float e2 = f0[4 * k + 3], e1 = f0[4 * k + 2] * e2, e0 = f0[4 * k + 1] * e1; T[k] = f0[4 * k] * e0; f0[4 * k + 3] = 1.f; f0[4 * k + 2] = e2; f0[4 * k + 1] = e1; f0[4 * k] = e0; }
                { const float e2 = f1[4 * k + 3], e1 = f1[4 * k + 2] * e2, e0 = f1[4 * k + 1] * e1; T[4 + k] = f1[4 * k] * e0; f1[4 * k + 3] = 1.f; f1[4 * k + 2] = e2; f1[4 * k + 1] = e1; f1[4 * k] = e0; }
            }
            float R = 1.f;
#pragma unroll
            for (int k = 7; k >= 0; --k) {
                auto rr = __builtin_amdgcn_permlane32_swap(__float_as_uint(T[k]), __float_as_uint(T[k]), false, false);
                const float tlo = __uint_as_float(rr[0]), thi = __uint_as_float(rr[1]);
                const float base = carry * R * (hi == 0 ? thi : 1.f);
                if (k < 4) { p0[4 * k] *= f0[4 * k] * base; p0[4 * k + 1] *= f0[4 * k + 1] * base; p0[4 * k + 2] *= f0[4 * k + 2] * base; p0[4 * k + 3] *= base; }
                else { p1[4 * (k - 4)] *= f1[4 * (k - 4)] * base; p1[4 * (k - 4) + 1] *= f1[4 * (k - 4) + 1] * base; p1[4 * (k - 4) + 2] *= f1[4 * (k - 4) + 2] * base; p1[4 * (k - 4) + 3] *= base; }
                R *= tlo * thi;
            }
            carry *= R;
            bf16x8 pa0, pa1, pa2, pa3;
#define PK4(P, B_, OUT) do { unsigned a0 = cvtpk(P[B_+0], P[B_+1]), a1 = cvtpk(P[B_+2], P[B_+3]);                          \
        unsigned b0 = cvtpk(P[B_+4], P[B_+5]), b1 = cvtpk(P[B_+6], P[B_+7]);                                             \
        auto r0 = __builtin_amdgcn_permlane32_swap(a0, b0, false, false); auto r1 = __builtin_amdgcn_permlane32_swap(a1, b1, false, false); \
        u32x4 w = {r0[0], r1[0], r0[1], r1[1]}; OUT = *reinterpret_cast<bf16x8*>(&w); } while (0)
            PK4(p0, 0, pa0); PK4(p0, 8, pa1); PK4(p1, 0, pa2); PK4(p1, 8, pa3);
            pv_tile<0, false>(o, vb0 + buf * SHM_V, pa0, pa1, pa2, pa3, true);
            if (__all(carry == 0.f)) wdone = true;
        }
        if (lane == 0) flags[par * 8 + wid] = wdone ? 1u : 0u;
        if (j > 0) { VMW(); if (buf == 0) { SWRITE_H(1); } else { SWRITE_H(0); } }
        __syncthreads();
        unsigned alld = 1u;
#pragma unroll
        for (int w = 0; w < 8; ++w) alld &= flags[par * 8 + w];
        if (alld) break;
        buf ^= 1; par ^= 1;
    }
    float rli[16];
#pragma unroll
    for (int r = 0; r < 16; ++r) rli[r] = 1.f;
    E(o, rli, cur, wid, r32, hi);
    __syncthreads();
}
struct EpiSb {
    const bf16* __restrict__ proj; bf16* __restrict__ ys; char* lds;
    __device__ __forceinline__ void put(const f32x16 (&o)[4], int row_w, int col0, char* scr, int r32, int hi) const {
        int lane = hi * 32 + r32; asm volatile("" : "+v"(lane));
        float one[16];
#pragma unroll
        for (int r = 0; r < 16; ++r) one[r] = 1.f;
        ost_put(scr, o, one, r32, hi);
        const int rowb = row_w + (lane >> 4), colb = col0 + (lane & 15) * 8;
        u32x4 zz[8];
#pragma unroll
        for (int q = 0; q < 8; ++q) zz[q] = *(const u32x4*)(proj + (size_t)(rowb + q * 4) * LDP + C_SZ + colb);
        asm volatile("" ::: "memory");
#pragma unroll
        for (int q = 0; q < 8; ++q) { const u32x4 os = ost_get(scr, q, lane);
            const unsigned zw[4] = {zz[q].x, zz[q].y, zz[q].z, zz[q].w}, osw[4] = {os.x, os.y, os.z, os.w}; unsigned res[4];
#pragma unroll
            for (int j = 0; j < 4; ++j) res[j] = cvtpk(lo_bf(osw[j]) * siluf_(lo_bf(zw[j])), hi_bf(osw[j]) * siluf_(hi_bf(zw[j])));
            *(u32x4*)(ys + (size_t)(rowb + q * 4) * 1024 + colb) = (u32x4){res[0], res[1], res[2], res[3]}; }
    }
    __device__ __forceinline__ void operator()(const f32x16 (&o)[4], const float (&rli)[16], const BlockRef& cur, int wid, int r32, int hi) const {
        put(o, cur.row0 + wid * QBLK, cur.aux, lds + OST_BASE + wid * OST_WAVE, r32, hi);
    }
};

__device__ __forceinline__ void glds16(const void* gsrc, char* lds_dst) {
    __builtin_amdgcn_global_load_lds((const unsigned*)gsrc, (__attribute__((address_space(3))) unsigned*)lds_dst, 16, 0, 0);
}

__device__ __forceinline__ void pv_tile256(f32x16* o, int vbA, int vbB, bf16x8 pa0, bf16x8 pa1, bf16x8 pa2, bf16x8 pa3) {
#define TRR(dst, base, off) asm volatile("ds_read_b64_tr_b16 %0, %1 offset:%2" : "=&v"(dst) : "v"(base), "i"(off) : "memory")
#define PV_LOAD(S, base, d0) do { constexpr int b_ = v_rd_off(d0, 0, 0); \
        TRR(S[0], base, b_); TRR(S[1], base, b_ + 2048); TRR(S[2], base, b_ + 4096); TRR(S[3], base, b_ + 6144); TRR(S[4], base, b_ + 8192); TRR(S[5], base, b_ + 10240); TRR(S[6], base, b_ + 12288); TRR(S[7], base, b_ + 14336); } while (0)
#define PV_MMA(S, acc) do { \
        acc = __builtin_amdgcn_mfma_f32_32x32x16_bf16(pa0, (bf16x8){S[0][0], S[0][1], S[0][2], S[0][3], S[1][0], S[1][1], S[1][2], S[1][3]}, acc, 0, 0, 0); \
        acc = __builtin_amdgcn_mfma_f32_32x32x16_bf16(pa1, (bf16x8){S[2][0], S[2][1], S[2][2], S[2][3], S[3][0], S[3][1], S[3][2], S[3][3]}, acc, 0, 0, 0); \
        acc = __builtin_amdgcn_mfma_f32_32x32x16_bf16(pa2, (bf16x8){S[4][0], S[4][1], S[4][2], S[4][3], S[5][0], S[5][1], S[5][2], S[5][3]}, acc, 0, 0, 0); \
        acc = __builtin_amdgcn_mfma_f32_32x32x16_bf16(pa3, (bf16x8){S[6][0], S[6][1], S[6][2], S[6][3], S[7][0], S[7][1], S[7][2], S[7][3]}, acc, 0, 0, 0); } while (0)
#define PV_W8() do { asm volatile("s_waitcnt lgkmcnt(8)" ::: "memory"); SBAR(); } while (0)
    s16x4 X[8], Y[8];
    asm volatile("s_waitcnt lgkmcnt(0)" ::: "memory");
    PV_LOAD(X, vbA, 0);
    PV_LOAD(Y, vbA, 1); PV_W8(); PV_MMA(X, o[0]);
    PV_LOAD(X, vbA, 2); PV_W8(); PV_MMA(Y, o[1]);
    PV_LOAD(Y, vbA, 3); PV_W8(); PV_MMA(X, o[2]);
    PV_LOAD(X, vbB, 0); PV_W8(); PV_MMA(Y, o[3]);
    PV_LOAD(Y, vbB, 1); PV_W8(); PV_MMA(X, o[4]);
    PV_LOAD(X, vbB, 2); PV_W8(); PV_MMA(Y, o[5]);
    PV_LOAD(Y, vbB, 3); PV_W8(); PV_MMA(X, o[6]);
    asm volatile("s_waitcnt lgkmcnt(0)" ::: "memory"); SBAR(); PV_MMA(Y, o[7]);
#undef TRR
#undef PV_LOAD
#undef PV_MMA
#undef PV_W8
}
__device__ __forceinline__ void diff_block(const BlockRef& cur, bf16* __restrict__ O, char* lds) {
    const int tid = opaque_tid(), wid = __builtin_amdgcn_readfirstlane(tid >> 6), lane = tid & 63, r32 = lane & 31, hi = lane >> 5;
    char* V_lds = lds; char* K_lds = lds + 4 * SHM_V;
    float* ws = (float*)(lds + 4 * SHM_V + 2 * SHM_K) + wid * 64; float* li_l = ws, * al_l = ws + 32;
    const int vb0 = (int)(uintptr_t)V_lds + v_rd_base(lane);
    const int qlo = cur.P0 + wid * QBLK, qm = qlo + r32 - 4 * hi;
    const int NT = cur.P0 / KVBLK + 4;
    unsigned koff[2], voff[2];
#pragma unroll
    for (int i = 0; i < 2; ++i) {
        const int q = i * 8 + wid;
        { const int row = q * 4 + (lane >> 4), ch = (lane & 15) ^ (row & 7); koff[i] = (unsigned)(row * LDP * 2 + ch * 16); }
        { const int sub = q * 2 + (lane >> 5), kk = (sub >> 2) * 8 + ((lane & 31) >> 2), c = (sub & 3) * 32 + (lane & 3) * 8;
          const int k = (kk & ~0xC) | ((kk & 4) << 1) | ((kk & 8) >> 1); voff[i] = (unsigned)(k * LDP * 2 + c * 2); }
    }
#define DIFF_STAGE(t_, b_) do { const char* kq_ = (const char*)cur.K + (size_t)(t_) * KVBLK * (LDP * 2); const char* vq_ = (const char*)cur.V + (size_t)(t_) * KVBLK * (LDP * 2); \
        _Pragma("unroll") for (int i_ = 0; i_ < 2; ++i_) { \
            glds16(kq_ + koff[i_], K_lds + (b_) * SHM_K + (i_ * 8 + wid) * 1024); \
            glds16(vq_ + voff[i_], V_lds + ((b_) * 2) * SHM_V + (i_ * 8 + wid) * 1024); \
            glds16(vq_ + 256 + voff[i_], V_lds + ((b_) * 2 + 1) * SHM_V + (i_ * 8 + wid) * 1024); } } while (0)
    bf16x8 qr[8];
    { const unsigned qoff = (unsigned)(r32 * LDP + hi * 8) * 2u, qs_ = (unsigned)(wid * QBLK) * (LDP * 2u);
#pragma unroll
      for (int d0 = 0; d0 < 8; ++d0) qr[d0] = bload8(cur.Q, qoff + d0 * 32, qs_); }
    DIFF_STAGE(0, 0);
    asm volatile("s_waitcnt vmcnt(0)" ::: "memory");
    __syncthreads();
    float m_reg = -1e30f, l_reg = 0.f; f32x16 o[8] = {};
    int buf = 0;
    for (int t = 0; t < NT; ++t) {
        const int kb = t * KVBLK;
        if (t + 1 < NT) { if (buf == 0) DIFF_STAGE(t + 1, 1); else DIFF_STAGE(t + 1, 0); }
        if (kb <= qlo + QBLK - 1) {
            f32x16 p0, p1; float mn, alpha; bf16x8 pa0, pa1, pa2, pa3;
            qkt<0, false>(p0, p1, K_lds + buf * SHM_K, r32, hi, qr, true);
            if (kb + KVBLK - 1 > qlo) mask_tile(p0, p1, qm - kb, 1u << 30);
            partialSM(p0, p1, m_reg, mn, alpha);
            finishSM(p0, p1, alpha, l_reg, pa0, pa1, pa2, pa3);
            if (__any(alpha < 1.f)) { if (hi == 0) al_l[r32] = alpha; asm volatile("s_waitcnt lgkmcnt(0)" ::: "memory");
#pragma unroll
                for (int d_ = 0; d_ < 8; ++d_)
#pragma unroll
                    for (int r = 0; r < 16; ++r) o[d_][r] *= al_l[crow(r, hi)]; }
            pv_tile256(o, vb0 + (buf * 2) * SHM_V, vb0 + (buf * 2 + 1) * SHM_V, pa0, pa1, pa2, pa3);
        }
        asm volatile("s_waitcnt vmcnt(0)" ::: "memory");
        __syncthreads();
        buf ^= 1;
    }
#undef DIFF_STAGE
    if (hi == 0) li_l[r32] = l_reg; asm volatile("s_waitcnt lgkmcnt(0)" ::: "memory");
    float rl[16];
#pragma unroll
    for (int r = 0; r < 16; ++r) rl[r] = __builtin_amdgcn_rcpf(li_l[crow(r, hi)]);
    char* scr = lds + wid * OST_WAVE;
    char* Ow = (char*)(O + (size_t)(cur.row0 + wid * QBLK) * 1024 + cur.aux);
    const unsigned loff = (unsigned)((lane >> 4) * 1024 + (lane & 15) * 8) * 2u;
#pragma unroll
    for (int h = 0; h < 2; ++h) {
        ost_put(scr, o + 4 * h, rl, r32, hi);
#pragma unroll
        for (int q = 0; q < 8; ++q) *(u32x4*)(Ow + (size_t)(q * 4 * 1024 + h * 128) * 2 + loff) = ost_get(scr, q, lane);
    }
    __syncthreads();
}

struct SbPairRef { const bf16* Q; const bf16* K; const bf16* V; int P0; int row0; int aux; };
__device__ __forceinline__ void sb_pair(const SbPairRef& pr, char* lds, const EpiSb& E) {
    const int tid = opaque_tid(), wid = __builtin_amdgcn_readfirstlane(tid >> 6), lane = tid & 63, r32 = lane & 31, hi = lane >> 5;
    const int hs = wid >> 2, w4 = wid & 3;
    char* V_lds = lds; char* K_lds = lds + 4 * SHM_V;
    volatile unsigned* flags = (volatile unsigned*)(lds + LDS_AUX + 4096);
    const int vb0 = (int)(uintptr_t)V_lds + v_rd_base(lane);
    const int qlo = pr.P0 + w4 * QBLK, qpos = qlo + r32;
    const int j_hi = pr.P0 / KVBLK + 2;
    unsigned koff[2], voff[2];
#pragma unroll
    for (int i = 0; i < 2; ++i) {
        const int q = i * 8 + wid;
        { const int row = q * 4 + (lane >> 4), ch = (lane & 15) ^ (row & 7); koff[i] = (unsigned)(row * LDP * 2 + ch * 16); }
        { const int sub = q * 2 + (lane >> 5), kk = (sub >> 2) * 8 + ((lane & 31) >> 2), c = (sub & 3) * 32 + (lane & 3) * 8;
          const int k = (kk & ~0xC) | ((kk & 4) << 1) | ((kk & 8) >> 1); voff[i] = (unsigned)(k * LDP * 2 + c * 2); }
    }
#define SBP_STAGE(t_, b_) do { const char* kq_ = (const char*)pr.K + (size_t)(t_) * KVBLK * (LDP * 2); const char* vq_ = (const char*)pr.V + (size_t)(t_) * KVBLK * (LDP * 2); \
        _Pragma("unroll") for (int i_ = 0; i_ < 2; ++i_) { \
            glds16(kq_ + koff[i_], K_lds + ((b_) * 2) * SHM_K + (i_ * 8 + wid) * 1024); glds16(kq_ + 256 + koff[i_], K_lds + ((b_) * 2 + 1) * SHM_K + (i_ * 8 + wid) * 1024); \
            glds16(vq_ + voff[i_], V_lds + ((b_) * 2) * SHM_V + (i_ * 8 + wid) * 1024); glds16(vq_ + 256 + voff[i_], V_lds + ((b_) * 2 + 1) * SHM_V + (i_ * 8 + wid) * 1024); } } while (0)
    bf16x8 qr[8];
    { const unsigned qoff = (unsigned)(r32 * LDP + hi * 8) * 2u + (unsigned)hs * 256u, qs_ = (unsigned)(w4 * QBLK) * (LDP * 2u);
#pragma unroll
      for (int d0 = 0; d0 < 8; ++d0) qr[d0] = bload8(pr.Q, qoff + d0 * 32, qs_); }
    SBP_STAGE(j_hi - 1, 0);
    if (tid < 16) flags[tid] = 0u;
    asm volatile("s_waitcnt vmcnt(0)" ::: "memory");
    __syncthreads();
    float carry = 1.f; f32x16 o[4] = {}; bool wdone = false; int buf = 0, par = 0;
    for (int j = j_hi - 1; j >= 0; --j) {
        const int kb = j * KVBLK;
        if (j > 0) { if (buf == 0) SBP_STAGE(j - 1, 1); else SBP_STAGE(j - 1, 0); }
        const bool act = (kb < qlo + QBLK - 1) && !wdone;
        if (act) {
            f32x16 p0, p1;
            qkt<0, false>(p0, p1, K_lds + (buf * 2 + hs) * SHM_K, r32, hi, qr, true);
            const int dq = qpos - kb - 4 * hi;
            f32x16 f0, f1;
            constexpr float CS = SCALE * 1.4426950408889634f, CCL = 80.f * 1.4426950408889634f;
            if (kb + KVBLK - 1 >= qlo) {
#pragma unroll
                for (int r = 0; r < 16; ++r) {
                    const int c = (r & 3) + 8 * (r >> 2);
                    const float u0 = __builtin_amdgcn_exp2f(fminf(p0[r] * CS, CCL)), u1 = __builtin_amdgcn_exp2f(fminf(p1[r] * CS, CCL));
                    const float r0 = __builtin_amdgcn_rcpf(1.0f + u0), r1 = __builtin_amdgcn_rcpf(1.0f + u1);
                    const bool s0 = c < dq, s1 = c + 32 < dq;
                    f0[r] = s0 ? r0 : 1.f; f1[r] = s1 ? r1 : 1.f;
                    p0[r] = s0 ? u0 : 0.f; p1[r] = s1 ? u1 : 0.f;
                }
            } else {
#pragma unroll
                for (int r = 0; r < 16; ++r) {
                    const float u0 = __builtin_amdgcn_exp2f(fminf(p0[r] * CS, CCL)), u1 = __builtin_amdgcn_exp2f(fminf(p1[r] * CS, CCL));
                    f0[r] = __builtin_amdgcn_rcpf(1.0f + u0); f1[r] = __builtin_amdgcn_rcpf(1.0f + u1);
                    p0[r] = u0; p1[r] = u1;
                }
            }
            float T[8];
#pragma unroll
            for (int k = 0; k < 4; ++k) {
                { const float e3 = f0[4 * k + 3], e2 = f0[4 * k + 2] * e3, e1 = f0[4 * k + 1] * e2, e0 = f0[4 * k] * e1; T[k] = e0; f0[4 * k + 2] = e2; f0[4 * k + 1] = e1; f0[4 * k] = e0; }
                { const float e3 = f1[4 * k + 3], e2 = f1[4 * k + 2] * e3, e1 = f1[4 * k + 1] * e2, e0 = f1[4 * k] * e1; T[4 + k] = e0; f1[4 * k + 2] = e2; f1[4 * k + 1] = e1; f1[4 * k] = e0; }
            }
            float R = 1.f;
#pragma unroll
            for (int k = 7; k >= 0; --k) {
                auto rr = __builtin_amdgcn_permlane32_swap(__float_as_uint(T[k]), __float_as_uint(T[k]), false, false);
                const float tlo = __uint_as_float(rr[0]), thi = __uint_as_float(rr[1]);
                const float base = carry * R * (hi == 0 ? thi : 1.f);
                if (k < 4) { p0[4 * k] *= f0[4 * k] * base; p0[4 * k + 1] *= f0[4 * k + 1] * base; p0[4 * k + 2] *= f0[4 * k + 2] * base; p0[4 * k + 3] *= f0[4 * k + 3] * base; }
                else { p1[4 * (k - 4)] *= f1[4 * (k - 4)] * base; p1[4 * (k - 4) + 1] *= f1[4 * (k - 4) + 1] * base; p1[4 * (k - 4) + 2] *= f1[4 * (k - 4) + 2] * base; p1[4 * (k - 4) + 3] *= f1[4 * (k - 4) + 3] * base; }
                R *= tlo * thi;
            }
            carry *= R;
            bf16x8 pa0, pa1, pa2, pa3;
            PK4(p0, 0, pa0); PK4(p0, 8, pa1); PK4(p1, 0, pa2); PK4(p1, 8, pa3);
            pv_tile<0, false>(o, vb0 + (buf * 2 + hs) * SHM_V, pa0, pa1, pa2, pa3, true);
            if (__all(carry == 0.f)) wdone = true;
        }
        if (lane == 0) flags[par * 8 + wid] = wdone ? 1u : 0u;
        asm volatile("s_waitcnt vmcnt(0)" ::: "memory");
        __syncthreads();
        unsigned alld = 1u;
#pragma unroll
        for (int w = 0; w < 8; ++w) alld &= flags[par * 8 + w];
        if (alld) break;
        buf ^= 1; par ^= 1;
    }
#undef SBP_STAGE
    E.put(o, pr.row0 + w4 * QBLK, pr.aux + hs * 128, lds + wid * OST_WAVE, r32, hi);
    __syncthreads();
}

__device__ __forceinline__ void pv_tile128p(f32x16* o, int vb, bf16x8 pa0, bf16x8 pa1, bf16x8 pa2, bf16x8 pa3) {
#define TRR(dst, base, off) asm volatile("ds_read_b64_tr_b16 %0, %1 offset:%2" : "=&v"(dst) : "v"(base), "i"(off) : "memory")
#define PV_LOAD(S, base, d0) do { constexpr int b_ = v_rd_off(d0, 0, 0); \
        TRR(S[0], base, b_); TRR(S[1], base, b_ + 2048); TRR(S[2], base, b_ + 4096); TRR(S[3], base, b_ + 6144); TRR(S[4], base, b_ + 8192); TRR(S[5], base, b_ + 10240); TRR(S[6], base, b_ + 12288); TRR(S[7], base, b_ + 14336); } while (0)
#define PV_MMA(S, acc) do { \
        acc = __builtin_amdgcn_mfma_f32_32x32x16_bf16(pa0, (bf16x8){S[0][0], S[0][1], S[0][2], S[0][3], S[1][0], S[1][1], S[1][2], S[1][3]}, acc, 0, 0, 0); \
        acc = __builtin_amdgcn_mfma_f32_32x32x16_bf16(pa1, (bf16x8){S[2][0], S[2][1], S[2][2], S[2][3], S[3][0], S[3][1], S[3][2], S[3][3]}, acc, 0, 0, 0); \
        acc = __builtin_amdgcn_mfma_f32_32x32x16_bf16(pa2, (bf16x8){S[4][0], S[4][1], S[4][2], S[4][3], S[5][0], S[5][1], S[5][2], S[5][3]}, acc, 0, 0, 0); \
        acc = __builtin_amdgcn_mfma_f32_32x32x16_bf16(pa3, (bf16x8){S[6][0], S[6][1], S[6][2], S[6][3], S[7][0], S[7][1], S[7][2], S[7][3]}, acc, 0, 0, 0); } while (0)
#define PV_W8() do { asm volatile("s_waitcnt lgkmcnt(8)" ::: "memory"); SBAR(); } while (0)
    s16x4 X[8], Y[8];
    asm volatile("s_waitcnt lgkmcnt(0)" ::: "memory");
    PV_LOAD(X, vb, 0);
    PV_LOAD(Y, vb, 1); PV_W8(); PV_MMA(X, o[0]);
    PV_LOAD(X, vb, 2); PV_W8(); PV_MMA(Y, o[1]);
    PV_LOAD(Y, vb, 3); PV_W8(); PV_MMA(X, o[2]);
    asm volatile("s_waitcnt lgkmcnt(0)" ::: "memory"); SBAR(); PV_MMA(Y, o[3]);
#undef TRR
#undef PV_LOAD
#undef PV_MMA
#undef PV_W8
}
template <bool SLC, int W, int HM, class Epi, bool TL = false>
__device__ __forceinline__ void attn_simple(const BlockRef& cur, char* lds, const Epi& E) {
    const int tid = opaque_tid(), wid = __builtin_amdgcn_readfirstlane(tid >> 6), lane = tid & 63, r32 = lane & 31, hi = lane >> 5;
    char* V_lds = lds; char* K_lds = lds + 2 * SHM_V;
    float* ws = (float*)(lds + 2 * SHM_V + 2 * SHM_K) + wid * 64; float* li_l = ws, * al_l = ws + 32;
    const int vb0 = (int)(uintptr_t)V_lds + v_rd_base(lane);
    constexpr int RW = 8 / HM, QSPAN = TL ? 8 : QBLK; const int wsub = wid & (RW - 1), hl = wid / RW;
    const int qlo = TL ? cur.P0 + wid * 8 : cur.P0 + wsub * QBLK, qm = (TL ? qlo + (r32 >> 2) : qlo + r32) - 4 * hi;
    const int j_lo = swa_jlo(cur.P0, W), NT = cur.P0 / KVBLK + RW * QBLK / KVBLK - j_lo;
    unsigned koff[2], voff[2];
#pragma unroll
    for (int i = 0; i < 2; ++i) {
        const int q = i * 8 + wid;
        { const int row = q * 4 + (lane >> 4), ch = (lane & 15) ^ (row & 7); koff[i] = (unsigned)(row * LDP * 2 + ch * 16); }
        { const int sub = q * 2 + (lane >> 5), kk = (sub >> 2) * 8 + ((lane & 31) >> 2), c = (sub & 3) * 32 + (lane & 3) * 8;
          const int k = (kk & ~0xC) | ((kk & 4) << 1) | ((kk & 8) >> 1); voff[i] = (unsigned)(k * LDP * 2 + c * 2); }
    }
#define AS_STAGE(t_, b_) do { const char* kq_ = (const char*)cur.K + (size_t)(j_lo + (t_)) * KVBLK * (LDP * 2); const char* vq_ = (const char*)cur.V + (size_t)(j_lo + (t_)) * KVBLK * (LDP * 2); \
        _Pragma("unroll") for (int i_ = 0; i_ < 2; ++i_) { \
            glds16(kq_ + koff[i_], K_lds + (b_) * SHM_K + (i_ * 8 + wid) * 1024); glds16(vq_ + voff[i_], V_lds + (b_) * SHM_V + (i_ * 8 + wid) * 1024); } } while (0)
    bf16x8 qr[8];
    { const unsigned qoff = TL ? (unsigned)((wid * 8 + (r32 >> 2)) * LDP + (r32 & 3) * 128 + hi * 8) * 2u : (unsigned)(r32 * LDP + hi * 8) * 2u, qs_ = TL ? 0u : (unsigned)(wsub * QBLK) * (LDP * 2u) + (unsigned)hl * 256u;
#pragma unroll
      for (int d0 = 0; d0 < 8; ++d0) qr[d0] = bload8(cur.Q, qoff + d0 * 32, qs_); }
    u64 rowmask = ~0ull; if constexpr (SLC) rowmask = cur.M[TL ? cur.P0 + wid * 8 + (r32 >> 2) : cur.P0 + wsub * QBLK + r32];
    AS_STAGE(0, 0);
    asm volatile("s_waitcnt vmcnt(0)" ::: "memory");
    __syncthreads();
    float m_reg = -1e30f, l_reg = 0.f; f32x16 o[4] = {};
    int buf = 0;
    for (int t = 0; t < NT; ++t) {
        const int kb = (j_lo + t) * KVBLK;
        if (t + 1 < NT) { if (buf == 0) AS_STAGE(t + 1, 1); else AS_STAGE(t + 1, 0); }
        bool act = kb <= qlo + QSPAN - 1 && kb + KVBLK - 1 >= qlo - W + 1;
        if constexpr (SLC && TL) act = act && __any(((rowmask >> (j_lo + t)) & 1ull) != 0ull);
        if (act) {
            f32x16 p0, p1; float mn, alpha; bf16x8 pa0, pa1, pa2, pa3;
            qkt<0, false>(p0, p1, K_lds + buf * SHM_K, r32, hi, qr, true);
            if (kb + KVBLK - 1 > qlo || kb <= qlo + QSPAN - 1 - W) mask_tile(p0, p1, qm - kb, (unsigned)W);
            if constexpr (SLC) partialSM_sel(p0, p1, m_reg, mn, alpha, ((rowmask >> (j_lo + t)) & 1ull) != 0ull); else partialSM(p0, p1, m_reg, mn, alpha);
            finishSM(p0, p1, alpha, l_reg, pa0, pa1, pa2, pa3);
            if (__any(alpha < 1.f)) { if (hi == 0) al_l[r32] = alpha; asm volatile("s_waitcnt lgkmcnt(0)" ::: "memory");
#pragma unroll
                for (int d_ = 0; d_ < 4; ++d_)
#pragma unroll
                    for (int r = 0; r < 16; ++r) o[d_][r] *= al_l[crow(r, hi)]; }
            pv_tile128p(o, vb0 + buf * SHM_V, pa0, pa1, pa2, pa3);
        }
        asm volatile("s_waitcnt vmcnt(0)" ::: "memory");
        __syncthreads();
        buf ^= 1;
    }
#undef AS_STAGE
    if (hi == 0) li_l[r32] = l_reg; asm volatile("s_waitcnt lgkmcnt(0)" ::: "memory");
    float rli[16];
#pragma unroll
    for (int r = 0; r < 16; ++r) rli[r] = __builtin_amdgcn_rcpf(li_l[crow(r, hi)]);
    if constexpr (HM == 1 || TL) E(o, rli, cur, wid, r32, hi);
    else { BlockRef cw = cur; cw.row0 = cur.row0 + (wsub - wid) * QBLK; cw.aux = cur.aux + hl * 128; cw.aux2 = cur.aux2 + hl; E(o, rli, cw, wid, r32, hi); }
    __syncthreads();
}

__device__ __forceinline__ float quad_sum(float x) {
    x += __int_as_float(__builtin_amdgcn_update_dpp(0, __float_as_int(x), 0xB1, 0xF, 0xF, true));
    x += __int_as_float(__builtin_amdgcn_update_dpp(0, __float_as_int(x), 0x4E, 0xF, 0xF, true));
    return x;
}
__device__ __forceinline__ void cmp_unit(const bf16* __restrict__ proj, bf16* __restrict__ ocmp, u64* __restrict__ selm, int bg, int tb, char* lds) {
    const int tid = opaque_tid(), wid = __builtin_amdgcn_readfirstlane(tid >> 6), lane = tid & 63, r32 = lane & 31, hi = lane >> 5;
    const int b = bg >> 1, g = bg & 1, tok0 = tb * 64;
    const int n_max = (tok0 + 32) >> 4;
    const int ntile = (n_max >> 6) + 1;
    char* K_lds = lds; char* V_lds = lds + 4 * SHM_K;
    float* impT = (float*)(lds + LDS_AUX);
    const int tokl = wid * 8 + (r32 >> 2), tpos = tok0 + tokl, head = g * 4 + (r32 & 3);
    bf16x8 qr[8];
    { const bf16* qp = proj + (size_t)(b * SEQ + tpos) * LDP + C_NQ + head * 128 + hi * 8;
#pragma unroll
      for (int d0 = 0; d0 < 8; ++d0) qr[d0] = ld8(qp + d0 * 16); }
    const int nlim = (tpos - 31) >> 4;
    const int vb0 = (int)(uintptr_t)V_lds + v_rd_base(lane);
    constexpr float C2 = 1.4426950408889634f * SCALE;
    float mx = -1e30f, lsum = 0.f;
    for (int t = 0; t < ntile; ++t) {
        f32x16 p0, p1; qkt<0, false>(p0, p1, K_lds + t * SHM_K, r32, hi, qr, true);
        const int nb = t * 64 + 4 * hi; float tm = -1e30f;
#pragma unroll
        for (int r = 0; r < 16; ++r) { const int c = (r & 3) + 8 * (r >> 2);
            if (nb + c <= nlim) tm = fmaxf(tm, p0[r]); if (nb + c + 32 <= nlim) tm = fmaxf(tm, p1[r]); }
        tm = fmaxf(tm, other_half(tm));
        const float mn = fmaxf(mx, tm), mLn = -mn * C2; float ps = 0.f;
#pragma unroll
        for (int r = 0; r < 16; ++r) { const int c = (r & 3) + 8 * (r >> 2);
            const float e0 = __builtin_amdgcn_exp2f(fmaf(p0[r], C2, mLn)), e1 = __builtin_amdgcn_exp2f(fmaf(p1[r], C2, mLn));
            ps += ((nb + c <= nlim) ? e0 : 0.f) + ((nb + c + 32 <= nlim) ? e1 : 0.f); }
        lsum = lsum * __builtin_amdgcn_exp2f((mx - mn) * C2) + ps; mx = mn;
    }
    lsum += other_half(lsum);
    const float inv_l = lsum > 0.f ? 1.0f / lsum : 0.f;
    f32x16 o[4] = {}; float prev_hi_last = 0.f;
    const float mL = -mx * C2;
    for (int t = 0; t < 4; ++t) {
        if (t < ntile) {
            f32x16 p0, p1; qkt<0, false>(p0, p1, K_lds + t * SHM_K, r32, hi, qr, true);
            const int nb = t * 64 + 4 * hi;
#pragma unroll
            for (int r = 0; r < 16; ++r) { const int c = (r & 3) + 8 * (r >> 2);
                const float e0 = __builtin_amdgcn_exp2f(fmaf(p0[r], C2, mL)) * inv_l, e1 = __builtin_amdgcn_exp2f(fmaf(p1[r], C2, mL)) * inv_l;
                p0[r] = (nb + c <= nlim) ? e0 : 0.f; p1[r] = (nb + c + 32 <= nlim) ? e1 : 0.f; }
#pragma unroll
            for (int k = 0; k < 8; ++k) {
                const float gs = (k < 4) ? (p0[4 * k] + p0[4 * k + 1]) + (p0[4 * k + 2] + p0[4 * k + 3]) : (p1[4 * (k - 4)] + p1[4 * (k - 4) + 1]) + (p1[4 * (k - 4) + 2] + p1[4 * (k - 4) + 3]);
                const float last = (k < 4) ? p0[4 * k + 3] : p1[4 * (k - 4) + 3];
                auto rr = __builtin_amdgcn_permlane32_swap(__float_as_uint(last), __float_as_uint(last), false, false);
                const float llo = __uint_as_float(rr[0]), lhi = __uint_as_float(rr[1]);
                float v = gs + (hi ? llo : prev_hi_last);
                prev_hi_last = lhi;
                v = quad_sum(v);
                if ((r32 & 3) == (k >> 1)) impT[tokl * 64 + t * 16 + 2 * k + hi] = v;
            }
            bf16x8 pa0, pa1, pa2, pa3;
            PK4(p0, 0, pa0); PK4(p0, 8, pa1); PK4(p1, 0, pa2); PK4(p1, 8, pa3);
            pv_tile<0, false>(o, vb0 + t * SHM_V, pa0, pa1, pa2, pa3, true);
        } else {
#pragma unroll
            for (int k = 0; k < 8; ++k) if ((r32 & 3) == (k >> 1)) impT[tokl * 64 + t * 16 + 2 * k + hi] = 0.f;
        }
    }
    {
        const size_t rowb = (size_t)(b * SEQ + tok0 + wid * 8);
#pragma unroll
        for (int r = 0; r < 16; ++r) { const int cr = crow(r, hi);
            bf16* op = ocmp + (rowb + (cr >> 2)) * 1024 + (g * 4 + (cr & 3)) * 128;
#pragma unroll
            for (int d0 = 0; d0 < 4; ++d0) { const float v = o[d0][r]; const float vn = __int_as_float(__builtin_amdgcn_update_dpp(0, __float_as_int(v), 0xB1, 0xF, 0xF, true));
                if ((r32 & 1) == 0) *(unsigned*)(op + d0 * 32 + r32) = cvtpk(v, vn); } }
    }
    asm volatile("s_waitcnt lgkmcnt(0)" ::: "memory");
#pragma unroll 1
    for (int tk = 0; tk < 8; ++tk) {
        const float v = impT[(wid * 8 + tk) * 64 + lane];
        unsigned key = (__float_as_uint(v) & ~63u) | (63u - (unsigned)lane);
        if (lane == tb || lane == 0) key = 0xFFFFFFC0u | (63u - (unsigned)lane);
        const bool valid = lane <= tb;
        if (!valid) key = 0u;
        unsigned T = 0u;
#pragma unroll
        for (int bit = 31; bit >= 0; --bit) { const unsigned Tt = T | (1u << bit); if (__popcll(__ballot(key >= Tt)) >= 16) T = Tt; }
        const u64 m = __ballot(valid && key >= T);
        if (lane == 0) selm[(size_t)bg * SEQ + tok0 + wid * 8 + tk] = m;
    }
}
__device__ __forceinline__ void cmp_pair(const bf16* __restrict__ proj, const bf16* __restrict__ kcmp, const bf16* __restrict__ vcmp, bf16* __restrict__ ocmp, u64* __restrict__ selm, int pair, char* lds) {
    const int tid = opaque_tid();
    const int bg = pair >> 5, p = pair & 31, tb_hi = 63 - p, tb_lo = p;
    const int ntile = (((tb_hi * 64 + 32) >> 4) >> 6) + 1;
    char* K_lds = lds; char* V_lds = lds + 4 * SHM_K;
    const int sr = tid >> 4, sc = (tid & 15) * 8, kws = KSWZ(sr, sc * 2), vst0 = v_st(sr, sc), vst1 = vst0 + 8192;
    bf16x8 kr[4][2], vr[4][2];
#pragma unroll
    for (int t = 0; t < 4; ++t) if (t < ntile) {
        const bf16* kp = kcmp + ((size_t)bg * 256 + t * 64) * 128 + sc; const bf16* vp = vcmp + ((size_t)bg * 256 + t * 64) * 128 + sc;
        kr[t][0] = ld8(kp + sr * 128); kr[t][1] = ld8(kp + (32 + sr) * 128); vr[t][0] = ld8(vp + sr * 128); vr[t][1] = ld8(vp + (32 + sr) * 128); }
#pragma unroll
    for (int t = 0; t < 4; ++t) if (t < ntile) {
        *(bf16x8*)(K_lds + t * SHM_K + kws) = kr[t][0]; *(bf16x8*)(K_lds + t * SHM_K + kws + 32 * 256) = kr[t][1];
        *(bf16x8*)(V_lds + t * SHM_V + vst0) = vr[t][0]; *(bf16x8*)(V_lds + t * SHM_V + vst1) = vr[t][1]; }
    __syncthreads();
    cmp_unit(proj, ocmp, selm, bg, tb_hi, lds);
    cmp_unit(proj, ocmp, selm, bg, tb_lo, lds);
    __syncthreads();
}

__device__ __forceinline__ void compress_item(const bf16* __restrict__ proj, const float* __restrict__ pe, const bf16* __restrict__ w1t, const bf16* __restrict__ w2t, bf16* __restrict__ outc, int kv, int bg, int nt, char* lds) {
    const int tid = opaque_tid(), wid = __builtin_amdgcn_readfirstlane(tid >> 6), lane = tid & 63, r32 = lane & 31, hi = lane >> 5;
    const int b = bg >> 1, g = bg & 1, n0 = nt * 32, jb = wid & 3, kh = wid >> 2;
    char* W_lds = lds; char* A_lds = lds + 98304; float* part = (float*)lds; bf16* hid = (bf16*)(lds + 40960); float* peT = (float*)(lds + LDS_AUX);
    unsigned woff[4];
#pragma unroll
    for (int i = 0; i < 4; ++i) { const int j = (i * 8 + wid) * 4 + (lane >> 4), ch = (lane & 15) ^ (j & 7); woff[i] = (unsigned)(j * 4096 * 2 + ch * 16); }
    unsigned aoff_;
    { const int nl = wid * 4 + (lane >> 4); int n = n0 + nl; if (n > 254) n = 254; const int ch = (lane & 15) ^ (nl & 7);
      aoff_ = (unsigned)((16 * n) * LDP * 2 + ch * 16); }
    const char* xbase = (const char*)(proj + (size_t)b * SEQ * LDP + (kv ? C_NVC : C_NKC) + g * 128);
#define CMP_STAGE(l_, bf_) do { \
        _Pragma("unroll") for (int i_ = 0; i_ < 4; ++i_) glds16((const char*)w1t + (size_t)(l_) * 256 + woff[i_], W_lds + (bf_) * 32768 + (i_ * 8 + wid) * 1024); \
        glds16(xbase + (size_t)(l_) * (LDP * 2) + aoff_, A_lds + (bf_) * 8192 + wid * 1024); } while (0)
    CMP_STAGE(0, 0);
    for (int i = tid; i < 32 * 128 / 4; i += 512) ((f32x4*)peT)[i] = ((const f32x4*)pe)[i];
    CMP_STAGE(1, 1);
    asm volatile("s_waitcnt vmcnt(5) lgkmcnt(0)" ::: "memory");
    __builtin_amdgcn_s_barrier();
    f32x16 acc = {};
    const int jrow = jb * 32 + r32;
    int cur = 0, nx1 = 1, nx2 = 2;
    for (int l = 0; l < 32; ++l) {
        if (l + 2 < 32) { if (nx2 == 0) CMP_STAGE(l + 2, 0); else if (nx2 == 1) CMP_STAGE(l + 2, 1); else CMP_STAGE(l + 2, 2); }
        const char* Wb = W_lds + cur * 32768 + jrow * 256; const char* Ab = A_lds + cur * 8192 + r32 * 256; const float* pl = peT + l * 128;
#pragma unroll
        for (int dd = 0; dd < 4; ++dd) { const int d0 = kh * 4 + dd, c = d0 * 2 + hi;
            const bf16x8 wf = *(const bf16x8*)(Wb + ((c ^ (jrow & 7)) << 4));
            const u32x4 xv = *(const u32x4*)(Ab + ((c ^ (r32 & 7)) << 4)); const f32x4 pa = *(const f32x4*)(pl + c * 8), pb = *(const f32x4*)(pl + c * 8 + 4);
            u32x4 aw; aw.x = cvtpk(lo_bf(xv.x) + pa[0], hi_bf(xv.x) + pa[1]); aw.y = cvtpk(lo_bf(xv.y) + pa[2], hi_bf(xv.y) + pa[3]);
            aw.z = cvtpk(lo_bf(xv.z) + pb[0], hi_bf(xv.z) + pb[1]); aw.w = cvtpk(lo_bf(xv.w) + pb[2], hi_bf(xv.w) + pb[3]);
            acc = __builtin_amdgcn_mfma_f32_32x32x16_bf16(wf, *reinterpret_cast<const bf16x8*>(&aw), acc, 0, 0, 0); }
        if (l + 2 < 32) asm volatile("s_waitcnt vmcnt(5) lgkmcnt(0)" ::: "memory");
        else asm volatile("s_waitcnt vmcnt(0) lgkmcnt(0)" ::: "memory");
        __builtin_amdgcn_s_barrier();
        const int t_ = cur; cur = nx1; nx1 = nx2; nx2 = t_;
    }
#undef CMP_STAGE
#pragma unroll
    for (int r = 0; r < 16; ++r) part[(kh * 32 + r32) * 129 + jb * 32 + crow(r, hi)] = acc[r];
    __syncthreads();
    {
        const int row = tid >> 4, c8 = (tid & 15) * 8; float sv[8];
#pragma unroll
        for (int j = 0; j < 8; ++j) sv[j] = part[row * 129 + c8 + j] + part[(32 + row) * 129 + c8 + j];
        u32x4 hw; hw.x = cvtpk(siluf_(sv[0]), siluf_(sv[1])); hw.y = cvtpk(siluf_(sv[2]), siluf_(sv[3])); hw.z = cvtpk(siluf_(sv[4]), siluf_(sv[5])); hw.w = cvtpk(siluf_(sv[6]), siluf_(sv[7]));
        *(u32x4*)((char*)hid + row * 256 + ((c8 * 2) ^ ((row & 7) << 4))) = hw;
    }
    __syncthreads();
    if (wid < 4) {
        f32x16 a2 = {};
#pragma unroll
        for (int k0 = 0; k0 < 8; ++k0) {
            const bf16x8 af = *(const bf16x8*)((char*)hid + r32 * 256 + (((k0 * 16 + hi * 8) * 2) ^ ((r32 & 7) << 4)));
            const bf16x8 bfr = ld8(w2t + (size_t)(wid * 32 + r32) * 128 + k0 * 16 + hi * 8);
            a2 = __builtin_amdgcn_mfma_f32_32x32x16_bf16(af, bfr, a2, 0, 0, 0);
        }
#pragma unroll
        for (int r = 0; r < 16; ++r) { const int nn = n0 + crow(r, hi);
            outc[((size_t)bg * 256 + nn) * 128 + wid * 32 + r32] = (bf16)f2bf(nn < 255 ? a2[r] : 0.f); }
    }
    __syncthreads();
}
#undef PK4

__device__ __forceinline__ float wave_sum(float v) {
#pragma unroll
    for (int o = 32; o >= 1; o >>= 1) v += __shfl_xor(v, o);
    return v;
}
__device__ __forceinline__ void norm_phase(const Params& P, int l, const float* xin) {
    const int tid = opaque_tid(), wid = tid >> 6, lane = tid & 63;
    const float* gpre = P.norm_pre_g + (size_t)l * DM;
    bf16* H = (bf16*)(P.ws + WS_H); unsigned char* H8 = P.ws + WS_H8;
    for (int row = blockIdx.x * 8 + wid; row < MTOK; row += gridDim.x * 8) {
        const float* mod = (const float*)(P.ws + WS_MOD) + ((size_t)l * 4 + (row >> 12)) * 6144;
        const float* xr = xin + (size_t)row * DM;
        f32x4 v[8]; float ss = 0.f;
#pragma unroll
        for (int k = 0; k < 4; ++k) { v[2 * k] = *(const f32x4*)(xr + k * 512 + lane * 8); v[2 * k + 1] = *(const f32x4*)(xr + k * 512 + lane * 8 + 4); }
#pragma unroll
        for (int k = 0; k < 8; ++k) ss += v[k][0] * v[k][0] + v[k][1] * v[k][1] + v[k][2] * v[k][2] + v[k][3] * v[k][3];
        ss = wave_sum(ss);
        const float rs = 1.0f / sqrtf(ss * (1.0f / DM) + 1e-6f);
#pragma unroll
        for (int k = 0; k < 4; ++k) {
            const int col = k * 512 + lane * 8; float o[8];
#pragma unroll
            for (int j = 0; j < 8; ++j) { const float xv = v[2 * k + (j >> 2)][j & 3];
                o[j] = xv * rs * gpre[col + j] * (1.0f + mod[2048 + col + j]) + mod[col + j]; }
            u32x4 w; w.x = pk2(o[0], o[1]); w.y = pk2(o[2], o[3]); w.z = pk2(o[4], o[5]); w.w = pk2(o[6], o[7]);
            *(u32x4*)(H + (size_t)row * DM + col) = w;
            u32x2 w8; w8.x = pk4_fp8(o[0] * F8_SCALE_H, o[1] * F8_SCALE_H, o[2] * F8_SCALE_H, o[3] * F8_SCALE_H); w8.y = pk4_fp8(o[4] * F8_SCALE_H, o[5] * F8_SCALE_H, o[6] * F8_SCALE_H, o[7] * F8_SCALE_H);
            *(u32x2*)(H8 + (size_t)row * DM + col) = w8;
        }
    }
}
__device__ __forceinline__ void post_phase(const Params& P, int l, const float* __restrict__ xin, bool grouped) {
    const int tid = opaque_tid(), wid = tid >> 6, lane = tid & 63;
    const float* __restrict__ gpost = P.norm_post_g + (size_t)l * DM;
    const bf16* __restrict__ OP = (const bf16*)(P.ws + WS_OUTPRE);
    bf16* __restrict__ H = (bf16*)(P.ws + WS_H); unsigned char* __restrict__ H8 = P.ws + WS_H8;
    float* __restrict__ outp = P.out;
    const int stride = grouped ? 8 : (int)gridDim.x * 8;
    int row = grouped ? (int)(blockIdx.x & 7) * (MTOK / 8) + (int)(blockIdx.x >> 3) * 64 + wid : (int)blockIdx.x * 8 + wid;
    const int row_end = grouped ? row - wid + 64 : MTOK;
    u32x4 opn[4]; f32x4 xn[8];
    if (row < row_end) {
#pragma unroll
        for (int k = 0; k < 4; ++k) { opn[k] = *(const u32x4*)(OP + (size_t)row * DM + k * 512 + lane * 8);
            xn[2 * k] = *(const f32x4*)(xin + (size_t)row * DM + k * 512 + lane * 8); xn[2 * k + 1] = *(const f32x4*)(xin + (size_t)row * DM + k * 512 + lane * 8 + 4); }
    }
    for (; row < row_end; row += stride) {
        const float* mod = (const float*)(P.ws + WS_MOD) + ((size_t)l * 4 + (row >> 12)) * 6144;
        float ov[32]; f32x4 xc[8]; float ss = 0.f;
#pragma unroll
        for (int k = 0; k < 4; ++k) { const u32x4 w = opn[k]; xc[2 * k] = xn[2 * k]; xc[2 * k + 1] = xn[2 * k + 1];
            ov[8 * k + 0] = lo_bf(w.x); ov[8 * k + 1] = hi_bf(w.x); ov[8 * k + 2] = lo_bf(w.y); ov[8 * k + 3] = hi_bf(w.y);
            ov[8 * k + 4] = lo_bf(w.z); ov[8 * k + 5] = hi_bf(w.z); ov[8 * k + 6] = lo_bf(w.w); ov[8 * k + 7] = hi_bf(w.w); }
        const int rown = row + stride;
        if (rown < row_end) {
#pragma unroll
            for (int k = 0; k < 4; ++k) { opn[k] = *(const u32x4*)(OP + (size_t)rown * DM + k * 512 + lane * 8);
                xn[2 * k] = *(const f32x4*)(xin + (size_t)rown * DM + k * 512 + lane * 8); xn[2 * k + 1] = *(const f32x4*)(xin + (size_t)rown * DM + k * 512 + lane * 8 + 4); }
        }
#pragma unroll
        for (int j = 0; j < 32; ++j) ss += ov[j] * ov[j];
        ss = wave_sum(ss);
        const float rs = 1.0f / sqrtf(ss * (1.0f / DM) + 1e-6f);
        float* orow = outp + (size_t)row * DM; float ss2 = 0.f;
#pragma unroll
        for (int k = 0; k < 4; ++k) {
            const int col = k * 512 + lane * 8;
#pragma unroll
            for (int j = 0; j < 8; ++j) { const float xv = xc[2 * k + (j >> 2)][j & 3];
                const float nv = xv + mod[4096 + col + j] * (ov[8 * k + j] * rs * gpost[col + j]); ov[8 * k + j] = nv; ss2 += nv * nv; }
            *(f32x4*)(orow + col) = (f32x4){ov[8 * k], ov[8 * k + 1], ov[8 * k + 2], ov[8 * k + 3]};
            *(f32x4*)(orow + col + 4) = (f32x4){ov[8 * k + 4], ov[8 * k + 5], ov[8 * k + 6], ov[8 * k + 7]};
        }
        if (l + 1 < DEPTH) {
            ss2 = wave_sum(ss2);
            const float rs2 = 1.0f / sqrtf(ss2 * (1.0f / DM) + 1e-6f);
            const float* mod2 = mod + 4 * 6144; const float* gpre = P.norm_pre_g + (size_t)(l + 1) * DM;
#pragma unroll
            for (int k = 0; k < 4; ++k) {
                const int col = k * 512 + lane * 8; float o[8];
#pragma unroll
                for (int j = 0; j < 8; ++j) o[j] = ov[8 * k + j] * rs2 * gpre[col + j] * (1.0f + mod2[2048 + col + j]) + mod2[col + j];
                u32x4 w; w.x = pk2(o[0], o[1]); w.y = pk2(o[2], o[3]); w.z = pk2(o[4], o[5]); w.w = pk2(o[6], o[7]);
                *(u32x4*)(H + (size_t)row * DM + col) = w;
                u32x2 w8; w8.x = pk4_fp8(o[0] * F8_SCALE_H, o[1] * F8_SCALE_H, o[2] * F8_SCALE_H, o[3] * F8_SCALE_H); w8.y = pk4_fp8(o[4] * F8_SCALE_H, o[5] * F8_SCALE_H, o[6] * F8_SCALE_H, o[7] * F8_SCALE_H);
                *(u32x2*)(H8 + (size_t)row * DM + col) = w8;
            }
        }
    }
}
__device__ __forceinline__ void diffpost_phase(const Params& P, int l) {
    const int tid = opaque_tid(), hw = tid >> 5, l32 = tid & 31;
    const bf16* O0 = (const bf16*)(P.ws + WS_DIFFO); const bf16* O1 = O0 + (size_t)MTOK * 1024;
    const bf16* proj = (const bf16*)(P.ws + WS_PROJ); bf16* ys = (bf16*)(P.ws + WS_YS);
    const float lam = ((const float*)(P.ws + WS_LAM))[l];
    const float lam_init = 0.8f - 0.6f * expf(-0.3f * (float)l);
    const float* g = P.diff_norm_g + (size_t)l * 256 + l32 * 8;
    float gv[8];
#pragma unroll
    for (int j = 0; j < 8; ++j) gv[j] = g[j] * (1.0f - lam_init);
    for (int v = blockIdx.x * 16 + hw; v < MTOK * 4; v += gridDim.x * 16) {
        const size_t row = (size_t)(v >> 2); const int col = (v & 3) * 256 + l32 * 8;
        const u32x4 a = *(const u32x4*)(O0 + row * 1024 + col), b = *(const u32x4*)(O1 + row * 1024 + col), z = *(const u32x4*)(proj + row * LDP + C_AZ + col);
        float d[8];
        d[0] = lo_bf(a.x) - lam * lo_bf(b.x); d[1] = hi_bf(a.x) - lam * hi_bf(b.x); d[2] = lo_bf(a.y) - lam * lo_bf(b.y); d[3] = hi_bf(a.y) - lam * hi_bf(b.y);
        d[4] = lo_bf(a.z) - lam * lo_bf(b.z); d[5] = hi_bf(a.z) - lam * hi_bf(b.z); d[6] = lo_bf(a.w) - lam * lo_bf(b.w); d[7] = hi_bf(a.w) - lam * hi_bf(b.w);
        float ss = 0.f;
#pragma unroll
        for (int j = 0; j < 8; ++j) ss += d[j] * d[j];
#pragma unroll
        for (int o = 16; o >= 1; o >>= 1) ss += __shfl_xor(ss, o);
        const float rs = 1.0f / sqrtf(ss * (1.0f / 256.0f) + 1e-5f);
        const float zz[8] = {lo_bf(z.x), hi_bf(z.x), lo_bf(z.y), hi_bf(z.y), lo_bf(z.z), hi_bf(z.z), lo_bf(z.w), hi_bf(z.w)};
        float o[8];
#pragma unroll
        for (int j = 0; j < 8; ++j) o[j] = d[j] * rs * gv[j] * siluf_(zz[j]);
        u32x4 w; w.x = pk2(o[0], o[1]); w.y = pk2(o[2], o[3]); w.z = pk2(o[4], o[5]); w.w = pk2(o[6], o[7]);
        *(u32x4*)(ys + row * 1024 + col) = w;
    }
}

__device__ __forceinline__ void conv_tile_load(f32x4 (&r)[8], const float* src, size_t lds_, int nvalid) {
    const int tid = opaque_tid(), c4 = (tid & 31) * 4, rb = tid >> 5;
#pragma unroll
    for (int i = 0; i < 8; ++i) r[i] = (c4 < nvalid) ? __builtin_nontemporal_load((const f32x4*)(src + (size_t)(rb + 16 * i) * lds_ + c4)) : (f32x4){0.f, 0.f, 0.f, 0.f};
}
__device__ __forceinline__ void conv_tile_store(const f32x4 (&r)[8], bf16* dst, size_t ldd, char* lds, unsigned char* dst8) {
    const int tid = opaque_tid(), c4 = (tid & 31) * 4, rb = tid >> 5;
    float* T = (float*)lds;
#pragma unroll
    for (int i = 0; i < 8; ++i) { const int k = rb + 16 * i; *(f32x4*)(T + k * 128 + (c4 ^ (((k >> 3) & 7) << 2))) = r[i]; }
    __syncthreads();
    const int kc = tid & 15;
#pragma unroll
    for (int i = 0; i < 4; ++i) { const int n = (tid >> 4) + 32 * i; float v[8];
#pragma unroll
        for (int j = 0; j < 8; ++j) v[j] = T[(8 * kc + j) * 128 + (n ^ ((kc & 7) << 2))];
        if (dst8) { u32x2 w8; w8.x = pk4_fp8(v[0] * F8_SCALE_W, v[1] * F8_SCALE_W, v[2] * F8_SCALE_W, v[3] * F8_SCALE_W); w8.y = pk4_fp8(v[4] * F8_SCALE_W, v[5] * F8_SCALE_W, v[6] * F8_SCALE_W, v[7] * F8_SCALE_W);
                    *(u32x2*)(dst8 + (size_t)n * ldd + 8 * kc) = w8; }
        else { u32x4 w; w.x = pk2(v[0], v[1]); w.y = pk2(v[2], v[3]); w.z = pk2(v[4], v[5]); w.w = pk2(v[6], v[7]);
               *(u32x4*)(dst + (size_t)n * ldd + 8 * kc) = w; } }
    __syncthreads();
}
struct ConvTile { const float* src; bf16* dst; unsigned char* dst8; size_t lds_, ldd; int nvalid; };
constexpr int CT_WIN1 = 16 * 142, CT_WBR1 = 8 * 16, CT_WOUT1 = 16 * 16, CT_W1 = 8 * 32, CT_W2 = 8;
__device__ __forceinline__ ConvTile conv_win(const Params& P, int l, int r) { ConvTile c; c.dst8 = nullptr;
    const int nt = r / 16, kt = r % 16; const int n0 = nt * 128;
    int s0, nv = 128; if (n0 < C_NZ) s0 = n0; else if (n0 < C_SQ) s0 = 6680 + (n0 - C_NZ); else if (n0 < C_NG) s0 = 7704 + (n0 - C_SQ);
    else if (n0 < C_MG) { s0 = 6656 + (n0 - C_NG); nv = (n0 == C_NG) ? 24 : 0; if (nv == 0) s0 = 0; } else s0 = 11800 + (n0 - C_MG);
    c.src = P.w_in + ((size_t)l * DM + kt * 128) * N_IN + s0; c.lds_ = N_IN; c.nvalid = nv; c.ldd = DM;
    c.dst = (bf16*)(P.ws + WS_WIN) + ((size_t)l * LDP + n0) * DM + kt * 128;
    if (n0 >= C_MG) c.dst8 = P.ws + WS_WG8 + ((size_t)l * N_F8 + (n0 - C_MG)) * DM + kt * 128;
    return c; }
__device__ __forceinline__ ConvTile conv_wbr(const Params& P, int m, int r) { ConvTile c; c.dst8 = nullptr; const int nt = r / 8, kt = r % 8;
    c.src = P.w_branch + ((size_t)m * 1024 + kt * 128) * DM + nt * 128; c.lds_ = DM; c.nvalid = 128;
    c.dst = (bf16*)(P.ws + WS_WBR) + ((size_t)m * DM + nt * 128) * 1024 + kt * 128; c.ldd = 1024; return c; }
__device__ __forceinline__ ConvTile conv_wout(const Params& P, int l, int r) { ConvTile c; c.dst8 = nullptr; const int nt = r / 16, kt = r % 16;
    c.src = P.w_out + ((size_t)l * DM + kt * 128) * DM + nt * 128; c.lds_ = DM; c.nvalid = 128;
    c.dst = (bf16*)(P.ws + WS_WOUT) + ((size_t)l * DM + nt * 128) * DM + kt * 128; c.ldd = DM; return c; }
__device__ __forceinline__ ConvTile conv_cmpw(const Params& P, int t) { ConvTile c; c.dst8 = nullptr;
    if (t < CT_W1) { const int kv = t / 128, r = t % 128, l = r / 32, kt = r % 32;
        c.src = (kv ? P.w1_v : P.w1_k) + ((size_t)l * 4096 + kt * 128) * 128; c.lds_ = 128; c.nvalid = 128;
        c.dst = (bf16*)(P.ws + (kv ? WS_W1V : WS_W1K)) + (size_t)l * 128 * 4096 + kt * 128; c.ldd = 4096; return c; }
    t -= CT_W1;
    { const int kv = t / 4, l = t % 4;
        c.src = (kv ? P.w2_v : P.w2_k) + (size_t)l * 128 * 128; c.lds_ = 128; c.nvalid = 128;
        c.dst = (bf16*)(P.ws + (kv ? WS_W2V : WS_W2K)) + (size_t)l * 128 * 128; c.ldd = 128; return c; }
}
constexpr int CT_PRO = CT_WIN1 + CT_W1 + CT_W2;
__device__ __forceinline__ ConvTile conv_decode_pro(const Params& P, int t) { if (t < CT_WIN1) return conv_win(P, 0, t); return conv_cmpw(P, t - CT_WIN1); }
constexpr int CT_DEF_A = 3 * CT_WBR1 + CT_WOUT1, CT_DEF = CT_DEF_A + CT_WIN1, CONV_TPI = 4;
__device__ __forceinline__ constexpr int conv_def_items(int l) { return ((l + 1 < DEPTH ? CT_DEF : CT_DEF_A) + CONV_TPI - 1) / CONV_TPI; }
__device__ __forceinline__ ConvTile conv_decode_def(const Params& P, int l, int t) {
    if (t < 3 * CT_WBR1) return conv_wbr(P, l * 3 + t / CT_WBR1, t % CT_WBR1);
    t -= 3 * CT_WBR1; if (t < CT_WOUT1) return conv_wout(P, l, t);
    return conv_win(P, l + 1, t - CT_WOUT1); }
__device__ __forceinline__ void conv_item(const Params& P, int l, int item, char* lds) {
    const int nt_ = (l + 1 < DEPTH) ? CT_DEF : CT_DEF_A, t0 = item * CONV_TPI, t1 = (t0 + CONV_TPI < nt_) ? t0 + CONV_TPI : nt_;
    f32x4 r[8]; ConvTile c = conv_decode_def(P, l, t0); conv_tile_load(r, c.src, c.lds_, c.nvalid);
    for (int t = t0; t < t1; ++t) {
        ConvTile cn = c; f32x4 rn[8];
        if (t + 1 < t1) { cn = conv_decode_def(P, l, t + 1); conv_tile_load(rn, cn.src, cn.lds_, cn.nvalid); }
        conv_tile_store(r, c.dst, c.ldd, lds, c.dst8);
        if (t + 1 < t1) {
#pragma unroll
            for (int i = 0; i < 8; ++i) r[i] = rn[i]; }
        c = cn;
    }
}
__device__ __forceinline__ void prologue_phase(const Params& P, char* lds) {
    const int tid = opaque_tid();
    {
        f32x4 r[8]; int t = blockIdx.x;
        ConvTile c = {}; if (t < CT_PRO) { c = conv_decode_pro(P, t); conv_tile_load(r, c.src, c.lds_, c.nvalid); }
        while (t < CT_PRO) {
            const int tn = t + gridDim.x; ConvTile cn = c; f32x4 rn[8];
            if (tn < CT_PRO) { cn = conv_decode_pro(P, tn); conv_tile_load(rn, cn.src, cn.lds_, cn.nvalid); }
            conv_tile_store(r, c.dst, c.ldd, lds, c.dst8);
            if (tn < CT_PRO) {
#pragma unroll
                for (int i = 0; i < 8; ++i) r[i] = rn[i]; }
            c = cn; t = tn;
        }
    }
    {
        float* sl = (float*)lds;
        float* modp = (float*)(P.ws + WS_MODP);
        for (int it = blockIdx.x; it < 4 * 32 * 12; it += gridDim.x) {
            const int l = it / 384, r = it % 384, kc = r / 12, jb = r % 12, j = jb * 512 + tid;
            __syncthreads();
            if (tid < 256) { const int b = tid >> 6, k = tid & 63; sl[tid] = siluf_(P.c[(size_t)b * DM + kc * 64 + k]); }
            __syncthreads();
            const float* w = P.w_ada + ((size_t)l * DM + kc * 64) * 6144 + j;
            float a0 = 0.f, a1 = 0.f, a2 = 0.f, a3 = 0.f;
#pragma unroll 16
            for (int k = 0; k < 64; ++k) { const float wv = w[(size_t)k * 6144]; a0 += sl[k] * wv; a1 += sl[64 + k] * wv; a2 += sl[128 + k] * wv; a3 += sl[192 + k] * wv; }
            float* mp = modp + (((size_t)l * 32 + kc) * 4) * 6144 + j;
            mp[0] = a0; mp[6144] = a1; mp[2 * 6144] = a2; mp[3 * 6144] = a3;
        }
        __syncthreads();
    }
    {
        float* rope = (float*)(P.ws + WS_ROPE);
        for (int i = blockIdx.x * 512 + tid; i < SEQ * 16; i += gridDim.x * 512) {
            const int pos = i >> 4, fi = i & 15;
            const float inv = powf(500000.0f, -(float)(2 * fi) / 32.0f);
            const float ang = (float)pos * inv;
            rope[pos * 32 + fi] = cosf(ang); rope[pos * 32 + 16 + fi] = sinf(ang);
        }
    }
}
__device__ __forceinline__ void modreduce_phase(const Params& P) {
    const int tid = opaque_tid();
    const float* modp = (const float*)(P.ws + WS_MODP); float* mod = (float*)(P.ws + WS_MOD);
    for (int i = blockIdx.x * 512 + tid; i < 4 * 4 * 6144; i += gridDim.x * 512) {
        const int l = i / (4 * 6144), r = i % (4 * 6144), b = r / 6144, j = r % 6144;
        float s = P.b_ada[(size_t)l * 6144 + j];
        for (int kc = 0; kc < 32; ++kc) s += modp[(((size_t)l * 32 + kc) * 4 + b) * 6144 + j];
        mod[i] = s;
    }
    if (blockIdx.x == 0 && tid < 256) {
        const int l = tid >> 6, lane = tid & 63;
        float s1 = P.lq1[l * 128 + lane] * P.lk1[l * 128 + lane] + P.lq1[l * 128 + 64 + lane] * P.lk1[l * 128 + 64 + lane];
        float s2 = P.lq2[l * 128 + lane] * P.lk2[l * 128 + lane] + P.lq2[l * 128 + 64 + lane] * P.lk2[l * 128 + 64 + lane];
        s1 = wave_sum(s1); s2 = wave_sum(s2);
        if (lane == 0) ((float*)(P.ws + WS_LAM))[l] = expf(s1) - expf(s2) + (0.8f - 0.6f * expf(-0.3f * (float)l));
    }
}

__device__ __forceinline__ BlockRef diff_ref(const bf16* proj, int item, int pass) {
    const int bh = item >> 3, x = item & 7, b = bh >> 4, hh = bh & 15, h = hh >> 2, c = (hh >> 1) & 1, vh = hh & 1;
    const int qb = pass ? 15 - x : x;
    BlockRef r; const bf16* base = proj + (size_t)b * SEQ * LDP;
    r.Q = base + (size_t)qb * QB * LDP + C_AQ + (h * 2 + c) * 128; r.K = base + C_AK + (h * 2 + c) * 128; r.V = base + C_AV + h * 256 + vh * 128;
    r.M = nullptr; r.P0 = qb * QB; r.row0 = b * SEQ + qb * QB + c * MTOK; r.aux = h * 256 + vh * 128; r.aux2 = 0; return r;
}
__device__ __forceinline__ BlockRef win_ref(const bf16* proj, int item, int pass) {
    const int blk = item * 2 + pass, bg = blk >> 6, qb = blk & 63, b = bg >> 1, g = bg & 1, head = g * 4;
    BlockRef r; const bf16* base = proj + (size_t)b * SEQ * LDP;
    r.Q = base + (size_t)qb * 64 * LDP + C_NQ + head * 128; r.K = base + C_NKW + g * 128; r.V = base + C_NVW + g * 128;
    r.M = nullptr; r.P0 = qb * 64; r.row0 = b * SEQ + qb * 64; r.aux = head * 128; r.aux2 = head; return r;
}
__device__ __forceinline__ BlockRef slc_ref(const bf16* proj, const u64* selm, int item, int pass) {
    const int bg = item >> 5, x = item & 31, b = bg >> 1, g = bg & 1, head = g * 4;
    const int qb = pass ? 63 - x : x;
    BlockRef r; const bf16* base = proj + (size_t)b * SEQ * LDP;
    r.Q = base + (size_t)qb * 64 * LDP + C_NQ + head * 128; r.K = base + C_NKS + g * 128; r.V = base + C_NVS + g * 128;
    r.M = selm + (size_t)(b * 2 + g) * SEQ; r.P0 = qb * 64; r.row0 = b * SEQ + qb * 64; r.aux = head * 128; r.aux2 = head; return r;
}
__device__ __forceinline__ BlockRef sb_ref(const bf16* proj, int blk) {
    const int bh = blk >> 4, qb = blk & 15, b = bh >> 3, head = bh & 7;
    BlockRef r; const bf16* base = proj + (size_t)b * SEQ * LDP;
    r.Q = base + (size_t)qb * QB * LDP + C_SQ + head * 128; r.K = base + C_SK + head * 128; r.V = base + C_SV + head * 128;
    r.M = nullptr; r.P0 = qb * QB; r.row0 = b * SEQ + qb * QB; r.aux = head * 128; r.aux2 = head; return r;
}

constexpr int N_PHASES = 3 + 7 * DEPTH;
typedef const __attribute__((address_space(4))) Params* kparams_t;
__device__ __forceinline__ kparams_t kparams() { kparams_t p = (kparams_t)__builtin_amdgcn_kernarg_segment_ptr(); asm volatile("" : "+s"(p)); return p; }
__device__ __forceinline__ Params load_params(kparams_t k) { Params p;
    p.x = k->x; p.c = k->c; p.norm_pre_g = k->norm_pre_g; p.norm_post_g = k->norm_post_g; p.w_ada = k->w_ada; p.b_ada = k->b_ada; p.w_in = k->w_in;
    p.lq1 = k->lq1; p.lk1 = k->lk1; p.lq2 = k->lq2; p.lk2 = k->lk2; p.diff_norm_g = k->diff_norm_g;
    p.pe_k = k->pe_k; p.w1_k = k->w1_k; p.w2_k = k->w2_k; p.pe_v = k->pe_v; p.w1_v = k->w1_v; p.w2_v = k->w2_v; p.w_branch = k->w_branch; p.w_out = k->w_out;
    p.out = k->out; p.ws = k->ws; return p; }
template <int MODE> __global__ void __launch_bounds__(512, 2) hybrid_fwd(Params Parg, int ph_lo, int ph_hi) {
    extern __shared__ __attribute__((aligned(16))) unsigned char lds_raw[];
    char* lds = (char*)lds_raw;
    (void)Parg;
    { const int tid = threadIdx.x;
      if (tid < 64) ((volatile unsigned*)(lds + LDS_CTL))[tid] = 0u; }
    __syncthreads();
    const bool one = (ph_hi - ph_lo) > 1;
    if (one) (void)xcd_barrier_post((unsigned*)(kparams()->ws + WS_CTL) + CW_BAR, (volatile LAS unsigned*)(lds + LDS_CTL));
    if (one && threadIdx.x == 0) (void)__hip_atomic_fetch_or((unsigned*)(kparams()->ws + WS_CTL) + CW_GXM + 64 * (blockIdx.x & 7), 1u << xb_xcc_id(), __ATOMIC_RELAXED, __HIP_MEMORY_SCOPE_AGENT);
#define IN(k) (ph_lo <= (k) && (k) < ph_hi)
#define TY(t) (MODE < 0 || MODE == (t) || ((t) == 4 && MODE >= 10 && MODE < 14))
#define SUB(s_) (MODE < 10 || MODE == 10 + (s_))
#define SEAM(k) do { if ((k) + 1 < ph_hi) { XcdBarrier b_; b_.bar = (unsigned*)(kparams()->ws + WS_CTL) + CW_BAR; b_.x = xb_xcc_id(); b_.st = (volatile LAS unsigned*)(lds + LDS_CTL); xcd_barrier(b_); } } while (0)
#define LOCAL_SEAM(k) do { if ((k) + 1 < ph_hi) { asm volatile("s_waitcnt vmcnt(0)" ::: "memory"); __syncthreads(); \
        if (threadIdx.x == 0) { __builtin_amdgcn_fence(__ATOMIC_ACQUIRE, "agent"); asm volatile("s_waitcnt vmcnt(0)" ::: "memory"); } __syncthreads(); } } while (0)
#define GROUP_SEAM(k, use_) do { if ((k) + 1 < ph_hi) { if (grp_ok) { unsigned* ctl_ = (unsigned*)(kparams()->ws + WS_CTL); group_barrier(ctl_ + CW_BAR, ctl_ + CW_GRP + 64 * (blockIdx.x & 7), 32u * (unsigned)(use_), ctl_ + CW_GXM + 64 * (blockIdx.x & 7), (volatile LAS unsigned*)(lds + LDS_CTL)); } else SEAM(k); } } while (0)
#define REP(id) for (int rep_ = 0; rep_ < ((((PROBE_DUP_MASK) >> (id)) & 1) ? 2 : 1); ++rep_)
#define KP() const Params P = load_params(kparams()); bf16* proj = (bf16*)(P.ws + WS_PROJ); const int G = gridDim.x, c = blockIdx.x; (void)proj; (void)G; (void)c
    if constexpr (TY(0)) if (IN(0)) { { KP(); REP(0) prologue_phase(P, lds); } SEAM(0); }
    if constexpr (TY(1)) if (IN(1)) { { KP(); REP(1) modreduce_phase(P); } SEAM(1); }
    if constexpr (TY(2)) if (IN(2)) { { KP(); REP(2) norm_phase(P, 0, P.x); } SEAM(2); }

    const bool grp_ok = gridDim.x == 256;
    for (int l = 0; l < DEPTH; ++l) {
        const int pb = 3 + 7 * l;
        if constexpr (TY(3)) if (IN(pb + 0)) {
            { KP();
            pg8::Gemm g{(const pg8::bf16_t*)(P.ws + WS_H), (const pg8::bf16_t*)(P.ws + WS_WIN) + (size_t)l * LDP * DM, MTOK, N_BF, DM};
            pg8::StaticOrder S; S.init(MTOK, N_BF, G, c);
            pg8::EpiProj E{(pg8::bf16_t*)proj, (const float*)(P.ws + WS_ROPE)};
            REP(3) pg8::gemm_phase<pg8::EpiProj, pg8::StaticOrder, true, true>((PG8_LAS unsigned char*)lds_raw, g, S, E);
            pg8::Gemm g8{(const pg8::bf16_t*)(P.ws + WS_H8), (const pg8::bf16_t*)(P.ws + WS_WG8 + (size_t)l * N_F8 * DM), MTOK, N_F8, DM / 2};
            pg8::StaticOrder S8; S8.init(MTOK, N_F8, G, c);
            pg8::EpiGate8 E8{(pg8::bf16_t*)proj};
            REP(3) pg8::gemm_phase<pg8::EpiGate8, pg8::StaticOrder, false, true, true>((PG8_LAS unsigned char*)lds_raw, g8, S8, E8); }
            SEAM(pb + 0);
        }
        if constexpr (TY(4)) if (IN(pb + 1)) {
            if constexpr (SUB(0)) REP(10) {
                KP();
                for (int L = c; L < 256; L += G) {
                    const int bhc = L >> 3, x = L & 7, b = bhc >> 3, h = (bhc >> 1) & 3, cm = bhc & 1;
                    const bf16* base = proj + (size_t)b * SEQ * LDP;
                    for (int pass = 0; pass < 2; ++pass) {
                        const int qb = pass ? 15 - x : x;
                        BlockRef r; r.Q = base + (size_t)qb * QB * LDP + C_AQ + (h * 2 + cm) * 128; r.K = base + C_AK + (h * 2 + cm) * 128; r.V = base + C_AV + h * 256;
                        r.M = nullptr; r.P0 = qb * QB; r.row0 = b * SEQ + qb * QB + cm * MTOK; r.aux = h * 256; r.aux2 = 0;
                        diff_block(r, (bf16*)(P.ws + WS_DIFFO), lds);
                    }
                }
            }
            if constexpr (SUB(1)) REP(11) {
                KP();
                EpiAttnStore E{(bf16*)(P.ws + WS_OWIN), 1024, lds};
                for (int L0 = c; L0 < 256; L0 += G) { const int L = L0;
                    for (int pass = 0; pass < 2; ++pass) { const BlockRef cur = win_ref(proj, L, pass); attn_simple<false, 512, 4, EpiAttnStore>(cur, lds, E); } }
            }
            if constexpr (SUB(2)) {
                KP();
                EpiSb E{proj, (bf16*)(P.ws + WS_YS) + (size_t)2 * MTOK * 1024, lds};
                unsigned* qctr = (unsigned*)(P.ws + WS_CTL) + CW_QUEUE + 64 * l;
                volatile unsigned* qslot = (volatile unsigned*)(lds + LDS_CTL + 64);
                const bool t0 = threadIdx.x == 0;
                if (t0) *qslot = __hip_atomic_fetch_add(qctr, 1u, __ATOMIC_RELAXED, __HIP_MEMORY_SCOPE_AGENT);
                __syncthreads(); unsigned it = *qslot; __syncthreads();
                const unsigned nq = 640u + (unsigned)conv_def_items(l);
                while (it < nq) {
                    unsigned nx = 0u; if (t0) nx = __hip_atomic_fetch_add(qctr, 1u, __ATOMIC_RELAXED, __HIP_MEMORY_SCOPE_AGENT);
                    if (it < 128u) { const int kv = (int)it >> 6, bg = ((int)it >> 3) & 7, nt = (int)it & 7;
                        compress_item(proj, (kv ? P.pe_v : P.pe_k) + (size_t)l * 32 * 128, (const bf16*)(P.ws + (kv ? WS_W1V : WS_W1K)) + (size_t)l * 128 * 4096,
                                      (const bf16*)(P.ws + (kv ? WS_W2V : WS_W2K)) + (size_t)l * 128 * 128, (bf16*)(P.ws + (kv ? WS_VCMP : WS_KCMP)), kv, bg, nt, lds); }
                    else if (it >= 640u) conv_item(P, l, (int)it - 640, lds);
                    else { const int idx = (int)it - 128, b = idx >> 7, hp = (idx >> 5) & 3, qh = 31 - (idx & 31);
                        const bf16* base = proj + (size_t)b * SEQ * LDP + hp * 256;
                        SbPairRef pr; pr.Q = base + (size_t)qh * 128 * LDP + C_SQ; pr.K = base + C_SK; pr.V = base + C_SV; pr.P0 = qh * 128; pr.row0 = b * SEQ + qh * 128; pr.aux = hp * 256;
                        sb_pair(pr, lds, E); }
                    if (t0) *qslot = nx;
                    __syncthreads(); it = *qslot; __syncthreads();
                }
            }
            SEAM(pb + 1);
        }
        if constexpr (TY(5)) if (IN(pb + 2)) {
            { KP(); REP(5) for (int it = c; it < 256; it += G)
                cmp_pair(proj, (const bf16*)(P.ws + WS_KCMP), (const bf16*)(P.ws + WS_VCMP), (bf16*)(P.ws + WS_OCMP), (u64*)(P.ws + WS_SELM), it, lds);
            REP(14) diffpost_phase(P, l); }
            LOCAL_SEAM(pb + 2);
        }
        if constexpr (TY(6)) if (IN(pb + 3)) {
            { KP();
            EpiNsaCombineT E{proj, (const bf16*)(P.ws + WS_OCMP), (const bf16*)(P.ws + WS_OWIN), (bf16*)(P.ws + WS_YS) + (size_t)MTOK * 1024, lds};
            const u64* selm = (const u64*)(P.ws + WS_SELM);
            REP(6) { for (int L = c; L < 256; L += G) {
                for (int pass = 0; pass < 2; ++pass) { const BlockRef cur = slc_ref(proj, selm, L, pass); attn_simple<true, 1 << 30, 4, EpiNsaCombineT, true>(cur, lds, E); }
            } } }
            SEAM(pb + 3);
        }
        if constexpr (TY(7)) if (IN(pb + 4)) {
            { KP();
            pg8::Gemm g{(const pg8::bf16_t*)(P.ws + WS_YS), (const pg8::bf16_t*)(P.ws + WS_WBR) + (size_t)l * 3 * DM * 1024, 3 * MTOK, 3 * DM, 1024};
            pg8::BranchOrder S{G, c};
            pg8::EpiBranch E{(const pg8::bf16_t*)proj, (pg8::bf16_t*)(P.ws + WS_MERGED)};
            REP(7) pg8::gemm_phase<pg8::EpiBranch, pg8::BranchOrder, false, true>((PG8_LAS unsigned char*)lds_raw, g, S, E); }
            GROUP_SEAM(pb + 4, 3 * l + 1);
        }
        if constexpr (TY(8)) if (IN(pb + 5)) {
            { KP();
            pg8::Gemm g{(const pg8::bf16_t*)(P.ws + WS_MERGED), (const pg8::bf16_t*)(P.ws + WS_WOUT) + (size_t)l * DM * DM, MTOK, DM, DM};
            pg8::StaticOrder S; S.init(MTOK, DM, G, c);
            pg8::EpiPlain E{(pg8::bf16_t*)(P.ws + WS_OUTPRE), DM};
            REP(8) pg8::gemm_phase<pg8::EpiPlain, pg8::StaticOrder, false, true>((PG8_LAS unsigned char*)lds_raw, g, S, E); }
            GROUP_SEAM(pb + 5, 3 * l + 2);
        }
        if constexpr (TY(9)) if (IN(pb + 6)) {
            { KP(); post_phase(P, l, l == 0 ? P.x : P.out, grp_ok); }
            GROUP_SEAM(pb + 6, 3 * l + 3);
        }
    }
#undef IN
#undef TY
#undef SUB
#undef SEAM
#undef REP
#undef KP
}

#if MK_ONE_LAUNCH
static hipError_t set_attrs() { return hipFuncSetAttribute((const void*)hybrid_fwd<-1>, hipFuncAttributeMaxDynamicSharedMemorySize, LDS_BYTES); }
#else
template <int T> static hipError_t set_attr1() { return hipFuncSetAttribute((const void*)hybrid_fwd<T>, hipFuncAttributeMaxDynamicSharedMemorySize, LDS_BYTES); }
static hipError_t set_attrs() { hipError_t e = hipSuccess, r;
    r = set_attr1<0>(); if (r != hipSuccess) e = r; r = set_attr1<1>(); if (r != hipSuccess) e = r; r = set_attr1<2>(); if (r != hipSuccess) e = r; r = set_attr1<3>(); if (r != hipSuccess) e = r;
    r = set_attr1<5>(); if (r != hipSuccess) e = r; r = set_attr1<6>(); if (r != hipSuccess) e = r; r = set_attr1<7>(); if (r != hipSuccess) e = r;
    r = set_attr1<8>(); if (r != hipSuccess) e = r; r = set_attr1<9>(); if (r != hipSuccess) e = r;
    r = set_attr1<10>(); if (r != hipSuccess) e = r; r = set_attr1<11>(); if (r != hipSuccess) e = r; r = set_attr1<12>(); if (r != hipSuccess) e = r; r = set_attr1<13>(); if (r != hipSuccess) e = r; return e; }
static void launch_phase(int ty, int grid, hipStream_t stream, const Params& p, int k) {
    switch (ty) {
    case 0: hipLaunchKernelGGL(hybrid_fwd<0>, dim3(grid), dim3(512), LDS_BYTES, stream, p, k, k + 1); break;
    case 1: hipLaunchKernelGGL(hybrid_fwd<1>, dim3(grid), dim3(512), LDS_BYTES, stream, p, k, k + 1); break;
    case 2: hipLaunchKernelGGL(hybrid_fwd<2>, dim3(grid), dim3(512), LDS_BYTES, stream, p, k, k + 1); break;
    case 3: hipLaunchKernelGGL(hybrid_fwd<3>, dim3(grid), dim3(512), LDS_BYTES, stream, p, k, k + 1); break;
    case 4: hipLaunchKernelGGL(hybrid_fwd<10>, dim3(grid), dim3(512), LDS_BYTES, stream, p, k, k + 1);
            hipLaunchKernelGGL(hybrid_fwd<11>, dim3(grid), dim3(512), LDS_BYTES, stream, p, k, k + 1);
            hipLaunchKernelGGL(hybrid_fwd<12>, dim3(grid), dim3(512), LDS_BYTES, stream, p, k, k + 1);
            hipLaunchKernelGGL(hybrid_fwd<13>, dim3(grid), dim3(512), LDS_BYTES, stream, p, k, k + 1); break;
    case 5: hipLaunchKernelGGL(hybrid_fwd<5>, dim3(grid), dim3(512), LDS_BYTES, stream, p, k, k + 1); break;
    case 6: hipLaunchKernelGGL(hybrid_fwd<6>, dim3(grid), dim3(512), LDS_BYTES, stream, p, k, k + 1); break;
    case 7: hipLaunchKernelGGL(hybrid_fwd<7>, dim3(grid), dim3(512), LDS_BYTES, stream, p, k, k + 1); break;
    case 8: hipLaunchKernelGGL(hybrid_fwd<8>, dim3(grid), dim3(512), LDS_BYTES, stream, p, k, k + 1); break;
    default: hipLaunchKernelGGL(hybrid_fwd<9>, dim3(grid), dim3(512), LDS_BYTES, stream, p, k, k + 1); break;
    }
}
#endif
extern "C" void kernel_launch(void* const* d_in, const int* in_sizes, int n_in, void* d_out, int out_size, void* d_ws, size_t ws_size, hipStream_t stream) {
    static int grid = 0;
    if (grid == 0) {
        if (n_in != 20 || out_size != MTOK * DM || ws_size < WS_END) { fprintf(stderr, "kernel_launch: unexpected shapes (n_in %d, out %d, ws %zu < %zu)\n", n_in, out_size, ws_size, (size_t)WS_END); grid = -1; return; }
        int dev = 0, cus = 0, per_cu = 0;
        if (hipGetDevice(&dev) != hipSuccess || hipDeviceGetAttribute(&cus, hipDeviceAttributeMultiprocessorCount, dev) != hipSuccess) { grid = -1; return; }
        if (set_attrs() != hipSuccess) { fprintf(stderr, "kernel_launch: hipFuncSetAttribute failed\n"); grid = -1; return; }
        (void)per_cu;
        (void)hipGetLastError();
        grid = cus;
    }
    if (grid < 0) return;
    (void)hipMemsetAsync((char*)d_ws + WS_CTL, 0, CTL_BYTES, stream);
    Params p{};
    p.x = (const float*)d_in[0]; p.c = (const float*)d_in[1]; p.norm_pre_g = (const float*)d_in[2]; p.norm_post_g = (const float*)d_in[3];
    p.w_ada = (const float*)d_in[4]; p.b_ada = (const float*)d_in[5]; p.w_in = (const float*)d_in[6];
    p.lq1 = (const float*)d_in[7]; p.lk1 = (const float*)d_in[8]; p.lq2 = (const float*)d_in[9]; p.lk2 = (const float*)d_in[10]; p.diff_norm_g = (const float*)d_in[11];
    p.pe_k = (const float*)d_in[12]; p.w1_k = (const float*)d_in[13]; p.w2_k = (const float*)d_in[14]; p.pe_v = (const float*)d_in[15]; p.w1_v = (const float*)d_in[16]; p.w2_v = (const float*)d_in[17];
    p.w_branch = (const float*)d_in[18]; p.w_out = (const float*)d_in[19];
    p.out = (float*)d_out; p.ws = (unsigned char*)d_ws;
#if MK_ONE_LAUNCH
    hipLaunchKernelGGL(hybrid_fwd<-1>, dim3(grid), dim3(512), LDS_BYTES, stream, p, 0, N_PHASES);
#else
    for (int k = 0; k < N_PHASES; ++k) launch_phase(k < 3 ? k : 3 + (k - 3) % 7, grid, stream, p, k);
#endif
}
```
